# Optimizing an MI355X kernel written in HIP

```python
import jax, jax.numpy as jnp
from jax import lax
import numpy as np

D_MODEL = 1024
BATCH = 2
SEQ = 8192
DEPTH = 2

GRID_W = 64
CTX_LEN = 256
N_MIXERS = 2
GLA_HEADS = 4
GLA_DK = D_MODEL // 2
GLA_DV = D_MODEL
GLA_DK_HEAD = GLA_DK // GLA_HEADS
GLA_DV_HEAD = GLA_DV // GLA_HEADS
GLA_LOW_RANK = 16
GLA_GATE_NORM = 16.0
GLA_CHUNK = 64
ROPE_BASE = 10000.0
NA_HEADS = 16
NA_HEAD_DIM = D_MODEL // NA_HEADS
NA_KH = 8
NA_KW = 16
D_FF = 2816
CONV_W = 3
EPS = 1e-6

kernel_name = "hybrid_gla_natten_convffn_prefix_dit"


def rms_norm(x, g):
    xf = x.astype(jnp.float32)
    y = xf * lax.rsqrt(jnp.mean(xf * xf, axis=-1, keepdims=True) + EPS)
    return (y * g.astype(jnp.float32)).astype(x.dtype)


def modulate(x, g, shift, scale):
    return rms_norm(x, g) * (1 + scale) + shift


def rope_2d(x, rows, cols):
    half = x.shape[-1] // 2
    inv = 1.0 / (ROPE_BASE ** (jnp.arange(0, half, 2, dtype=jnp.float32) / half))

    def rot(xa, pos):
        ang = pos.astype(jnp.float32)[:, None] * inv[None, :]
        cos = jnp.cos(ang)[:, None, :].astype(x.dtype)
        sin = jnp.sin(ang)[:, None, :].astype(x.dtype)
        x1, x2 = jnp.split(xa, 2, axis=-1)
        return jnp.concatenate([x1 * cos - x2 * sin, x1 * sin + x2 * cos], axis=-1)

    return jnp.concatenate([rot(x[..., :half], rows), rot(x[..., half:], cols)], axis=-1)


def gla_chunked(q, k, v, g, s0):
    B, H, T, dk = q.shape
    dv = v.shape[-1]
    n = T // GLA_CHUNK

    def to_chunks(t):
        return jnp.moveaxis(t.reshape(B, H, n, GLA_CHUNK, t.shape[-1]), 2, 0)

    mask = jnp.tril(jnp.ones((GLA_CHUNK, GLA_CHUNK), dtype=bool))[:, :, None]

    def step(s, xs):
        qc, kc, vc, gc = xs
        b = jnp.cumsum(gc, axis=2)
        b_last = b[:, :, -1:, :]
        o_inter = jnp.einsum('bhid,bhde->bhie', qc * jnp.exp(b), s)
        diff = jnp.where(mask, b[:, :, :, None, :] - b[:, :, None, :, :], -jnp.inf)
        att = jnp.einsum('bhid,bhjd,bhijd->bhij', qc, kc, jnp.exp(diff))
        o = o_inter + jnp.einsum('bhij,bhje->bhie', att, vc)
        s_new = jnp.exp(b_last)[:, :, 0, :, None] * s + jnp.einsum('bhjd,bhje->bhde', kc * jnp.exp(b_last - b), vc)
        return s_new, o

    s_final, o = lax.scan(step, s0, (to_chunks(q), to_chunks(k), to_chunks(v), to_chunks(g)))
    o = jnp.moveaxis(o, 0, 2).reshape(B, H, T, dv)
    return o, s_final


def gla_mixer(h_ctx, h_lat, w_in, a_w1, a_w2, a_b, norm_g, w_out, with_ctx_out):
    B, N, _ = h_lat.shape
    L = h_ctx.shape[1]
    T = L + N
    h = jnp.concatenate([h_ctx, h_lat], axis=1)
    proj = h @ w_in
    q, k, v, r = jnp.split(proj, [GLA_DK, 2 * GLA_DK, 2 * GLA_DK + GLA_DV], axis=-1)
    q = q.reshape(B, T, GLA_HEADS, GLA_DK_HEAD)
    k = k.reshape(B, T, GLA_HEADS, GLA_DK_HEAD)
    v = v.reshape(B, T, GLA_HEADS, GLA_DV_HEAD)
    pos = jnp.arange(N)
    rows, cols = pos // GRID_W, pos % GRID_W
    q = jnp.concatenate([q[:, :L], rope_2d(q[:, L:], rows, cols)], axis=1) * (GLA_DK_HEAD ** -0.5)
    k = jnp.concatenate([k[:, :L], rope_2d(k[:, L:], rows, cols)], axis=1)
    to_bhtd = lambda t: jnp.transpose(t, (0, 2, 1, 3))
    q, k, v = to_bhtd(q), to_bhtd(k), to_bhtd(v)
    s0 = jnp.zeros((B, GLA_HEADS, GLA_DK_HEAD, GLA_DV_HEAD), dtype=q.dtype)
    flip = lambda t: jnp.flip(t, axis=2)

    o_sum = None
    for d in range(2):
        g = jax.nn.log_sigmoid((h @ a_w1[d]) @ a_w2[d] + a_b[d]) / GLA_GATE_NORM
        g = to_bhtd(g.reshape(B, T, GLA_HEADS, GLA_DK_HEAD))
        qd, kd, vd, gd = q, k, v, g
        if d == 1:
            qd, kd, vd, gd = flip(q), flip(k), flip(v), flip(g)
            o_c, s_c = gla_chunked(qd[:, :, N:], kd[:, :, N:], vd[:, :, N:], gd[:, :, N:], s0)
            o_l, _ = gla_chunked(qd[:, :, :N], kd[:, :, :N], vd[:, :, :N], gd[:, :, :N], s_c)
            o_d = jnp.concatenate([flip(o_c), flip(o_l)], axis=2)
        else:
            o_c, s_c = gla_chunked(qd[:, :, :L], kd[:, :, :L], vd[:, :, :L], gd[:, :, :L], s0)
            o_l, _ = gla_chunked(qd[:, :, L:], kd[:, :, L:], vd[:, :, L:], gd[:, :, L:], s_c)
            o_d = jnp.concatenate([o_c, o_l], axis=2)
        o_sum = o_d if o_sum is None else o_sum + o_d

    o = jnp.transpose(o_sum, (0, 2, 1, 3))
    r = r.reshape(B, T, GLA_HEADS, GLA_DV_HEAD)
    if not with_ctx_out:
        o, r = o[:, L:], r[:, L:]
    y = (rms_norm(o, norm_g) * jax.nn.silu(r)).reshape(B, -1, GLA_DV) @ w_out
    if with_ctx_out:
        return y[:, :L], y[:, L:]
    return None, y


def na_mixer(h_ctx, h_lat, w_qkv, rpb, w_out, with_ctx_out):
    B, N, _ = h_lat.shape
    L = h_ctx.shape[1]
    rows_n = N // GRID_W
    kh = min(NA_KH, rows_n)
    q_l, k_l, v_l = jnp.split(h_lat @ w_qkv, 3, axis=-1)
    q_c, k_c, v_c = jnp.split(h_ctx @ w_qkv, 3, axis=-1)
    sc = NA_HEAD_DIM ** -0.5
    q_g = (q_l * sc).reshape(B, rows_n, GRID_W, NA_HEADS, NA_HEAD_DIM)
    k_g = k_l.reshape(B, rows_n, GRID_W, NA_HEADS, NA_HEAD_DIM)
    v_g = v_l.reshape(B, rows_n, GRID_W, NA_HEADS, NA_HEAD_DIM)
    k_c = k_c.reshape(B, L, NA_HEADS, NA_HEAD_DIM)
    v_c = v_c.reshape(B, L, NA_HEADS, NA_HEAD_DIM)

    cpos = np.arange(GRID_W)
    col_start = np.clip(cpos - NA_KW // 2, 0, GRID_W - NA_KW)
    col_idx = col_start[:, None] + np.arange(NA_KW)[None, :]
    dc_idx = col_idx - cpos[:, None] + (NA_KW - 1)
    rpb_c = rpb[:, :, dc_idx]

    def row_block(r):
        rs = jnp.clip(r - kh // 2, 0, rows_n - kh)
        q_r = lax.dynamic_index_in_dim(q_g, r, axis=1, keepdims=False)
        k_rows = lax.dynamic_slice_in_dim(k_g, rs, kh, axis=1)
        v_rows = lax.dynamic_slice_in_dim(v_g, rs, kh, axis=1)
        k_win = k_rows[:, :, col_idx]
        v_win = v_rows[:, :, col_idx]
        s_nb = jnp.einsum('bchd,bicjhd->bhcij', q_r, k_win).reshape(B, NA_HEADS, GRID_W, kh * NA_KW)
        dr_idx = rs + jnp.arange(kh) - r + (NA_KH - 1)
        bias = jnp.take(rpb_c, dr_idx, axis=1)
        bias = jnp.transpose(bias, (0, 2, 1, 3)).reshape(NA_HEADS, GRID_W, kh * NA_KW)
        s_nb = s_nb + bias[None]
        s_cx = jnp.einsum('bchd,blhd->bhcl', q_r, k_c)
        p = jax.nn.softmax(jnp.concatenate([s_nb, s_cx], axis=-1).astype(jnp.float32), axis=-1).astype(v_l.dtype)
        p_nb = p[..., :kh * NA_KW].reshape(B, NA_HEADS, GRID_W, kh, NA_KW)
        p_cx = p[..., kh * NA_KW:]
        return jnp.einsum('bhcij,bicjhd->bchd', p_nb, v_win) + jnp.einsum('bhcl,blhd->bchd', p_cx, v_c)

    o = lax.map(row_block, jnp.arange(rows_n))
    o_lat = jnp.transpose(o, (1, 0, 2, 3, 4)).reshape(B, N, D_MODEL) @ w_out
    if not with_ctx_out:
        return None, o_lat
    qc = (q_c * sc).reshape(B, L, NA_HEADS, NA_HEAD_DIM)
    s = jnp.einsum('blhd,bmhd->bhlm', qc, k_c)
    p = jax.nn.softmax(s.astype(jnp.float32), axis=-1).astype(v_c.dtype)
    o_ctx = jnp.einsum('bhlm,bmhd->blhd', p, v_c).reshape(B, L, D_MODEL) @ w_out
    return o_ctx, o_lat


def conv_ffn(h, w_in, conv_w, conv_b, w_out):
    a, val = jnp.split(h @ w_in, 2, axis=-1)
    ap = jnp.pad(a, ((0, 0), (1, 1), (0, 0)))
    a = ap[:, :-2] * conv_w[0] + ap[:, 1:-1] * conv_w[1] + ap[:, 2:] * conv_w[2] + conv_b
    return (jax.nn.silu(a) * val) @ w_out


def setup_inputs(seed: int = 0) -> dict:
    key = jax.random.key(seed)
    ks = jax.random.split(key, 24)
    n_gla = (DEPTH + N_MIXERS - 1) // N_MIXERS
    n_na = DEPTH // N_MIXERS
    D = D_MODEL

    def nrm(k, shape, scale):
        return jax.random.normal(k, shape, jnp.float32) * scale

    return {
        "x": nrm(ks[0], (BATCH, SEQ, D), 1.0),
        "c": nrm(ks[1], (BATCH, D), 1.0),
        "ctx": nrm(ks[2], (BATCH, CTX_LEN, D), 1.0),
        "c_ctx": nrm(ks[3], (D,), 1.0),
        "ada_w": nrm(ks[4], (DEPTH, D, 6 * D), 0.5 * D ** -0.5),
        "ada_b": nrm(ks[5], (DEPTH, 6 * D), 0.02),
        "norm1_g": 1.0 + nrm(ks[6], (DEPTH, D), 0.02),
        "norm2_g": 1.0 + nrm(ks[7], (DEPTH, D), 0.02),
        "ffn_w_in": nrm(ks[8], (DEPTH, D, 2 * D_FF), D ** -0.5),
        "ffn_conv_w": nrm(ks[9], (DEPTH, CONV_W, D_FF), CONV_W ** -0.5),
        "ffn_conv_b": nrm(ks[10], (DEPTH, D_FF), 0.02),
        "ffn_w_out": nrm(ks[11], (DEPTH, D_FF, D), D_FF ** -0.5),
        "gla_w_in": nrm(ks[12], (n_gla, D, 2 * GLA_DK + 2 * GLA_DV), D ** -0.5),
        "gla_a_w1": nrm(ks[13], (n_gla, 2, D, GLA_LOW_RANK), D ** -0.5),
        "gla_a_w2": nrm(ks[14], (n_gla, 2, GLA_LOW_RANK, GLA_DK), GLA_LOW_RANK ** -0.5),
        "gla_a_b": nrm(ks[15], (n_gla, 2, GLA_DK), 0.1),
        "gla_norm_g": 1.0 + nrm(ks[16], (n_gla, GLA_DV_HEAD), 0.02),
        "gla_w_out": nrm(ks[17], (n_gla, GLA_DV, D), GLA_DV ** -0.5),
        "na_w_qkv": nrm(ks[18], (n_na, D, 3 * D), D ** -0.5),
        "na_rpb": nrm(ks[19], (n_na, NA_HEADS, 2 * NA_KH - 1, 2 * NA_KW - 1), 0.1),
        "na_w_out": nrm(ks[20], (n_na, D, D), D ** -0.5),
        "final_g": 1.0 + nrm(ks[21], (D,), 0.02),
    }


def reference(x, c, ctx, c_ctx, ada_w, ada_b, norm1_g, norm2_g, ffn_w_in, ffn_conv_w, ffn_conv_b, ffn_w_out,
              gla_w_in, gla_a_w1, gla_a_w2, gla_a_b, gla_norm_g, gla_w_out, na_w_qkv, na_rpb, na_w_out, final_g):
    x_lat, x_ctx = x, ctx
    sc_lat = jax.nn.silu(c)
    sc_ctx = jax.nn.silu(c_ctx)
    for i in range(DEPTH):
        last = i == DEPTH - 1
        j = i // N_MIXERS
        mod_l = (sc_lat @ ada_w[i] + ada_b[i])[:, None, :]
        mod_c = sc_ctx @ ada_w[i] + ada_b[i]
        sh1_l, s1_l, g1_l, sh2_l, s2_l, g2_l = jnp.split(mod_l, 6, axis=-1)
        sh1_c, s1_c, g1_c, sh2_c, s2_c, g2_c = jnp.split(mod_c, 6, axis=-1)

        h_l = modulate(x_lat, norm1_g[i], sh1_l, s1_l)
        h_c = modulate(x_ctx, norm1_g[i], sh1_c, s1_c)
        if i % N_MIXERS == 0:
            o_c, o_l = gla_mixer(h_c, h_l, gla_w_in[j], gla_a_w1[j], gla_a_w2[j], gla_a_b[j],
                                 gla_norm_g[j], gla_w_out[j], not last)
        else:
            o_c, o_l = na_mixer(h_c, h_l, na_w_qkv[j], na_rpb[j], na_w_out[j], not last)
        x_lat = x_lat + g1_l * o_l

        h_l = modulate(x_lat, norm2_g[i], sh2_l, s2_l)
        x_lat = x_lat + g2_l * conv_ffn(h_l, ffn_w_in[i], ffn_conv_w[i], ffn_conv_b[i], ffn_w_out[i])

        if not last:
            x_ctx = x_ctx + g1_c * o_c
            h_c = modulate(x_ctx, norm2_g[i], sh2_c, s2_c)
            x_ctx = x_ctx + g2_c * conv_ffn(h_c, ffn_w_in[i], ffn_conv_w[i], ffn_conv_b[i], ffn_w_out[i])
    return rms_norm(x_lat, final_g)
```

```cpp
#include <hip/hip_runtime.h>
#include <hip/hip_bf16.h>
#include <hip/hip_fp16.h>
#include <cstdint>
#include <cstdio>

namespace {
constexpr int D = 1024, NB = 2, NSEQ = 8192, LCTX = 256, TB = LCTX + NSEQ  , T = NB * TB  ;
constexpr int DFF = 2816, GW = 64;
constexpr float EPS = 1e-6f;
typedef unsigned short bf16_t;

__device__ __forceinline__ float bf2f(bf16_t v) { return __uint_as_float(((unsigned)v) << 16); }
__device__ __forceinline__ bf16_t f2bf(float f) {
    unsigned u = __float_as_uint(f); u += 0x7fffu + ((u >> 16) & 1u); return (bf16_t)(u >> 16);
}
__device__ __forceinline__ float siluf(float x) { return x / (1.0f + expf(-x)); }
__device__ __forceinline__ float logsigmoidf(float x) { return fminf(x, 0.f) - log1pf(expf(-fabsf(x))); }

struct Ptrs {
    const float *x, *c, *ctx, *c_ctx, *ada_w, *ada_b, *norm1_g, *norm2_g, *ffn_w_in, *ffn_conv_w, *ffn_conv_b, *ffn_w_out;
    const float *gla_w_in, *gla_a_w1, *gla_a_w2, *gla_a_b, *gla_norm_g, *gla_w_out, *na_w_qkv, *na_rpb, *na_w_out, *final_g;
    float* xlat;
    float* xctx;
    float* mod;
    bf16_t* H;
    bf16_t* Y;
    float* QKraw;
    float* O;
    bf16_t *Q, *K;
    bf16_t *V, *R;
    __half* G;
    bf16_t* U;
    bf16_t *NQ, *NK, *NV, *NO;
};

__device__ __forceinline__ float* xrow(const Ptrs& P, int row) {
    const int b = row / TB, p = row % TB;
    return p < LCTX ? P.xctx + ((size_t)(b * LCTX + p)) * D : P.xlat + ((size_t)(b * NSEQ + (p - LCTX))) * D;
}
__device__ __forceinline__ int modrow(int row) { const int b = row / TB, p = row % TB; return p < LCTX ? 2 : b; }

__global__ void __launch_bounds__(256) k_mod(Ptrs P) {
    __shared__ float s[3][D];
    const int i = blockIdx.y, tid = threadIdx.x;
    for (int e = tid; e < 3 * D; e += 256) { const int r = e / D, k = e % D; const float v = r < 2 ? P.c[r * D + k] : P.c_ctx[k]; s[r][k] = siluf(v); }
    __syncthreads();
    const int n = blockIdx.x * 256 + tid;
    const float* w = P.ada_w + (size_t)i * D * 6 * D + n;
    float a0 = 0.f, a1 = 0.f, a2 = 0.f;
    for (int k = 0; k < D; ++k) { const float wv = w[(size_t)k * 6 * D]; a0 += s[0][k] * wv; a1 += s[1][k] * wv; a2 += s[2][k] * wv; }
    const float bb = P.ada_b[i * 6 * D + n];
    float* m = P.mod + (size_t)i * 3 * 6 * D;
    m[0 * 6 * D + n] = a0 + bb; m[1 * 6 * D + n] = a1 + bb; m[2 * 6 * D + n] = a2 + bb;
}

__global__ void __launch_bounds__(256) k_modulate(Ptrs P, int layer, int which  ) {
    __shared__ float red[4];
    const int row = blockIdx.x, tid = threadIdx.x;
    const float* x = xrow(P, row);
    const float4 v = *(const float4*)(x + tid * 4);
    float ss = v.x * v.x + v.y * v.y + v.z * v.z + v.w * v.w;
    for (int o = 32; o > 0; o >>= 1) ss += __shfl_xor(ss, o);
    if ((tid & 63) == 0) red[tid >> 6] = ss;
    __syncthreads();
    const float tot = red[0] + red[1] + red[2] + red[3];
    const float rs = rsqrtf(tot * (1.0f / D) + EPS);
    const float* g = (which == 0 ? P.norm1_g : P.norm2_g) + layer * D;
    const float* m = P.mod + ((size_t)layer * 3 + modrow(row)) * 6 * D;
    const float* sh = m + (which == 0 ? 0 : 3) * D; const float* sc = m + (which == 0 ? 1 : 4) * D;
    const float xv[4] = {v.x, v.y, v.z, v.w};
    bf16_t o[4];
    for (int j = 0; j < 4; ++j) { const int n = tid * 4 + j; const float y = xv[j] * rs * g[n]; o[j] = f2bf(y * (1.0f + sc[n]) + sh[n]); }
    *(uint2*)(P.H + (size_t)row * D + tid * 4) = make_uint2((unsigned)o[0] | ((unsigned)o[1] << 16), (unsigned)o[2] | ((unsigned)o[3] << 16));
}

struct EpiGlaIn { Ptrs P;
    __device__ __forceinline__ void operator()(int row, int col, const float (&a)[4]) const {
        if (col < 1024) { *(float4*)(P.QKraw + (size_t)row * 1024 + col) = make_float4(a[0], a[1], a[2], a[3]); }
        else { bf16_t* dst = (col < 2048 ? P.V + (size_t)row * 1024 + (col - 1024) : P.R + (size_t)row * 1024 + (col - 2048));
               *(uint2*)dst = make_uint2((unsigned)f2bf(a[0]) | ((unsigned)f2bf(a[1]) << 16), (unsigned)f2bf(a[2]) | ((unsigned)f2bf(a[3]) << 16)); }
    } };
struct EpiResid { Ptrs P; int layer; int gchunk  ; int skip_ctx; int pad;
    __device__ __forceinline__ void operator()(int row, int col, const float (&a)[4]) const {
        if (skip_ctx && (row % TB) < LCTX) return;
        float* x = xrow(P, row) + col; const float* g = P.mod + ((size_t)layer * 3 + modrow(row)) * 6 * D + gchunk * D + col;
        float4 v = *(float4*)x; v.x += g[0] * a[0]; v.y += g[1] * a[1]; v.z += g[2] * a[2]; v.w += g[3] * a[3]; *(float4*)x = v;
    } };
struct EpiNaQkv { Ptrs P;
    __device__ __forceinline__ void operator()(int row, int col, const float (&a)[4]) const {
        const int t = col >> 10, cc = col & 1023; const float s = t == 0 ? 0.125f : 1.0f;
        bf16_t* dst = (t == 0 ? P.NQ : t == 1 ? P.NK : P.NV) + (size_t)row * 1024 + cc;
        *(uint2*)dst = make_uint2((unsigned)f2bf(a[0] * s) | ((unsigned)f2bf(a[1] * s) << 16), (unsigned)f2bf(a[2] * s) | ((unsigned)f2bf(a[3] * s) << 16));
    } };

template <class Epi>
__global__ void __launch_bounds__(256) k_gemm(const bf16_t* __restrict__ A, int lda, const float* __restrict__ B, int ldb, int K, Epi epi) {
    __shared__ float As[16][68];
    __shared__ float Bs[16][68];
    const int tid = threadIdx.x, tx = tid & 15, ty = tid >> 4;
    const int m0 = blockIdx.y * 64, n0 = blockIdx.x * 64;
    float acc[4][4] = {};
    for (int k0 = 0; k0 < K; k0 += 16) {
        { const int r = tid >> 2, kc = (tid & 3) * 4; const uint2 w = *(const uint2*)(A + (size_t)(m0 + r) * lda + k0 + kc);
          As[kc + 0][r] = bf2f((bf16_t)(w.x & 0xffff)); As[kc + 1][r] = bf2f((bf16_t)(w.x >> 16)); As[kc + 2][r] = bf2f((bf16_t)(w.y & 0xffff)); As[kc + 3][r] = bf2f((bf16_t)(w.y >> 16)); }
        { const int kr = tid >> 4, nc = (tid & 15) * 4; const float4 w = *(const float4*)(B + (size_t)(k0 + kr) * ldb + n0 + nc); *(float4*)&Bs[kr][nc] = w; }
        __syncthreads();
#pragma unroll
        for (int kk = 0; kk < 16; ++kk) {
            const float4 a = *(const float4*)&As[kk][ty * 4]; const float4 b = *(const float4*)&Bs[kk][tx * 4];
            const float av[4] = {a.x, a.y, a.z, a.w}, bv[4] = {b.x, b.y, b.z, b.w};
#pragma unroll
            for (int i = 0; i < 4; ++i)
#pragma unroll
                for (int j = 0; j < 4; ++j) acc[i][j] += av[i] * bv[j];
        }
        __syncthreads();
    }
#pragma unroll
    for (int i = 0; i < 4; ++i) epi(m0 + ty * 4 + i, n0 + tx * 4, acc[i]);
}

__global__ void __launch_bounds__(256) k_rope(Ptrs P) {
    const int row = blockIdx.x, tid = threadIdx.x;
    const int p = row % TB;
    const float* src = P.QKraw + (size_t)row * 1024;
    for (int e = tid; e < 512; e += 256) {
        const int qk = e >> 8, rem = e & 255, head = rem >> 6, r2 = rem & 63, half = r2 >> 5, i = r2 & 31;
        const int base = qk * 512 + head * 128 + half * 64;
        float x1 = src[base + i], x2 = src[base + 32 + i];
        if (p >= LCTX) {
            const int pos = p - LCTX; const int pr = half == 0 ? pos / GW : pos % GW;
            const float inv = 1.0f / powf(10000.0f, (float)(2 * i) / 64.0f);
            const float ang = (float)pr * inv; const float cs = cosf(ang), sn = sinf(ang);
            const float y1 = x1 * cs - x2 * sn, y2 = x1 * sn + x2 * cs; x1 = y1; x2 = y2;
        }
        const float s = qk == 0 ? 0.08838834764831845f : 1.0f;
        bf16_t* dst = (qk == 0 ? P.Q : P.K) + (size_t)row * 512 + head * 128 + half * 64;
        dst[i] = f2bf(x1 * s); dst[32 + i] = f2bf(x2 * s);
    }
}

__global__ void __launch_bounds__(256) k_gate(Ptrs P) {
    __shared__ float part[8][32];
    __shared__ float hw[32];
    const int row = blockIdx.x, tid = threadIdx.x;
    const int j32 = tid & 31, kg = tid >> 5; const int dir = j32 >> 4, j = j32 & 15;
    const bf16_t* h = P.H + (size_t)row * D;
    const float* w1 = P.gla_a_w1 + (size_t)dir * D * 16 + j;
    float s = 0.f;
    for (int k = kg * 128; k < kg * 128 + 128; ++k) s += bf2f(h[k]) * w1[(size_t)k * 16];
    part[kg][j32] = s;
    __syncthreads();
    if (tid < 32) { float t = 0.f; for (int g = 0; g < 8; ++g) t += part[g][tid]; hw[tid] = t; }
    __syncthreads();
    for (int e = tid; e < 1024; e += 256) {
        const int d2 = e >> 9, c = e & 511;
        float xg = P.gla_a_b[d2 * 512 + c];
        for (int jj = 0; jj < 16; ++jj) xg += hw[d2 * 16 + jj] * P.gla_a_w2[((size_t)d2 * 16 + jj) * 512 + c];
        P.G[((size_t)d2 * T + row) * 512 + c] = __float2half(logsigmoidf(xg) * (1.0f / 16.0f));
    }
}

__global__ void __launch_bounds__(256) k_gla(Ptrs P) {
    __shared__ float red[2][16][17];
    const int tid = threadIdx.x, e = tid & 15, dg = tid >> 4;
    const int sl = blockIdx.x & 15, h = (blockIdx.x >> 4) & 3, b = blockIdx.x >> 6;
    const int vcol = h * 256 + sl * 16;
    for (int dir = 0; dir < 2; ++dir) {
        float S[8];
#pragma unroll
        for (int i = 0; i < 8; ++i) S[i] = 0.f;
        int par = 0;
        for (int seg = 0; seg < 2; ++seg) {
            const int n = seg == 0 ? LCTX : NSEQ; const int base = b * TB + (seg == 0 ? 0 : LCTX);
            for (int s = 0; s < n; ++s) {
                const int row = base + (dir == 0 ? s : n - 1 - s);
                const uint4 qw = *(const uint4*)(P.Q + (size_t)row * 512 + h * 128 + dg * 8);
                const uint4 kw = *(const uint4*)(P.K + (size_t)row * 512 + h * 128 + dg * 8);
                const uint4 gw = *(const uint4*)(P.G + ((size_t)dir * T + row) * 512 + h * 128 + dg * 8);
                const float v = bf2f(P.V[(size_t)row * 1024 + vcol + e]);
                const unsigned qa[4] = {qw.x, qw.y, qw.z, qw.w}, ka[4] = {kw.x, kw.y, kw.z, kw.w}, ga[4] = {gw.x, gw.y, gw.z, gw.w};
                float part = 0.f;
#pragma unroll
                for (int i = 0; i < 8; ++i) {
                    const float q = bf2f((bf16_t)((qa[i >> 1] >> ((i & 1) * 16)) & 0xffff));
                    const float k = bf2f((bf16_t)((ka[i >> 1] >> ((i & 1) * 16)) & 0xffff));
                    const float g = __half2float(__ushort_as_half((unsigned short)((ga[i >> 1] >> ((i & 1) * 16)) & 0xffff)));
                    S[i] = expf(g) * S[i] + k * v;
                    part += q * S[i];
                }
                red[par][dg][e] = part;
                __syncthreads();
                if (tid < 16) {
                    float o = 0.f;
#pragma unroll
                    for (int g2 = 0; g2 < 16; ++g2) o += red[par][g2][tid];
                    float* dst = P.O + (size_t)row * 1024 + vcol + tid;
                    if (dir == 0) *dst = o; else *dst += o;
                }
                par ^= 1;
            }
        }
        __syncthreads();
    }
}

__global__ void __launch_bounds__(256) k_gla_post(Ptrs P) {
    const int row = blockIdx.x, tid = threadIdx.x;
    const float4 v = *(const float4*)(P.O + (size_t)row * 1024 + tid * 4);
    float ss = v.x * v.x + v.y * v.y + v.z * v.z + v.w * v.w;
    for (int o = 32; o > 0; o >>= 1) ss += __shfl_xor(ss, o);
    const float rs = rsqrtf(ss * (1.0f / 256.0f) + EPS);
    const float ov[4] = {v.x, v.y, v.z, v.w};
    bf16_t out[4];
    for (int j = 0; j < 4; ++j) { const int n = tid * 4 + j; const float r = bf2f(P.R[(size_t)row * 1024 + n]);
        out[j] = f2bf(ov[j] * rs * P.gla_norm_g[n & 255] * siluf(r)); }
    *(uint2*)(P.Y + (size_t)row * D + tid * 4) = make_uint2((unsigned)out[0] | ((unsigned)out[1] << 16), (unsigned)out[2] | ((unsigned)out[3] << 16));
}

__global__ void __launch_bounds__(256) k_ffn_in(Ptrs P, int layer) {
    __shared__ float As[16][72];
    __shared__ float Ba[16][68];
    __shared__ float Bv[16][68];
    const int tid = threadIdx.x, tx = tid & 15, ty = tid >> 4;
    const int m0 = blockIdx.y * 64, n0 = blockIdx.x * 64;
    const int p0 = m0 % TB; const int sstart = p0 < LCTX ? 0 : LCTX, send = p0 < LCTX ? LCTX : TB;
    const bool has_prev = (p0 - 1) >= sstart, has_next = (p0 + 64) < send;
    const float* W = P.ffn_w_in + (size_t)layer * D * 2 * DFF;
    float aa[6][4] = {}, vv[4][4] = {};
    for (int k0 = 0; k0 < D; k0 += 16) {
        { const int r = tid >> 2, kc = (tid & 3) * 4; const uint2 w = *(const uint2*)(P.H + (size_t)(m0 + r) * D + k0 + kc);
          As[kc + 0][r + 1] = bf2f((bf16_t)(w.x & 0xffff)); As[kc + 1][r + 1] = bf2f((bf16_t)(w.x >> 16)); As[kc + 2][r + 1] = bf2f((bf16_t)(w.y & 0xffff)); As[kc + 3][r + 1] = bf2f((bf16_t)(w.y >> 16)); }
        if (tid < 32) { const int which = tid >> 4, kk = tid & 15;
            float v = 0.f;
            if (which == 0) { if (has_prev) v = bf2f(P.H[(size_t)(m0 - 1) * D + k0 + kk]); As[kk][0] = v; }
            else { if (has_next) v = bf2f(P.H[(size_t)(m0 + 64) * D + k0 + kk]); As[kk][65] = v; } }
        { const int kr = tid >> 4, nc = (tid & 15) * 4;
          *(float4*)&Ba[kr][nc] = *(const float4*)(W + (size_t)(k0 + kr) * 2 * DFF + n0 + nc);
          *(float4*)&Bv[kr][nc] = *(const float4*)(W + (size_t)(k0 + kr) * 2 * DFF + DFF + n0 + nc); }
        __syncthreads();
#pragma unroll
        for (int kk = 0; kk < 16; ++kk) {
            float av[6];
#pragma unroll
            for (int i = 0; i < 6; ++i) av[i] = As[kk][ty * 4 + i];
            const float4 b4 = *(const float4*)&Ba[kk][tx * 4]; const float4 v4 = *(const float4*)&Bv[kk][tx * 4];
            const float ba[4] = {b4.x, b4.y, b4.z, b4.w}, bv[4] = {v4.x, v4.y, v4.z, v4.w};
#pragma unroll
            for (int i = 0; i < 6; ++i)
#pragma unroll
                for (int j = 0; j < 4; ++j) aa[i][j] += av[i] * ba[j];
#pragma unroll
            for (int i = 0; i < 4; ++i)
#pragma unroll
                for (int j = 0; j < 4; ++j) vv[i][j] += av[i + 1] * bv[j];
        }
        __syncthreads();
    }
    const float* cw = P.ffn_conv_w + (size_t)layer * 3 * DFF; const float* cb = P.ffn_conv_b + (size_t)layer * DFF;
#pragma unroll
    for (int i = 0; i < 4; ++i) {
        const int row = m0 + ty * 4 + i; bf16_t o[4];
#pragma unroll
        for (int j = 0; j < 4; ++j) { const int f = n0 + tx * 4 + j;
            const float ac = aa[i][j] * cw[f] + aa[i + 1][j] * cw[DFF + f] + aa[i + 2][j] * cw[2 * DFF + f] + cb[f];
            o[j] = f2bf(siluf(ac) * vv[i][j]); }
        *(uint2*)(P.U + (size_t)row * DFF + n0 + tx * 4) = make_uint2((unsigned)o[0] | ((unsigned)o[1] << 16), (unsigned)o[2] | ((unsigned)o[3] << 16));
    }
}

__global__ void __launch_bounds__(128) k_na(Ptrs P) {
    __shared__ float q[64];
    __shared__ float pr[384];
    __shared__ int krow[384];
    __shared__ float red[2];
    const int tid = threadIdx.x; const int h = blockIdx.x & 15; const int tok = blockIdx.x >> 4;
    const int b = tok / NSEQ, pos = tok % NSEQ, r = pos / GW, c = pos % GW;
    const int row = b * TB + LCTX + pos;
    int rs = r - 4; rs = rs < 0 ? 0 : (rs > 120 ? 120 : rs);
    int cs = c - 8; cs = cs < 0 ? 0 : (cs > 48 ? 48 : cs);
    if (tid < 64) q[tid] = bf2f(P.NQ[(size_t)row * 1024 + h * 64 + tid]);
    __syncthreads();
    float sc[3]; float mx = -3.0e38f;
    for (int m = 0; m < 3; ++m) {
        const int idx = tid + 128 * m; int kr; float bias = 0.f;
        if (idx < 128) { const int i = idx >> 4, j = idx & 15; kr = b * TB + LCTX + (rs + i) * GW + (cs + j);
            bias = P.na_rpb[((size_t)h * 15 + (rs + i - r + 7)) * 31 + (cs + j - c + 15)]; }
        else kr = b * TB + (idx - 128);
        krow[idx] = kr;
        const bf16_t* kp = P.NK + (size_t)kr * 1024 + h * 64;
        float s = 0.f;
        for (int d = 0; d < 64; ++d) s += q[d] * bf2f(kp[d]);
        s += bias; sc[m] = s; mx = fmaxf(mx, s);
    }
    for (int o = 32; o > 0; o >>= 1) mx = fmaxf(mx, __shfl_xor(mx, o));
    if ((tid & 63) == 0) red[tid >> 6] = mx;
    __syncthreads();
    mx = fmaxf(red[0], red[1]);
    __syncthreads();
    float sum = 0.f;
    for (int m = 0; m < 3; ++m) { const float e = expf(sc[m] - mx); pr[tid + 128 * m] = e; sum += e; }
    for (int o = 32; o > 0; o >>= 1) sum += __shfl_xor(sum, o);
    if ((tid & 63) == 0) red[tid >> 6] = sum;
    __syncthreads();
    const float inv = 1.0f / (red[0] + red[1]);
    if (tid < 64) {
        float o = 0.f;
        for (int idx = 0; idx < 384; ++idx) o += pr[idx] * bf2f(P.NV[(size_t)krow[idx] * 1024 + h * 64 + tid]);
        P.NO[(size_t)row * 1024 + h * 64 + tid] = f2bf(o * inv);
    }
}

__global__ void __launch_bounds__(256) k_final(Ptrs P) {
    __shared__ float red[4];
    const int row = blockIdx.x, tid = threadIdx.x;
    float* x = P.xlat + (size_t)row * D;
    const float4 v = *(const float4*)(x + tid * 4);
    float ss = v.x * v.x + v.y * v.y + v.z * v.z + v.w * v.w;
    for (int o = 32; o > 0; o >>= 1) ss += __shfl_xor(ss, o);
    if ((tid & 63) == 0) red[tid >> 6] = ss;
    __syncthreads();
    const float rs = rsqrtf((red[0] + red[1] + red[2] + red[3]) * (1.0f / D) + EPS);
    const float4 g = *(const float4*)(P.final_g + tid * 4);
    *(float4*)(x + tid * 4) = make_float4(v.x * rs * g.x, v.y * rs * g.y, v.z * rs * g.z, v.w * rs * g.w);
}
}

extern "C" void kernel_launch(void* const* d_in, const int* in_sizes, int n_in, void* d_out, int out_size, void* d_ws, size_t ws_size, hipStream_t stream) {
    Ptrs P{};
    const float** f = (const float**)&P;
    for (int i = 0; i < 22; ++i) f[i] = (const float*)d_in[i];
    char* ws = (char*)d_ws; size_t off = 0;
    auto take = [&](size_t bytes) { char* p = ws + off; off += (bytes + 255) & ~(size_t)255; return p; };
    P.xlat = (float*)d_out;
    P.xctx = (float*)take((size_t)NB * LCTX * D * 4);
    P.mod = (float*)take((size_t)2 * 3 * 6 * D * 4);
    P.H = (bf16_t*)take((size_t)T * D * 2); P.Y = P.H;
    P.G = (__half*)take((size_t)2 * T * 512 * 2);
    P.QKraw = (float*)take((size_t)T * D * 4); P.O = P.QKraw;
    char* big = take((size_t)T * 3072 * 2);
    P.Q = (bf16_t*)big; P.K = P.Q + (size_t)T * 512; P.V = P.K + (size_t)T * 512; P.R = P.V + (size_t)T * 1024;
    P.U = (bf16_t*)big;
    P.NQ = (bf16_t*)big; P.NK = P.NQ + (size_t)T * 1024; P.NV = P.NK + (size_t)T * 1024;
    P.NO = P.H;
    if (off > ws_size) { fprintf(stderr, "workspace too small: need %zu have %zu\n", off, ws_size); return; }

    hipMemcpyAsync(P.xlat, P.x, (size_t)NB * NSEQ * D * 4, hipMemcpyDeviceToDevice, stream);
    hipMemcpyAsync(P.xctx, P.ctx, (size_t)NB * LCTX * D * 4, hipMemcpyDeviceToDevice, stream);
    k_mod<<<dim3(24, 2), 256, 0, stream>>>(P);
    k_modulate<<<T, 256, 0, stream>>>(P, 0, 0);
    k_gemm<EpiGlaIn><<<dim3(3072 / 64, T / 64), 256, 0, stream>>>(P.H, D, P.gla_w_in, 3072, D, EpiGlaIn{P});
    k_gate<<<T, 256, 0, stream>>>(P);
    k_rope<<<T, 256, 0, stream>>>(P);
    k_gla<<<128, 256, 0, stream>>>(P);
    k_gla_post<<<T, 256, 0, stream>>>(P);
    k_gemm<EpiResid><<<dim3(1024 / 64, T / 64), 256, 0, stream>>>(P.Y, D, P.gla_w_out, 1024, D, EpiResid{P, 0, 2, 0, 0});
    k_modulate<<<T, 256, 0, stream>>>(P, 0, 1);
    k_ffn_in<<<dim3(DFF / 64, T / 64), 256, 0, stream>>>(P, 0);
    k_gemm<EpiResid><<<dim3(1024 / 64, T / 64), 256, 0, stream>>>(P.U, DFF, P.ffn_w_out, 1024, DFF, EpiResid{P, 0, 5, 0, 0});
    k_modulate<<<T, 256, 0, stream>>>(P, 1, 0);
    k_gemm<EpiNaQkv><<<dim3(3072 / 64, T / 64), 256, 0, stream>>>(P.H, D, P.na_w_qkv, 3072, D, EpiNaQkv{P});
    k_na<<<NB * NSEQ * 16, 128, 0, stream>>>(P);
    k_gemm<EpiResid><<<dim3(1024 / 64, T / 64), 256, 0, stream>>>(P.NO, D, P.na_w_out, 1024, D, EpiResid{P, 1, 2, 1, 0});
    k_modulate<<<T, 256, 0, stream>>>(P, 1, 1);
    k_ffn_in<<<dim3(DFF / 64, T / 64), 256, 0, stream>>>(P, 1);
    k_gemm<EpiResid><<<dim3(1024 / 64, T / 64), 256, 0, stream>>>(P.U, DFF, P.ffn_w_out + (size_t)DFF * D, 1024, DFF, EpiResid{P, 1, 5, 1, 0});
    k_final<<<NB * NSEQ, 256, 0, stream>>>(P);
}
```

```cpp
#include <hip/hip_runtime.h>
#include <hip/hip_fp16.h>
#include <cstdint>
#include <cstdio>
#ifndef MK_HYBRID
#define MK_HYBRID 0
#endif
#ifndef GOLD_FFN_IN
#define GOLD_FFN_IN 0
#endif
#ifndef GOLD_FFN_OUT
#define GOLD_FFN_OUT 0
#endif
#ifndef GOLD_WOUT
#define GOLD_WOUT 0
#endif
#ifndef GOLD_GATE
#define GOLD_GATE 0
#endif
#ifndef GATE_NAIVE
#define GATE_NAIVE 0
#endif
#ifndef GATE_CHECK
#define GATE_CHECK 0
#endif
namespace pg8 {
#define PG8_LAS __attribute__((address_space(3)))
typedef unsigned short bf16_t;
typedef short bf16x8 __attribute__((ext_vector_type(8)));
typedef float f32x4 __attribute__((ext_vector_type(4)));
typedef unsigned u32x4 __attribute__((ext_vector_type(4)));
constexpr int BM = 256, BK = 64, HALF = 128, HTB = HALF * BK * 2  , STAGE_BYTES = 8 * HTB, NXCD = 8, WGM = 8;

__host__ __device__ __forceinline__ int lds_byte(int r, int c) { const int st = (r >> 4) * 2 + (c >> 5), rr = r & 15, cc = c & 31, ob = rr * 64 + cc * 2; return st * 1024 + (ob ^ (((ob >> 9) & 1) << 5)); }
__host__ __device__ __forceinline__ void stage_rc(int b, int& R, int& C) { const int st = b / 1024, sb = b % 1024, swz = sb ^ (((sb >> 9) & 1) << 5); R = (st >> 1) * 16 + swz / 64; C = (st & 1) * 32 + (swz % 64) / 2; }
__host__ __device__ __forceinline__ int perm32(int rho) { const int n = rho >> 4, i = rho & 15; return 8 * (i >> 2) + 4 * n + (i & 3); }

struct Unit { int pm, pn, arow; };
struct Gemm { const bf16_t* A; const bf16_t* Bt; int M, N, K; };

__device__ __forceinline__ unsigned cvt_pk_bf16(float lo, float hi) { unsigned r; asm volatile("v_cvt_pk_bf16_f32 %0, %1, %2" : "=v"(r) : "v"(lo), "v"(hi)); return r; }

template <class Epi, class Sched, bool ALIGN_EPI = false, bool SP2 = false>
__device__ __forceinline__ void gemm_phase(PG8_LAS unsigned char* lds, const Gemm g, const Sched& S, const Epi& E) {
    const int tid = threadIdx.x, wid = __builtin_amdgcn_readfirstlane(tid >> 6), lane = tid & 63, wr = wid >> 2, wc = wid & 3, fr = lane & 15, fq = lane >> 4;
    const int K = g.K, nt = K / BK;
    unsigned voffA[2], voffB[2];
#pragma unroll
    for (int i = 0; i < 2; ++i) { int R, C; stage_rc(tid * 16 + i * 8192, R, C); const int Rb = Epi::PERM ? ((R & ~31) + perm32(R & 31)) : R;
        voffA[i] = (unsigned)(R * K + C) * 2u; voffB[i] = (unsigned)(Rb * K + C) * 2u; }
    const size_t kstep = (size_t)(BK * 2);
    const size_t hstep = (size_t)HALF * K * 2;
    const size_t tstep = 2 * hstep;
    const unsigned ldsw = (unsigned)wid * 1024u;
    const int aoff = lds_byte(wr * 64 + fr, fq * 8), boff = lds_byte(wc * 32 + fr, fq * 8);
#define PG8_SA(b, h) (((b) * 2 + (h)) * HTB)
#define PG8_SB(b, h) ((4 + (b) * 2 + (h)) * HTB)
#define PG8_STAGE(bufoff, gbase, voff) do { _Pragma("unroll") for (int _i = 0; _i < 2; ++_i) \
        __builtin_amdgcn_global_load_lds((const unsigned*)((const char*)(gbase) + (voff)[_i]), (PG8_LAS unsigned*)(lds + (bufoff) + ldsw + _i * 8192), 16, 0, 0); } while (0)
#define PG8_LDA(dst, b, h) do { _Pragma("unroll") for (int m = 0; m < 4; ++m) _Pragma("unroll") for (int k = 0; k < 2; ++k) dst[m][k] = *(const PG8_LAS bf16x8*)(lds + PG8_SA(b, h) + aoff + m * 2048 + k * 1024); } while (0)
#define PG8_LDB(dst, b, h) do { _Pragma("unroll") for (int n = 0; n < 2; ++n) _Pragma("unroll") for (int k = 0; k < 2; ++k) dst[n][k] = *(const PG8_LAS bf16x8*)(lds + PG8_SB(b, h) + boff + n * 2048 + k * 1024); } while (0)
#define PG8_MMA(ai, bj, At, Bt) do { __builtin_amdgcn_s_setprio(1); _Pragma("unroll") for (int m = 0; m < 4; ++m) _Pragma("unroll") for (int n = 0; n < 2; ++n) _Pragma("unroll") for (int k = 0; k < 2; ++k) \
        acc[ai][bj][m][n] = __builtin_amdgcn_mfma_f32_16x16x32_bf16(Bt[n][k], At[m][k], acc[ai][bj][m][n], 0, 0, 0); __builtin_amdgcn_s_setprio(0); } while (0)
#define PG8_WAIT_V(n) asm volatile("s_waitcnt vmcnt(" #n ")" ::: "memory")
#define PG8_WAIT_L(n) asm volatile("s_waitcnt lgkmcnt(" #n ")" ::: "memory")
#define PG8_BAR __builtin_amdgcn_s_barrier()
#define PG8_SCHED __builtin_amdgcn_sched_barrier(0)
    Unit cur, nxt; int ui = 0;
    if (!S.next(0, cur)) return;
    f32x4 acc[2][2][4][2];
#pragma unroll
    for (int a = 0; a < 2; ++a)
#pragma unroll
        for (int b = 0; b < 2; ++b)
#pragma unroll
            for (int m = 0; m < 4; ++m)
#pragma unroll
                for (int n = 0; n < 2; ++n) acc[a][b][m][n] = (f32x4){0.f, 0.f, 0.f, 0.f};
    bf16x8 At[4][2], B0[2][2], B1[2][2];
    const char* cA = (const char*)g.A + (size_t)cur.arow * (size_t)(K * 2); const char* cB = (const char*)g.Bt + (size_t)cur.pn * tstep;
    S.a_ready(cur);
    if constexpr (SP2) {
        PG8_STAGE(PG8_SB(0, 0), cB, voffB); PG8_STAGE(PG8_SB(0, 1), cB + hstep, voffB); PG8_STAGE(PG8_SA(0, 0), cA, voffA); PG8_STAGE(PG8_SA(0, 1), cA + hstep, voffA);
        if (wr == 1) PG8_BAR;
        PG8_WAIT_V(2); PG8_BAR;
        PG8_STAGE(PG8_SB(1, 0), cB + kstep, voffB); PG8_STAGE(PG8_SA(1, 0), cA + kstep, voffA); PG8_STAGE(PG8_SB(1, 1), cB + hstep + kstep, voffB);
        PG8_WAIT_V(6); PG8_BAR;
    } else {
        PG8_STAGE(PG8_SB(0, 0), cB, voffB); PG8_STAGE(PG8_SA(0, 0), cA, voffA); PG8_STAGE(PG8_SB(0, 1), cB + hstep, voffB); PG8_STAGE(PG8_SA(0, 1), cA + hstep, voffA);
        if (wr == 1) PG8_BAR;
        PG8_WAIT_V(4); PG8_BAR;
        PG8_STAGE(PG8_SB(1, 0), cB + kstep, voffB); PG8_STAGE(PG8_SA(1, 0), cA + kstep, voffA); PG8_STAGE(PG8_SB(1, 1), cB + hstep + kstep, voffB);
        PG8_WAIT_V(6); PG8_BAR;
    }
    for (;;) {
        const bool has_next = S.next(ui + 1, nxt);
        const char* nA = has_next ? (const char*)g.A + (size_t)nxt.arow * (size_t)(K * 2) : cA; const char* nB = has_next ? (const char*)g.Bt + (size_t)nxt.pn * tstep : cB;
        for (int t = 0; t < nt; t += 2) {
            const bool last = (t == nt - 2);
            const char* a1 = cA + (size_t)(t + 1) * kstep;
            const char* a2 = last ? nA : cA + (size_t)(t + 2) * kstep; const char* b2 = last ? nB : cB + (size_t)(t + 2) * kstep;
            const char* a3 = a2 + kstep; const char* b3 = b2 + kstep;
            if (last && has_next) S.a_ready(nxt);
            if constexpr (SP2) {
            PG8_LDB(B0, 0, 0); PG8_LDB(B1, 0, 1); PG8_SCHED; PG8_LDA(At, 0, 0); PG8_STAGE(PG8_SA(1, 1), a1 + hstep, voffA);
            PG8_WAIT_V(8); PG8_WAIT_L(0); PG8_BAR; PG8_MMA(0, 0, At, B0); PG8_MMA(0, 1, At, B1); PG8_BAR; PG8_SCHED;
            PG8_LDA(At, 0, 1); PG8_STAGE(PG8_SB(0, 0), b2, voffB); PG8_STAGE(PG8_SB(0, 1), b2 + hstep, voffB); PG8_STAGE(PG8_SA(0, 0), a2, voffA);
            PG8_WAIT_V(8); PG8_WAIT_L(0); PG8_BAR; PG8_MMA(1, 0, At, B0); PG8_MMA(1, 1, At, B1); PG8_BAR; PG8_SCHED;
            PG8_LDB(B0, 1, 0); PG8_LDB(B1, 1, 1); PG8_SCHED; PG8_LDA(At, 1, 0); PG8_STAGE(PG8_SA(0, 1), a2 + hstep, voffA);
            PG8_WAIT_V(8); PG8_WAIT_L(0); PG8_BAR; PG8_MMA(0, 0, At, B0); PG8_MMA(0, 1, At, B1); PG8_BAR; PG8_SCHED;
            PG8_LDA(At, 1, 1); PG8_STAGE(PG8_SB(1, 0), b3, voffB); PG8_STAGE(PG8_SB(1, 1), b3 + hstep, voffB); PG8_STAGE(PG8_SA(1, 0), a3, voffA);
            PG8_WAIT_V(8); PG8_WAIT_L(0); PG8_BAR; PG8_MMA(1, 0, At, B0); PG8_MMA(1, 1, At, B1); PG8_BAR; PG8_SCHED;
            } else {
            PG8_LDB(B0, 0, 0); PG8_SCHED; PG8_LDA(At, 0, 0); PG8_STAGE(PG8_SA(1, 1), a1 + hstep, voffA);
            PG8_WAIT_L(8); PG8_BAR; PG8_WAIT_L(0); PG8_MMA(0, 0, At, B0); PG8_BAR; PG8_SCHED;
            PG8_LDB(B1, 0, 1); PG8_STAGE(PG8_SB(0, 0), b2, voffB);
            PG8_BAR; PG8_WAIT_L(0); PG8_MMA(0, 1, At, B1); PG8_BAR;
            PG8_LDA(At, 0, 1); PG8_STAGE(PG8_SA(0, 0), a2, voffA);
            PG8_BAR; PG8_WAIT_L(0); PG8_MMA(1, 0, At, B0); PG8_BAR; PG8_SCHED;
            PG8_STAGE(PG8_SB(0, 1), b2 + hstep, voffB);
            PG8_WAIT_V(6); PG8_BAR; PG8_MMA(1, 1, At, B1); PG8_BAR;
            PG8_LDB(B0, 1, 0); PG8_SCHED; PG8_LDA(At, 1, 0); PG8_STAGE(PG8_SA(0, 1), a2 + hstep, voffA);
            PG8_WAIT_L(8); PG8_BAR; PG8_WAIT_L(0); PG8_MMA(0, 0, At, B0); PG8_BAR; PG8_SCHED;
            PG8_LDB(B1, 1, 1); PG8_STAGE(PG8_SB(1, 0), b3, voffB);
            PG8_BAR; PG8_WAIT_L(0); PG8_MMA(0, 1, At, B1); PG8_BAR;
            PG8_LDA(At, 1, 1); PG8_STAGE(PG8_SA(1, 0), a3, voffA);
            PG8_BAR; PG8_WAIT_L(0); PG8_MMA(1, 0, At, B0); PG8_BAR; PG8_SCHED;
            PG8_STAGE(PG8_SB(1, 1), b3 + hstep, voffB);
            PG8_WAIT_V(6); PG8_BAR; PG8_MMA(1, 1, At, B1); PG8_BAR;
            }
        }
        if constexpr (ALIGN_EPI) { if (wr == 0) PG8_BAR; }
        if constexpr (!Epi::AFTER_DRAIN) { E(acc, cur, wr, wc, fr, fq); S.done(cur); }
        if (!has_next) break;
#pragma unroll
        for (int a = 0; a < 2; ++a)
#pragma unroll
            for (int b = 0; b < 2; ++b)
#pragma unroll
                for (int m = 0; m < 4; ++m)
#pragma unroll
                    for (int n = 0; n < 2; ++n) acc[a][b][m][n] = (f32x4){0.f, 0.f, 0.f, 0.f};
        cur = nxt; cA = nA; cB = nB; ++ui;
        if constexpr (ALIGN_EPI) { if (wr == 1) PG8_BAR; }
    }
    PG8_WAIT_V(0);
    if constexpr (!ALIGN_EPI) { if (wr == 0) PG8_BAR; }
    PG8_BAR;
    if constexpr (Epi::AFTER_DRAIN) { E.fused(acc, cur, wr, wc, fr, fq, lds, wid, lane); S.done(cur); }
#undef PG8_SA
#undef PG8_SB
#undef PG8_STAGE
#undef PG8_LDA
#undef PG8_LDB
#undef PG8_MMA
#undef PG8_WAIT_V
#undef PG8_WAIT_L
#undef PG8_BAR
#undef PG8_SCHED
}
}

#ifndef PG8_SP2
#define PG8_SP2 true
#endif
#ifndef PG8_ALIGN
#define PG8_ALIGN true
#endif

constexpr int NWAVES = 8, NTHR = 512;
constexpr int D = 1024, NB = 2, NSEQ = 8192, LCTX = 256, TB = LCTX + NSEQ  , T = NB * TB  ;
constexpr int DFF = 2816, GW = 64;
constexpr float EPS = 1e-6f;
constexpr float LOG2E = 1.4426950408889634f;

#define LAS __attribute__((address_space(3)))
#define GAS __attribute__((address_space(1)))
typedef unsigned short bf16;
typedef unsigned v4u __attribute__((ext_vector_type(4)));
typedef unsigned v2u __attribute__((ext_vector_type(2)));
typedef float f32x4 __attribute__((ext_vector_type(4)));
typedef _Float16 h2 __attribute__((ext_vector_type(2)));
typedef GAS unsigned gu32;
#define RLX_AGENT __ATOMIC_RELAXED, __HIP_MEMORY_SCOPE_AGENT
#define LDS_WAIT() asm volatile("s_waitcnt lgkmcnt(0)" ::: "memory")
#define VM_WAIT() asm volatile("s_waitcnt vmcnt(0)" ::: "memory")

constexpr size_t MiB = 1u << 20;
constexpr size_t WS_CTL = 0, CTL_ZERO_BYTES = 64 * 1024;
constexpr size_t WS_TAB = 1 * MiB;
constexpr size_t TAB_COS = 0, TAB_SIN = 16384, TAB_MOD = 32768;
constexpr size_t WS_XCTX = 2 * MiB;
constexpr size_t WS_OCTX = 4 * MiB;
constexpr size_t WS_WT = 6 * MiB;
constexpr size_t WT_GLA_IN = 0, WT_GLA_OUT = 6 * MiB, WT_FFN_IN0 = 8 * MiB, WT_FFN_IN1 = 19 * MiB, WT_FFN_OUT0 = 30 * MiB, WT_FFN_OUT1 = 30 * MiB + 5632 * 1024, WT_NA_QKV = 41 * MiB, WT_NA_OUT = 47 * MiB;
constexpr size_t WS_H = 55 * MiB;
constexpr size_t WS_G = WS_H + 33 * MiB + MiB / 2;
constexpr size_t WS_BIG = WS_G + 33 * MiB;
constexpr size_t WS_END = WS_BIG + 99 * MiB;
static_assert(WS_END <= 256 * MiB, "ws map");
constexpr int CW_BAR = 1024;

constexpr int RING_BYTES = 131072;
constexpr int EDGE_OFF = RING_BYTES;
constexpr int MISC_OFF = RING_BYTES + 8192;
constexpr int LDS_BYTES = 147456;

__device__ __forceinline__ unsigned f2bf(float f) { unsigned u = __builtin_bit_cast(unsigned, f); return (u + 0x7fffu + ((u >> 16) & 1u)) >> 16; }
__device__ __forceinline__ unsigned pk2(float lo, float hi) { return f2bf(lo) | (f2bf(hi) << 16); }
__device__ __forceinline__ float bf2f(unsigned v) { return __builtin_bit_cast(float, v << 16); }
__device__ __forceinline__ float wave_sum(float v) {
#pragma unroll
    for (int o = 1; o < 64; o <<= 1) v += __shfl_xor(v, o);
    return v;
}
__device__ __forceinline__ float fast_silu(float x) { return x * __builtin_amdgcn_rcpf(1.0f + __builtin_amdgcn_exp2f(-x * LOG2E)); }


__device__ __forceinline__ h2 as_h2(unsigned u) { return __builtin_bit_cast(h2, u); }
#ifndef USE_FDOT2
#define USE_FDOT2 1
#endif
__device__ __forceinline__ float dot2_impl(h2 a, h2 b, float c) {
#if USE_FDOT2
    return __builtin_amdgcn_fdot2(a, b, c, false);
#else
    return c + (float)a[0] * (float)b[0] + (float)a[1] * (float)b[1];
#endif
}
#define DOT2(a, b, c, cl) dot2_impl((a), (b), (c))

#define XB_TMO      128
#define XB_XCNT(j)  (256  + 64 * (j))
#define XB_XSUB(j)  (1280 + 64 * (j))
#define XB_XGEN(j)  (2304 + 64 * (j))
#define XB_TOP      3328
#define XB_TOPGEN   3392
#define XCD_BAR_WORDS 3456
#define XB_SPIN_CAP (1u << 23)
__device__ __forceinline__ unsigned xb_ld(unsigned* p)              { return __hip_atomic_load(p, __ATOMIC_RELAXED, __HIP_MEMORY_SCOPE_AGENT); }
__device__ __forceinline__ unsigned xb_add(unsigned* p, unsigned v) { return __hip_atomic_fetch_add(p, v, __ATOMIC_RELAXED, __HIP_MEMORY_SCOPE_AGENT); }
__device__ __forceinline__ unsigned xb_xcc_id() { return (unsigned)__builtin_amdgcn_s_getreg((3 << 11) | 20) & 0xFu; }
#define XB_SPIN(cond, bar) do { unsigned _sp = 0; while (cond) { __builtin_amdgcn_s_sleep(1); \
    if ((++_sp & 255u) == 0u) { if (xb_ld(&(bar)[XB_TMO])) break; if (_sp > XB_SPIN_CAP) { atomicAdd(&(bar)[XB_TMO], 1u); break; } } } } while (0)
struct XcdBarrier { unsigned* bar; unsigned x; volatile LAS unsigned* st; };
__device__ __forceinline__ XcdBarrier xcd_barrier_post(unsigned* bar, volatile LAS unsigned* st) {
    XcdBarrier b; b.bar = bar; b.x = xb_xcc_id(); b.st = st;
    if (threadIdx.x == 0) (void)xb_add(&bar[XB_XCNT(b.x)], 1u);
    return b;
}
__device__ __forceinline__ void xcd_barrier_complete(unsigned* bar, unsigned x, unsigned& nloc, unsigned& nx) {
    const unsigned G = gridDim.x * gridDim.y * gridDim.z;
    unsigned sum, cnt, mine, sp = 0u;
    for (;;) {
        sum = 0u; cnt = 0u; mine = 0u;
#pragma unroll
        for (unsigned j = 0; j < 16; ++j) { const unsigned c = xb_ld(&bar[XB_XCNT(j)]); sum += c; cnt += (c > 0u) ? 1u : 0u; mine = (j == x) ? c : mine; }
        if (sum == G) break;
        __builtin_amdgcn_s_sleep(1);
        if ((++sp & 255u) == 0u) { if (xb_ld(&bar[XB_TMO])) break; if (sp > XB_SPIN_CAP) { atomicAdd(&bar[XB_TMO], 1u); break; } }
    }
    nloc = mine > 0u ? mine : 1u; nx = cnt > 0u ? cnt : 1u;
}
__device__ __forceinline__ void xcd_barrier(const XcdBarrier& b) {
    asm volatile("s_waitcnt vmcnt(0)" ::: "memory");
    __syncthreads();
    if (threadIdx.x == 0) {
        unsigned* bar = b.bar;
        __builtin_amdgcn_s_waitcnt(0);
        unsigned nloc = b.st[0], nx = b.st[1];
        if (nloc == 0u) { xcd_barrier_complete(bar, b.x, nloc, nx); b.st[0] = nloc; b.st[1] = nx; }
        const unsigned old = xb_add(&bar[XB_XSUB(b.x)], 1u);
        const unsigned gen = old / nloc;
        if (old + 1u == (gen + 1u) * nloc) {
            __builtin_amdgcn_fence(__ATOMIC_RELEASE, "agent");
            asm volatile("s_waitcnt vmcnt(0)" ::: "memory");
            const unsigned og = xb_add(&bar[XB_TOP], 1u);
            const unsigned tg = og / nx;
            if (og + 1u == (tg + 1u) * nx) xb_add(&bar[XB_TOPGEN], 1u);
            else XB_SPIN(xb_ld(&bar[XB_TOPGEN]) == tg, bar);
            __builtin_amdgcn_fence(__ATOMIC_ACQUIRE, "agent");
            xb_add(&bar[XB_XGEN(b.x)], 1u);
            asm volatile("s_waitcnt vmcnt(0)" ::: "memory");
        } else {
            XB_SPIN(xb_ld(&bar[XB_XGEN(b.x)]) == gen, bar);
            __builtin_amdgcn_fence(__ATOMIC_ACQUIRE, "agent");
            asm volatile("s_waitcnt vmcnt(0)" ::: "memory");
        }
    }
    __syncthreads();
}

struct Args { const float* in[22]; float* out; unsigned char* ws; int ph_lo, ph_hi; };
enum { I_X = 0, I_C, I_CTX, I_CCTX, I_ADA_W, I_ADA_B, I_N1G, I_N2G, I_FFN_WIN, I_FFN_CW, I_FFN_CB, I_FFN_WOUT, I_GLA_WIN, I_GLA_AW1, I_GLA_AW2, I_GLA_AB, I_GLA_NG, I_GLA_WOUT, I_NA_WQKV, I_NA_RPB, I_NA_WOUT, I_FINAL_G };

struct Frame {
    LAS unsigned char* lds;
    int tid, lane, wave, G, bid;
    const float* const* in;
    float* xlat; float* xctx; float* octx;
    float *rcos, *rsin, *mod;
    bf16 *wt; bf16 *H; _Float16* Gt; bf16* BIG;
};
__device__ __forceinline__ float* xrow(const Frame& F, int row) { const int b = row / TB, p = row % TB; return p < LCTX ? F.xctx + (size_t)(b * LCTX + p) * D : F.xlat + (size_t)(b * NSEQ + p - LCTX) * D; }
__device__ __forceinline__ float* orow(const Frame& F, int row) { const int b = row / TB, p = row % TB; return p < LCTX ? F.octx + (size_t)(b * LCTX + p) * D : F.xlat + (size_t)(b * NSEQ + p - LCTX) * D; }
__device__ __forceinline__ const float* xinrow(const Frame& F, int row) { const int b = row / TB, p = row % TB; return p < LCTX ? F.in[I_CTX] + (size_t)(b * LCTX + p) * D : F.in[I_X] + (size_t)(b * NSEQ + p - LCTX) * D; }
__device__ __forceinline__ int modrow(int row) { const int b = row / TB, p = row % TB; return p < LCTX ? 2 : b; }
__device__ __forceinline__ int qk_src(int cl) { const int grp = cl >> 3, within = cl & 7, pi = grp * 4 + (within & 3), x2 = within >> 2; return (pi >> 5) * 64 + x2 * 32 + (pi & 31); }

namespace pg8 {
enum RowMap { RM_ALL66 = 0, RM_LAT64 = 1, RM_WIN68 = 2, RM_WIN66 = 3 };
struct Sched {
    int nM, nN, nwg, G, c, rm;
    __device__ __forceinline__ void init(int rm_, int N, int G_, int c_) { rm = rm_; nM = rm_ == RM_ALL66 ? 66 : rm_ == RM_LAT64 ? 64 : rm_ == RM_WIN68 ? 68 : 66; nN = N / BM; nwg = nM * nN; G = G_; c = c_; }
    __device__ __forceinline__ int rowmap(int pm) const {
        if (rm == RM_ALL66) return pm * 256;
        if (rm == RM_LAT64) return (pm >> 5) * TB + LCTX + (pm & 31) * 256;
        if (rm == RM_WIN68) { const int b = pm / 34, j = pm % 34; return b * TB + (j == 0 ? 0 : LCTX + 254 * (j - 1)); }
        { const int b = pm / 33, j = pm % 33; return b * TB + LCTX + 254 * j; }
    }
    __device__ __forceinline__ bool next(int i, Unit& u) const {
        const long L = (long)i * G + c; if (L >= nwg) return false;
        int wgid = (int)L; { const int q = nwg / NXCD, r = nwg % NXCD, xcd = wgid % NXCD, off = wgid / NXCD; wgid = (xcd < r ? xcd * (q + 1) : r * (q + 1) + (xcd - r) * q) + off; }
        const int nig = WGM * nN, gid = wgid / nig, fm = gid * WGM, gsz = (nM - fm) < WGM ? (nM - fm) : WGM;
        u.pm = fm + ((wgid % nig) % gsz); u.pn = (wgid % nig) / gsz; u.arow = rowmap(u.pm); return true;
    }
    __device__ __forceinline__ void a_ready(const Unit&) const {}
    __device__ __forceinline__ void done(const Unit&) const {}
};

__device__ __forceinline__ u32x4 pack8(const f32x4& a, const f32x4& b) { u32x4 w; w.x = cvt_pk_bf16(a[0], a[1]); w.y = cvt_pk_bf16(a[2], a[3]); w.z = cvt_pk_bf16(b[0], b[1]); w.w = cvt_pk_bf16(b[2], b[3]); return w; }

struct EpiGlaIn {
    static constexpr bool PERM = true, AFTER_DRAIN = false;
    bf16_t *Q, *K, *V, *R; const float *rcos, *rsin;
    __device__ __forceinline__ void operator()(const f32x4 (&acc)[2][2][4][2], const Unit& u, int wr, int wc, int fr, int fq) const {
        const int row0 = u.arow + wr * 64 + fr;
        if (u.pn >= 4) {
            bf16_t* base = u.pn < 8 ? V : R; const int col0 = ((u.pn & 3) * 256) + wc * 32 + 8 * fq;
#pragma unroll
            for (int ai = 0; ai < 2; ++ai)
#pragma unroll
                for (int m = 0; m < 4; ++m) { bf16_t* rowp = base + (size_t)(row0 + ai * HALF + m * 16) * 1024 + col0;
#pragma unroll
                    for (int bj = 0; bj < 2; ++bj) *(u32x4*)(rowp + bj * HALF) = pack8(acc[ai][bj][m][0], acc[ai][bj][m][1]); }
        } else {
            const bool isq = u.pn < 2; bf16_t* base = isq ? Q : K; const int col0 = (u.pn & 1) * 256 + wc * 32 + 8 * fq;
            const float sc = isq ? 0.08838834764831845f : 1.0f;
            const bool lat = (u.arow % TB) >= LCTX;
            const int half = wc >> 1, i0 = 16 * (wc & 1) + 4 * fq;
#pragma unroll
            for (int ai = 0; ai < 2; ++ai)
#pragma unroll
                for (int m = 0; m < 4; ++m) { const int row = row0 + ai * HALF + m * 16; bf16_t* rowp = base + (size_t)row * 512 + col0;
                    f32x4 cs = (f32x4){1.f, 1.f, 1.f, 1.f}, sn = (f32x4){0.f, 0.f, 0.f, 0.f};
                    if (lat) { const int pos = (row % TB) - LCTX; const int pr = half == 0 ? (pos >> 6) : (pos & 63); cs = *(const f32x4*)(rcos + pr * 32 + i0); sn = *(const f32x4*)(rsin + pr * 32 + i0); }
#pragma unroll
                    for (int bj = 0; bj < 2; ++bj) { const f32x4 x1 = acc[ai][bj][m][0], x2 = acc[ai][bj][m][1];
                        const f32x4 y1 = (x1 * cs - x2 * sn) * sc, y2 = (x1 * sn + x2 * cs) * sc;
                        *(u32x4*)(rowp + bj * HALF) = pack8(y1, y2); } }
        }
    }
};
struct EpiResid {
    static constexpr bool PERM = false, AFTER_DRAIN = false;
    const float *src_lat, *src_ctx; float *dst_lat, *dst_ctx; const float* gate;
    __device__ __forceinline__ void operator()(const f32x4 (&acc)[2][2][4][2], const Unit& u, int wr, int wc, int fr, int fq) const {
        const int b = u.arow / TB, p0 = u.arow % TB; const bool ctx = p0 < LCTX;
        const size_t rbase = ctx ? (size_t)b * LCTX : (size_t)b * NSEQ + (p0 - LCTX);
        const float* s = (ctx ? src_ctx : src_lat) + rbase * D; float* d = (ctx ? dst_ctx : dst_lat) + rbase * D;
        const float* g = gate + (ctx ? 2 : b) * 6144;
        const int col0 = u.pn * BM + wc * 32 + 4 * fq;
        f32x4 gv[2][2];
#pragma unroll
        for (int bj = 0; bj < 2; ++bj)
#pragma unroll
            for (int n = 0; n < 2; ++n) gv[bj][n] = *(const f32x4*)(g + col0 + bj * HALF + n * 16);
#pragma unroll
        for (int ai = 0; ai < 2; ++ai)
#pragma unroll
            for (int m = 0; m < 4; ++m) { const size_t off = (size_t)(ai * HALF + wr * 64 + m * 16 + fr) * D + col0;
#pragma unroll
                for (int bj = 0; bj < 2; ++bj)
#pragma unroll
                    for (int n = 0; n < 2; ++n) *(f32x4*)(d + off + bj * HALF + n * 16) = *(const f32x4*)(s + off + bj * HALF + n * 16) + gv[bj][n] * acc[ai][bj][m][n]; }
    }
};
struct EpiNaQkv {
    static constexpr bool PERM = true, AFTER_DRAIN = false;
    bf16_t* base;
    __device__ __forceinline__ void operator()(const f32x4 (&acc)[2][2][4][2], const Unit& u, int wr, int wc, int fr, int fq) const {
        const int t = u.pn >> 2; bf16_t* o = base + (size_t)t * T * 1024; const float sc = t == 0 ? 0.125f : 1.0f;
        const int row0 = u.arow + wr * 64 + fr, col0 = (u.pn & 3) * 256 + wc * 32 + 8 * fq;
#pragma unroll
        for (int ai = 0; ai < 2; ++ai)
#pragma unroll
            for (int m = 0; m < 4; ++m) { bf16_t* rowp = o + (size_t)(row0 + ai * HALF + m * 16) * 1024 + col0;
#pragma unroll
                for (int bj = 0; bj < 2; ++bj) *(u32x4*)(rowp + bj * HALF) = pack8(acc[ai][bj][m][0] * sc, acc[ai][bj][m][1] * sc); }
    }
};
__device__ __forceinline__ float dpp_ror1(float v) { return __builtin_bit_cast(float, __builtin_amdgcn_update_dpp(0, __builtin_bit_cast(int, v), 0x121, 0xf, 0xf, false)); }
__device__ __forceinline__ float dpp_rol1(float v) { return __builtin_bit_cast(float, __builtin_amdgcn_update_dpp(0, __builtin_bit_cast(int, v), 0x12F, 0xf, 0xf, false)); }
struct EpiFfnIn {
    static constexpr bool PERM = true, AFTER_DRAIN = false;
    bf16_t* U; const float *cw, *cb; PG8_LAS float* edge;
    __device__ __forceinline__ void operator()(f32x4 (&acc)[2][2][4][2], const Unit& u, int wr, int wc, int fr, int fq) const {
        const int b = u.arow / TB, p0 = u.arow % TB; const bool ctx = p0 < LCTX;
        const int seq_lo = b * TB + (ctx ? 0 : LCTX), seq_hi = b * TB + (ctx ? LCTX : TB);
        const int cl = wc * 32 + 8 * fq;
#pragma unroll
        for (int ai = 0; ai < 2; ++ai)
#pragma unroll
            for (int m = 0; m < 4; ++m) { const int row = u.arow + ai * HALF + wr * 64 + m * 16 + fr; const bool ok = row >= seq_lo && row < seq_hi;
                if (!ok) { acc[ai][0][m][0] = (f32x4){0.f, 0.f, 0.f, 0.f}; acc[ai][0][m][1] = (f32x4){0.f, 0.f, 0.f, 0.f}; } }
#pragma unroll
        for (int ai = 0; ai < 2; ++ai) { const int g = 2 * ai + wr;
            if (fr == 0) { *(PG8_LAS f32x4*)(edge + (2 * g) * 128 + cl) = acc[ai][0][0][0]; *(PG8_LAS f32x4*)(edge + (2 * g) * 128 + cl + 4) = acc[ai][0][0][1]; }
            if (fr == 15) { *(PG8_LAS f32x4*)(edge + (2 * g + 1) * 128 + cl) = acc[ai][0][3][0]; *(PG8_LAS f32x4*)(edge + (2 * g + 1) * 128 + cl + 4) = acc[ai][0][3][1]; } }
        asm volatile("s_waitcnt lgkmcnt(0)" ::: "memory"); __builtin_amdgcn_s_barrier(); asm volatile("" ::: "memory");
        const int f0 = u.pn * 128 + cl;
        f32x4 w0[2], w1[2], w2[2], bb[2];
#pragma unroll
        for (int n = 0; n < 2; ++n) { w0[n] = *(const f32x4*)(cw + f0 + 4 * n); w1[n] = *(const f32x4*)(cw + DFF + f0 + 4 * n); w2[n] = *(const f32x4*)(cw + 2 * DFF + f0 + 4 * n); bb[n] = *(const f32x4*)(cb + f0 + 4 * n); }
#pragma unroll
        for (int ai = 0; ai < 2; ++ai) { const int g = 2 * ai + wr;
            f32x4 ep[2], en[2];
#pragma unroll
            for (int n = 0; n < 2; ++n) { ep[n] = g > 0 ? *(const PG8_LAS f32x4*)(edge + (2 * (g - 1) + 1) * 128 + cl + 4 * n) : (f32x4){0.f, 0.f, 0.f, 0.f};
                                          en[n] = g < 3 ? *(const PG8_LAS f32x4*)(edge + (2 * (g + 1)) * 128 + cl + 4 * n) : (f32x4){0.f, 0.f, 0.f, 0.f}; }
#pragma unroll
            for (int m = 0; m < 4; ++m) { const int wrow = ai * HALF + wr * 64 + m * 16 + fr, row = u.arow + wrow;
                float o[8];
#pragma unroll
                for (int n = 0; n < 2; ++n)
#pragma unroll
                    for (int j = 0; j < 4; ++j) { const float cur = acc[ai][0][m][n][j];
                        const float sp = (m > 0 && fr == 15) ? acc[ai][0][m > 0 ? m - 1 : 0][n][j] : cur;
                        float pv = dpp_ror1(sp); if (m == 0) pv = fr == 0 ? ep[n][j] : pv;
                        const float sn = (m < 3 && fr == 0) ? acc[ai][0][m < 3 ? m + 1 : 3][n][j] : cur;
                        float nv = dpp_rol1(sn); if (m == 3) nv = fr == 15 ? en[n][j] : nv;
                        const float ac = pv * w0[n][j] + cur * w1[n][j] + nv * w2[n][j] + bb[n][j];
                        o[4 * n + j] = ac * __builtin_amdgcn_rcpf(1.0f + __builtin_amdgcn_exp2f(-ac * 1.4426950408889634f)) * acc[ai][1][m][n][j]; }
                const bool ok = row >= seq_lo && row < seq_hi && (wrow >= 1 || row == seq_lo) && (wrow <= 254 || row == seq_hi - 1);
                if (ok) { u32x4 w; w.x = cvt_pk_bf16(o[0], o[1]); w.y = cvt_pk_bf16(o[2], o[3]); w.z = cvt_pk_bf16(o[4], o[5]); w.w = cvt_pk_bf16(o[6], o[7]); *(u32x4*)(U + (size_t)row * DFF + f0) = w; } } }
    }
};
}

template <class CMap>
__device__ __forceinline__ void p0_transpose_item(const float* W, int K, int N, bf16* WT, LAS float* scr, int item, int lane, CMap cmap) {
    const int nblk = N / 32, kb = item / nblk, nb = item % nblk, k0 = 64 * kb, n0 = 32 * nb;
    const int srcc = cmap(n0 + (lane & 31));
#pragma unroll 8
    for (int i = 0; i < 32; ++i) { const int kk = 2 * i + (lane >> 5); scr[kk * 33 + (lane & 31)] = W[(size_t)(k0 + kk) * N + srcc]; }
    LDS_WAIT(); asm volatile("" ::: "memory");
    const int c = lane & 7;
#pragma unroll
    for (int j = 0; j < 4; ++j) { const int n = (lane >> 3) + 8 * j; const LAS float* s = scr + (8 * c) * 33 + n;
        v4u o; o.x = pk2(s[0 * 33], s[1 * 33]); o.y = pk2(s[2 * 33], s[3 * 33]); o.z = pk2(s[4 * 33], s[5 * 33]); o.w = pk2(s[6 * 33], s[7 * 33]);
        *(GAS v4u*)(WT + (size_t)(n0 + n) * K + k0 + 8 * c) = o; }
    LDS_WAIT(); asm volatile("" ::: "memory");
}
struct CmId { __device__ __forceinline__ int operator()(int c) const { return c; } };
struct CmGlaIn { __device__ __forceinline__ int operator()(int c) const { return c < 1024 ? (c & ~127) + qk_src(c & 127) : c; } };
struct CmFfnIn { __device__ __forceinline__ int operator()(int c) const { const int t = c >> 8, cl = c & 255; return cl < 128 ? 128 * t + cl : DFF + 128 * t + (cl - 128); } };

__device__ __forceinline__ void p0_prologue(Frame& F) {
    if (F.bid < 192) {
        LAS float* s = (LAS float*)F.lds;
        LAS float* part = (LAS float*)(F.lds + 12288);
        for (int e = F.tid; e < 3 * D; e += NTHR) { const int r = e / D, k = e % D; const float v = r < 2 ? F.in[I_C][r * D + k] : F.in[I_CCTX][k]; s[e] = v / (1.0f + expf(-v)); }
        __syncthreads();
        const int layer = F.bid / 96, n = (F.bid % 96) * 64 + (F.tid & 63), ks = F.tid >> 6;
        const float* w = F.in[I_ADA_W] + (size_t)layer * D * 6144 + n;
        float a0 = 0.f, a1 = 0.f, a2 = 0.f;
#pragma unroll 8
        for (int k = ks * 128; k < ks * 128 + 128; ++k) { const float wv = w[(size_t)k * 6144]; a0 += s[k] * wv; a1 += s[D + k] * wv; a2 += s[2 * D + k] * wv; }
        part[(ks * 3 + 0) * 64 + (F.tid & 63)] = a0; part[(ks * 3 + 1) * 64 + (F.tid & 63)] = a1; part[(ks * 3 + 2) * 64 + (F.tid & 63)] = a2;
        __syncthreads();
        if (F.tid < 192) { const int r = F.tid >> 6, cc = F.tid & 63; float t = 0.f;
#pragma unroll
            for (int q = 0; q < 8; ++q) t += part[(q * 3 + r) * 64 + cc];
            const int nn = (F.bid % 96) * 64 + cc;
            F.mod[((size_t)layer * 3 + r) * 6144 + nn] = t + F.in[I_ADA_B][layer * 6144 + nn]; }
        __syncthreads();
    } else if (F.bid < 200) {
        const int e = (F.bid - 192) * NTHR + F.tid; const int pos = e >> 5, i = e & 31;
        const float inv = 1.0f / powf(10000.0f, (float)(2 * i) / 64.0f); const float ang = (float)pos * inv;
        F.rcos[e] = cosf(ang); F.rsin[e] = sinf(ang);
    }
    LAS float* scr = (LAS float*)(F.lds + F.wave * 16384);
    const int gw = F.bid * NWAVES + F.wave, NGW = F.G * NWAVES;
    constexpr int I_GI = 16 * 96, I_GO = 16 * 32, I_FI = 16 * 176, I_FO = 44 * 32, I_NQ = 16 * 96, I_NO = 16 * 32;
    constexpr int NITEMS = I_GI + I_GO + 2 * I_FI + 2 * I_FO + I_NQ + I_NO;
    for (int it = gw; it < NITEMS; it += NGW) {
        int r = it;
        if (r < I_GI) { p0_transpose_item(F.in[I_GLA_WIN], D, 3072, (bf16*)((char*)F.wt + WT_GLA_IN), scr, r, F.lane, CmGlaIn{}); continue; } r -= I_GI;
        if (r < I_GO) { p0_transpose_item(F.in[I_GLA_WOUT], D, 1024, (bf16*)((char*)F.wt + WT_GLA_OUT), scr, r, F.lane, CmId{}); continue; } r -= I_GO;
        if (r < I_FI) { p0_transpose_item(F.in[I_FFN_WIN], D, 5632, (bf16*)((char*)F.wt + WT_FFN_IN0), scr, r, F.lane, CmFfnIn{}); continue; } r -= I_FI;
        if (r < I_FI) { p0_transpose_item(F.in[I_FFN_WIN] + (size_t)D * 5632, D, 5632, (bf16*)((char*)F.wt + WT_FFN_IN1), scr, r, F.lane, CmFfnIn{}); continue; } r -= I_FI;
        if (r < I_FO) { p0_transpose_item(F.in[I_FFN_WOUT], DFF, 1024, (bf16*)((char*)F.wt + WT_FFN_OUT0), scr, r, F.lane, CmId{}); continue; } r -= I_FO;
        if (r < I_FO) { p0_transpose_item(F.in[I_FFN_WOUT] + (size_t)DFF * 1024, DFF, 1024, (bf16*)((char*)F.wt + WT_FFN_OUT1), scr, r, F.lane, CmId{}); continue; } r -= I_FO;
        if (r < I_NQ) { p0_transpose_item(F.in[I_NA_WQKV], D, 3072, (bf16*)((char*)F.wt + WT_NA_QKV), scr, r, F.lane, CmId{}); continue; } r -= I_NQ;
        p0_transpose_item(F.in[I_NA_WOUT], D, 1024, (bf16*)((char*)F.wt + WT_NA_OUT), scr, r, F.lane, CmId{});
    }
}

template <bool GATE, bool FROM_INPUT>
__device__ __forceinline__ void modulate_phase(Frame& F, int layer, int which) {
    LAS _Float16* W1p = (LAS _Float16*)F.lds;
    LAS unsigned* W2p = (LAS unsigned*)(F.lds + 65536);
    LAS float* B2 = (LAS float*)(F.lds + 65536 + 32768);
    LAS _Float16* hrow = (LAS _Float16*)(F.lds + 65536 + 32768 + 4096) + F.wave * 1024;
    if (GATE) {
        const float* w1 = F.in[I_GLA_AW1];
        for (int s = F.tid; s < 32768; s += NTHR) { const int dir = s >> 14, k = (s >> 4) & 1023, j = s & 15; W1p[((k >> 3) * 32 + dir * 16 + j) * 8 + (k & 7)] = (_Float16)w1[s]; }
        const float* w2 = F.in[I_GLA_AW2];
        for (int s = F.tid; s < 8192; s += NTHR) { const int djp = s >> 9, c = s & 511, dir = djp >> 3, jp = djp & 7; const int oc = (c & ~127) + qk_src(c & 127);
            const h2 pr = (h2){(_Float16)w2[(dir * 16 + 2 * jp) * 512 + oc], (_Float16)w2[(dir * 16 + 2 * jp + 1) * 512 + oc]}; W2p[s] = __builtin_bit_cast(unsigned, pr); }
        for (int s = F.tid; s < 1024; s += NTHR) { const int dir = s >> 9, c = s & 511; B2[s] = F.in[I_GLA_AB][dir * 512 + (c & ~127) + qk_src(c & 127)]; }
        __syncthreads();
#if GATE_CHECK
        { unsigned bad = 0;
          for (int s = F.tid; s < 32768; s += NTHR) { const int dir = s >> 14, k = (s >> 4) & 1023, j = s & 15; const float got = (float)W1p[((k >> 3) * 32 + dir * 16 + j) * 8 + (k & 7)]; bad += fabsf(got - w1[s]) > 1e-3f; }
          if (bad) atomicAdd((unsigned*)((char*)F.wt - WS_WT + WS_CTL + 32768) + 4, bad); }
        __syncthreads();
#endif
    }
    const float* gn = F.in[which == 0 ? I_N1G : I_N2G] + layer * D;
    const int gw = F.bid * NWAVES + F.wave, NGW = F.G * NWAVES;
    for (int row = gw; row < T; row += NGW) {
        const float* x = FROM_INPUT ? xinrow(F, row) : (const float*)xrow(F, row);
        const float* m = F.mod + ((size_t)layer * 3 + modrow(row)) * 6144;
        const float* sh = m + (which == 0 ? 0 : 3) * D; const float* sc = m + (which == 0 ? 1 : 4) * D;
        f32x4 v[4]; float ss = 0.f;
#pragma unroll
        for (int j = 0; j < 4; ++j) { v[j] = *(const f32x4*)(x + F.lane * 4 + 256 * j); ss += (v[j][0] * v[j][0] + v[j][1] * v[j][1]) + (v[j][2] * v[j][2] + v[j][3] * v[j][3]); }
        const float rs = rsqrtf(wave_sum(ss) * (1.0f / D) + EPS);
#pragma unroll
        for (int j = 0; j < 4; ++j) { const int n = F.lane * 4 + 256 * j; const f32x4 g4 = *(const f32x4*)(gn + n), s4 = *(const f32x4*)(sc + n), h4 = *(const f32x4*)(sh + n);
            v[j] = (v[j] * rs * g4) * (s4 + 1.0f) + h4;
            v2u w; w.x = pk2(v[j][0], v[j][1]); w.y = pk2(v[j][2], v[j][3]); *(v2u*)(F.H + (size_t)row * D + n) = w;
            if (GATE) { const h2 a = (h2){(_Float16)v[j][0], (_Float16)v[j][1]}, b = (h2){(_Float16)v[j][2], (_Float16)v[j][3]};
                v2u hw2; hw2.x = __builtin_bit_cast(unsigned, a); hw2.y = __builtin_bit_cast(unsigned, b); *(LAS v2u*)(hrow + n) = hw2; } }
        if (GATE) {
            LDS_WAIT(); asm volatile("" ::: "memory");
#if GATE_CHECK == 2
            { unsigned bad = 0; const int ol = (F.lane + 1) & 63;
              for (int j = 0; j < 4; ++j) for (int t = 0; t < 4; ++t) { const float want = __shfl(v[j][t], ol); const float got = (float)hrow[ol * 4 + 256 * j + t]; bad += fabsf(got - want) > 0.01f + 0.01f * fabsf(want); }
              if (bad) atomicAdd((unsigned*)((char*)F.wt - WS_WT + WS_CTL + 32768) + 4, bad); }
#endif
            const int mo = F.lane & 31, kh = F.lane >> 5;
            float a0 = 0.f, a1 = 0.f;
#pragma unroll 8
            for (int i = 0; i < 64; ++i) { const int k8 = kh * 64 + i;
                const v4u hv = *(const LAS v4u*)(hrow + k8 * 8); const v4u wv = *(const LAS v4u*)(W1p + (k8 * 32 + mo) * 8);
                a0 = DOT2(as_h2(hv.x), as_h2(wv.x), a0, false); a1 = DOT2(as_h2(hv.y), as_h2(wv.y), a1, false);
                a0 = DOT2(as_h2(hv.z), as_h2(wv.z), a0, false); a1 = DOT2(as_h2(hv.w), as_h2(wv.w), a1, false); }
            float hsum = a0 + a1; hsum += __shfl_xor(hsum, 32);
#if GATE_NAIVE
            { float mine = 0.f;
              for (int mm = 0; mm < 32; ++mm) { float p = 0.f; const float* wq = F.in[I_GLA_AW1] + (size_t)(mm >> 4) * D * 16 + (mm & 15);
                  for (int j = 0; j < 4; ++j) for (int t = 0; t < 4; ++t) p += v[j][t] * wq[(size_t)(F.lane * 4 + 256 * j + t) * 16];
                  p = wave_sum(p); if (mo == mm) mine = p; }
              hsum = mine; }
#endif
#if MK_HYBRID
            if (F.lane < 32) ((float*)F.BIG)[(size_t)row * 32 + F.lane] = hsum;
#endif
            unsigned hwp[16];
#pragma unroll
            for (int q = 0; q < 16; ++q) { const float e0 = __builtin_bit_cast(float, __builtin_amdgcn_readlane(__builtin_bit_cast(int, hsum), 2 * q)), e1 = __builtin_bit_cast(float, __builtin_amdgcn_readlane(__builtin_bit_cast(int, hsum), 2 * q + 1));
                hwp[q] = __builtin_bit_cast(unsigned, (h2){(_Float16)e0, (_Float16)e1}); }
#pragma unroll
            for (int grp = 0; grp < 4; ++grp) { const int dir = grp >> 1, c4 = F.lane * 4 + 256 * (grp & 1);
                f32x4 xg = *(const LAS f32x4*)(B2 + dir * 512 + c4);
#pragma unroll
                for (int jp = 0; jp < 8; ++jp) { const v4u wv = *(const LAS v4u*)(W2p + (dir * 8 + jp) * 512 + c4); const h2 hp = as_h2(hwp[dir * 8 + jp]);
                    xg[0] = DOT2(hp, as_h2(wv.x), xg[0], false); xg[1] = DOT2(hp, as_h2(wv.y), xg[1], false);
                    xg[2] = DOT2(hp, as_h2(wv.z), xg[2], false); xg[3] = DOT2(hp, as_h2(wv.w), xg[3], false); }
                _Float16 o[4];
#pragma unroll
                for (int t = 0; t < 4; ++t) { const float xv = xg[t]; const float tt = __builtin_amdgcn_exp2f(-fabsf(xv) * LOG2E);
                    o[t] = (_Float16)((fminf(xv, 0.f) * LOG2E - __builtin_amdgcn_logf(1.0f + tt)) * (1.0f / 16.0f)); }
                v2u w; w.x = (unsigned)__builtin_bit_cast(unsigned short, o[0]) | ((unsigned)__builtin_bit_cast(unsigned short, o[1]) << 16); w.y = (unsigned)__builtin_bit_cast(unsigned short, o[2]) | ((unsigned)__builtin_bit_cast(unsigned short, o[3]) << 16);
                *(v2u*)(F.Gt + ((size_t)dir * T + row) * 512 + c4) = w; }
            LDS_WAIT(); asm volatile("" ::: "memory");
        }
    }
}

__device__ __forceinline__ void gla_golden_phase(Frame& F) {
    if (F.bid >= 128) return;
    LAS float* red = (LAS float*)F.lds;
    const int tid = F.tid, e = tid & 15, dg = tid >> 4;
    const int sl = F.bid & 15, h = (F.bid >> 4) & 3, b = F.bid >> 6;
    const int vcol = h * 256 + sl * 16;
    const bf16* Q = F.BIG; const bf16* K = Q + (size_t)T * 512; const bf16* V = K + (size_t)T * 512;
    for (int dir = 0; dir < 2; ++dir) {
        float S[4] = {0.f, 0.f, 0.f, 0.f};
        int par = 0;
        for (int seg = 0; seg < 2; ++seg) {
            const int n = seg == 0 ? LCTX : NSEQ; const int base = b * TB + (seg == 0 ? 0 : LCTX);
            for (int s = 0; s < n; ++s) {
                const int row = base + (dir == 0 ? s : n - 1 - s);
                const v2u qw = *(const v2u*)(Q + (size_t)row * 512 + h * 128 + dg * 4);
                const v2u kw = *(const v2u*)(K + (size_t)row * 512 + h * 128 + dg * 4);
                const v2u gw = *(const v2u*)(F.Gt + ((size_t)dir * T + row) * 512 + h * 128 + dg * 4);
                const float v = bf2f(V[(size_t)row * 1024 + vcol + e]);
                const unsigned qa[2] = {qw.x, qw.y}, ka[2] = {kw.x, kw.y}, ga[2] = {gw.x, gw.y};
                float part = 0.f;
#pragma unroll
                for (int i = 0; i < 4; ++i) {
                    const float q = bf2f((qa[i >> 1] >> ((i & 1) * 16)) & 0xffffu), k = bf2f((ka[i >> 1] >> ((i & 1) * 16)) & 0xffffu);
                    const float g = (float)__builtin_bit_cast(_Float16, (unsigned short)((ga[i >> 1] >> ((i & 1) * 16)) & 0xffffu));
                    S[i] = __builtin_amdgcn_exp2f(g) * S[i] + k * v; part += q * S[i];
                }
                red[(par * 32 + dg) * 17 + e] = part;
                __syncthreads();
                if (tid < 16) { float o = 0.f;
#pragma unroll
                    for (int g2 = 0; g2 < 32; ++g2) o += red[(par * 32 + g2) * 17 + tid];
                    float* dst = orow(F, row) + vcol + tid;
                    if (dir == 0) *dst = o; else *dst += o; }
                par ^= 1;
            }
        }
        __syncthreads();
    }
}
__device__ __forceinline__ void gla_post_phase(Frame& F) {
    const bf16* R = F.BIG + (size_t)T * 2048;
    const float* ng = F.in[I_GLA_NG];
    const int gw = F.bid * NWAVES + F.wave, NGW = F.G * NWAVES;
    for (int row = gw; row < T; row += NGW) {
        const float* o = orow(F, row);
#pragma unroll
        for (int j = 0; j < 4; ++j) { const f32x4 v = *(const f32x4*)(o + F.lane * 4 + 256 * j);
            const float rs = rsqrtf(wave_sum((v[0] * v[0] + v[1] * v[1]) + (v[2] * v[2] + v[3] * v[3])) * (1.0f / 256.0f) + EPS);
            const f32x4 g4 = *(const f32x4*)(ng + F.lane * 4); const v2u rw = *(const v2u*)(R + (size_t)row * 1024 + F.lane * 4 + 256 * j);
            const float r0 = bf2f(rw.x & 0xffffu), r1 = bf2f(rw.x >> 16), r2 = bf2f(rw.y & 0xffffu), r3 = bf2f(rw.y >> 16);
            v2u w; w.x = pk2(v[0] * rs * g4[0] * fast_silu(r0), v[1] * rs * g4[1] * fast_silu(r1)); w.y = pk2(v[2] * rs * g4[2] * fast_silu(r2), v[3] * rs * g4[3] * fast_silu(r3));
            *(v2u*)(F.H + (size_t)row * D + F.lane * 4 + 256 * j) = w; }
    }
}
__device__ __forceinline__ void na_golden_phase(Frame& F) {
    const int grp = F.tid >> 7, t = F.tid & 127;
    LAS float* q = (LAS float*)F.lds + grp * 1024;
    LAS float* pr = q + 64;
    LAS int* krow = (LAS int*)(q + 448);
    LAS float* red = q + 832;
    const bf16* NQ = F.BIG; const bf16* NK = NQ + (size_t)T * 1024; const bf16* NV = NK + (size_t)T * 1024;
    const float* rpb = F.in[I_NA_RPB];
    const int nitems = NB * NSEQ * 16, stride = F.G * 4;
    for (int it0 = F.bid * 4; it0 < nitems; it0 += stride) {
        const int item = it0 + grp; const bool act = item < nitems;
        const int h = item & 15, tok = act ? item >> 4 : 0;
        const int b = tok / NSEQ, pos = tok % NSEQ, r = pos / GW, c = pos % GW, row = b * TB + LCTX + pos;
        int rs = r - 4; rs = rs < 0 ? 0 : (rs > 120 ? 120 : rs);
        int cs = c - 8; cs = cs < 0 ? 0 : (cs > 48 ? 48 : cs);
        if (t < 64) q[t] = bf2f(NQ[(size_t)row * 1024 + h * 64 + t]);
        __syncthreads();
        float sc[3]; float mx = -3.0e38f;
        for (int m = 0; m < 3; ++m) {
            const int idx = t + 128 * m; int kr; float bias = 0.f;
            if (idx < 128) { const int i = idx >> 4, j = idx & 15; kr = b * TB + LCTX + (rs + i) * GW + (cs + j); bias = rpb[((size_t)h * 15 + (rs + i - r + 7)) * 31 + (cs + j - c + 15)]; }
            else kr = b * TB + (idx - 128);
            krow[idx] = kr;
            const bf16* kp = NK + (size_t)kr * 1024 + h * 64;
            float s = 0.f;
            for (int d8 = 0; d8 < 8; ++d8) { const v4u w = *(const v4u*)(kp + d8 * 8);
                s += q[d8 * 8 + 0] * bf2f(w.x & 0xffffu) + q[d8 * 8 + 1] * bf2f(w.x >> 16) + q[d8 * 8 + 2] * bf2f(w.y & 0xffffu) + q[d8 * 8 + 3] * bf2f(w.y >> 16)
                   + q[d8 * 8 + 4] * bf2f(w.z & 0xffffu) + q[d8 * 8 + 5] * bf2f(w.z >> 16) + q[d8 * 8 + 6] * bf2f(w.w & 0xffffu) + q[d8 * 8 + 7] * bf2f(w.w >> 16); }
            s += bias; sc[m] = s; mx = fmaxf(mx, s);
        }
        for (int o = 32; o > 0; o >>= 1) mx = fmaxf(mx, __shfl_xor(mx, o));
        if ((t & 63) == 0) red[t >> 6] = mx;
        __syncthreads();
        mx = fmaxf(red[0], red[1]);
        __syncthreads();
        float sum = 0.f;
        for (int m = 0; m < 3; ++m) { const float e = __builtin_amdgcn_exp2f((sc[m] - mx) * LOG2E); pr[t + 128 * m] = e; sum += e; }
        for (int o = 32; o > 0; o >>= 1) sum += __shfl_xor(sum, o);
        if ((t & 63) == 0) red[t >> 6] = sum;
        __syncthreads();
        const float inv = 1.0f / (red[0] + red[1]);
        if (t < 64 && act) { float o = 0.f;
            for (int idx = 0; idx < 384; ++idx) o += pr[idx] * bf2f(NV[(size_t)krow[idx] * 1024 + h * 64 + t]);
            F.H[(size_t)row * 1024 + h * 64 + t] = (bf16)f2bf(o * inv); }
        __syncthreads();
    }
}
__device__ __forceinline__ void final_phase(Frame& F) {
    const float* fg = F.in[I_FINAL_G];
    const int gw = F.bid * NWAVES + F.wave, NGW = F.G * NWAVES;
    for (int row = gw; row < NB * NSEQ; row += NGW) {
        float* x = F.xlat + (size_t)row * D;
        f32x4 v[4]; float ss = 0.f;
#pragma unroll
        for (int j = 0; j < 4; ++j) { v[j] = *(const f32x4*)(x + F.lane * 4 + 256 * j); ss += (v[j][0] * v[j][0] + v[j][1] * v[j][1]) + (v[j][2] * v[j][2] + v[j][3] * v[j][3]); }
        const float rs = rsqrtf(wave_sum(ss) * (1.0f / D) + EPS);
#pragma unroll
        for (int j = 0; j < 4; ++j) *(f32x4*)(x + F.lane * 4 + 256 * j) = v[j] * rs * *(const f32x4*)(fg + F.lane * 4 + 256 * j);
    }
}

constexpr int NPHASE = 17;
__global__ void __launch_bounds__(NTHR, 2) mega_fwd(Args args) {
    extern __shared__ __attribute__((aligned(16))) unsigned char lds[];
    Frame F;
    F.lds = (LAS unsigned char*)lds;
    F.tid = threadIdx.x; F.lane = F.tid & 63; F.wave = __builtin_amdgcn_readfirstlane(F.tid >> 6);
    F.G = gridDim.x; F.bid = blockIdx.x;
    F.in = args.in; F.xlat = args.out;
    unsigned char* ws = args.ws;
    F.xctx = (float*)(ws + WS_XCTX); F.octx = (float*)(ws + WS_OCTX);
    F.rcos = (float*)(ws + WS_TAB + TAB_COS); F.rsin = (float*)(ws + WS_TAB + TAB_SIN); F.mod = (float*)(ws + WS_TAB + TAB_MOD);
    F.wt = (bf16*)(ws + WS_WT); F.H = (bf16*)(ws + WS_H); F.Gt = (_Float16*)(ws + WS_G); F.BIG = (bf16*)(ws + WS_BIG);
    volatile LAS unsigned* MISC = (volatile LAS unsigned*)(F.lds + MISC_OFF);
    for (int u = F.tid; u < (LDS_BYTES - MISC_OFF) / 4; u += NTHR) ((LAS unsigned*)(F.lds + MISC_OFF))[u] = 0u;
    __syncthreads();
    const int lo = args.ph_lo, hi = args.ph_hi;
    const bool multi = (hi - lo) > 1;
    XcdBarrier bar; bar.bar = (unsigned*)(ws + WS_CTL) + CW_BAR; bar.x = 0; bar.st = nullptr;
    if (multi) bar = xcd_barrier_post((unsigned*)(ws + WS_CTL) + CW_BAR, MISC + 8);
#define IN(k) (lo <= (k) && (k) < hi)
#define SEAM(k) do { if (IN(k) && IN((k) + 1)) xcd_barrier(bar); } while (0)
    bf16* Q = F.BIG; bf16* Kq = Q + (size_t)T * 512; bf16* V = Kq + (size_t)T * 512; bf16* R = V + (size_t)T * 1024;
    PG8_LAS unsigned char* ring = (PG8_LAS unsigned char*)F.lds;
    PG8_LAS float* edge = (PG8_LAS float*)(F.lds + EDGE_OFF);

    if (IN(0)) { p0_prologue(F); } SEAM(0);
    if (IN(1)) { modulate_phase<true, true>(F, 0, 0); } SEAM(1);
    if (IN(2)) { pg8::Gemm g{F.H, (const bf16*)((const char*)F.wt + WT_GLA_IN), T, 3072, D}; pg8::Sched S; S.init(pg8::RM_ALL66, 3072, F.G, F.bid);
        pg8::EpiGlaIn E{Q, Kq, V, R, F.rcos, F.rsin};
        pg8::gemm_phase<pg8::EpiGlaIn, pg8::Sched, PG8_ALIGN, PG8_SP2>(ring, g, S, E); } SEAM(2);
    if (IN(3)) { gla_golden_phase(F); } SEAM(3);
    if (IN(4)) { gla_post_phase(F); } SEAM(4);
    if (IN(5)) { pg8::Gemm g{F.H, (const bf16*)((const char*)F.wt + WT_GLA_OUT), T, 1024, D}; pg8::Sched S; S.init(pg8::RM_ALL66, 1024, F.G, F.bid);
        pg8::EpiResid E{F.in[I_X], F.in[I_CTX], F.xlat, F.xctx, F.mod + 0 * 3 * 6144 + 2 * D};
        pg8::gemm_phase<pg8::EpiResid, pg8::Sched, PG8_ALIGN, PG8_SP2>(ring, g, S, E); } SEAM(5);
    if (IN(6)) { modulate_phase<false, false>(F, 0, 1); } SEAM(6);
    if (IN(7)) { pg8::Gemm g{F.H, (const bf16*)((const char*)F.wt + WT_FFN_IN0), T, 5632, D}; pg8::Sched S; S.init(pg8::RM_WIN68, 5632, F.G, F.bid);
        pg8::EpiFfnIn E{F.BIG, F.in[I_FFN_CW], F.in[I_FFN_CB], edge};
        pg8::gemm_phase<pg8::EpiFfnIn, pg8::Sched, true, PG8_SP2>(ring, g, S, E); } SEAM(7);
    if (IN(8)) { pg8::Gemm g{F.BIG, (const bf16*)((const char*)F.wt + WT_FFN_OUT0), T, 1024, DFF}; pg8::Sched S; S.init(pg8::RM_ALL66, 1024, F.G, F.bid);
        pg8::EpiResid E{F.xlat, F.xctx, F.xlat, F.xctx, F.mod + 0 * 3 * 6144 + 5 * D};
        pg8::gemm_phase<pg8::EpiResid, pg8::Sched, PG8_ALIGN, PG8_SP2>(ring, g, S, E); } SEAM(8);
    if (IN(9)) { modulate_phase<false, false>(F, 1, 0); } SEAM(9);
    if (IN(10)) { pg8::Gemm g{F.H, (const bf16*)((const char*)F.wt + WT_NA_QKV), T, 3072, D}; pg8::Sched S; S.init(pg8::RM_ALL66, 3072, F.G, F.bid);
        pg8::EpiNaQkv E{F.BIG};
        pg8::gemm_phase<pg8::EpiNaQkv, pg8::Sched, PG8_ALIGN, PG8_SP2>(ring, g, S, E); } SEAM(10);
    if (IN(11)) { na_golden_phase(F); } SEAM(11);
    if (IN(12)) { pg8::Gemm g{F.H, (const bf16*)((const char*)F.wt + WT_NA_OUT), T, 1024, D}; pg8::Sched S; S.init(pg8::RM_LAT64, 1024, F.G, F.bid);
        pg8::EpiResid E{F.xlat, F.xctx, F.xlat, F.xctx, F.mod + 1 * 3 * 6144 + 2 * D};
        pg8::gemm_phase<pg8::EpiResid, pg8::Sched, PG8_ALIGN, PG8_SP2>(ring, g, S, E); } SEAM(12);
    if (IN(13)) { modulate_phase<false, false>(F, 1, 1); } SEAM(13);
    if (IN(14)) { pg8::Gemm g{F.H, (const bf16*)((const char*)F.wt + WT_FFN_IN1), T, 5632, D}; pg8::Sched S; S.init(pg8::RM_WIN66, 5632, F.G, F.bid);
        pg8::EpiFfnIn E{F.BIG, F.in[I_FFN_CW] + 3 * DFF, F.in[I_FFN_CB] + DFF, edge};
        pg8::gemm_phase<pg8::EpiFfnIn, pg8::Sched, true, PG8_SP2>(ring, g, S, E); } SEAM(14);
    if (IN(15)) { pg8::Gemm g{F.BIG, (const bf16*)((const char*)F.wt + WT_FFN_OUT1), T, 1024, DFF}; pg8::Sched S; S.init(pg8::RM_LAT64, 1024, F.G, F.bid);
        pg8::EpiResid E{F.xlat, F.xctx, F.xlat, F.xctx, F.mod + 1 * 3 * 6144 + 5 * D};
        pg8::gemm_phase<pg8::EpiResid, pg8::Sched, PG8_ALIGN, PG8_SP2>(ring, g, S, E); } SEAM(15);
    if (IN(16)) { final_phase(F); }
#undef IN
#undef SEAM
}


#if MK_HYBRID
namespace gold {
struct GP { const float* const* dummy; const float *x_in, *ctx_in, *ffn_w_in, *ffn_cw, *ffn_cb, *ffn_w_out, *gla_w_in, *gla_w_out, *na_w_qkv, *na_w_out; float *xlat, *xctx, *mod; bf16 *H, *BIG; };
__device__ __forceinline__ float* gxrow(const GP& P, int row) { const int b = row / TB, p = row % TB; return p < LCTX ? P.xctx + (size_t)(b * LCTX + p) * D : P.xlat + (size_t)(b * NSEQ + p - LCTX) * D; }
__device__ __forceinline__ const float* gxinrow(const GP& P, int row) { const int b = row / TB, p = row % TB; return p < LCTX ? P.ctx_in + (size_t)(b * LCTX + p) * D : P.x_in + (size_t)(b * NSEQ + p - LCTX) * D; }
struct EpiResidG { GP P; int layer, gchunk, skip_ctx, from_input;
    __device__ __forceinline__ void operator()(int row, int col, const float (&a)[4]) const {
        if (skip_ctx && (row % TB) < LCTX) return;
        float* x = gxrow(P, row) + col; const float* xs = from_input ? gxinrow(P, row) + col : x; const float* g = P.mod + ((size_t)layer * 3 + modrow(row)) * 6144 + gchunk * D + col;
        f32x4 v = *(const f32x4*)xs; v[0] += g[0] * a[0]; v[1] += g[1] * a[1]; v[2] += g[2] * a[2]; v[3] += g[3] * a[3]; *(f32x4*)x = v;
    } };
template <class Epi>
__global__ void __launch_bounds__(256) k_gemm(const bf16* __restrict__ A, int lda, const float* __restrict__ B, int ldb, int K, Epi epi) {
    __shared__ float As[16][68];
    __shared__ float Bs[16][68];
    const int tid = threadIdx.x, tx = tid & 15, ty = tid >> 4;
    const int m0 = blockIdx.y * 64, n0 = blockIdx.x * 64;
    float acc[4][4] = {};
    for (int k0 = 0; k0 < K; k0 += 16) {
        { const int r = tid >> 2, kc = (tid & 3) * 4; const v2u w = *(const v2u*)(A + (size_t)(m0 + r) * lda + k0 + kc);
          As[kc + 0][r] = bf2f(w.x & 0xffffu); As[kc + 1][r] = bf2f(w.x >> 16); As[kc + 2][r] = bf2f(w.y & 0xffffu); As[kc + 3][r] = bf2f(w.y >> 16); }
        { const int kr = tid >> 4, nc = (tid & 15) * 4; *(f32x4*)&Bs[kr][nc] = *(const f32x4*)(B + (size_t)(k0 + kr) * ldb + n0 + nc); }
        __syncthreads();
#pragma unroll
        for (int kk = 0; kk < 16; ++kk) {
            const f32x4 a = *(const f32x4*)&As[kk][ty * 4]; const f32x4 b = *(const f32x4*)&Bs[kk][tx * 4];
#pragma unroll
            for (int i = 0; i < 4; ++i)
#pragma unroll
                for (int j = 0; j < 4; ++j) acc[i][j] += a[i] * b[j];
        }
        __syncthreads();
    }
#pragma unroll
    for (int i = 0; i < 4; ++i) epi(m0 + ty * 4 + i, n0 + tx * 4, acc[i]);
}
__global__ void __launch_bounds__(256) k_ffn_in(GP P, int layer) {
    __shared__ float As[16][72];
    __shared__ float Ba[16][68];
    __shared__ float Bv[16][68];
    const int tid = threadIdx.x, tx = tid & 15, ty = tid >> 4;
    const int m0 = blockIdx.y * 64, n0 = blockIdx.x * 64;
    const int p0 = m0 % TB; const int sstart = p0 < LCTX ? 0 : LCTX, send = p0 < LCTX ? LCTX : TB;
    const bool has_prev = (p0 - 1) >= sstart, has_next = (p0 + 64) < send;
    const float* W = P.ffn_w_in + (size_t)layer * D * 2 * DFF;
    float aa[6][4] = {}, vv[4][4] = {};
    for (int k0 = 0; k0 < D; k0 += 16) {
        { const int r = tid >> 2, kc = (tid & 3) * 4; const v2u w = *(const v2u*)(P.H + (size_t)(m0 + r) * D + k0 + kc);
          As[kc + 0][r + 1] = bf2f(w.x & 0xffffu); As[kc + 1][r + 1] = bf2f(w.x >> 16); As[kc + 2][r + 1] = bf2f(w.y & 0xffffu); As[kc + 3][r + 1] = bf2f(w.y >> 16); }
        if (tid < 32) { const int which = tid >> 4, kk = tid & 15; float v = 0.f;
            if (which == 0) { if (has_prev) v = bf2f(P.H[(size_t)(m0 - 1) * D + k0 + kk]); As[kk][0] = v; }
            else { if (has_next) v = bf2f(P.H[(size_t)(m0 + 64) * D + k0 + kk]); As[kk][65] = v; } }
        { const int kr = tid >> 4, nc = (tid & 15) * 4;
          *(f32x4*)&Ba[kr][nc] = *(const f32x4*)(W + (size_t)(k0 + kr) * 2 * DFF + n0 + nc);
          *(f32x4*)&Bv[kr][nc] = *(const f32x4*)(W + (size_t)(k0 + kr) * 2 * DFF + DFF + n0 + nc); }
        __syncthreads();
#pragma unroll
        for (int kk = 0; kk < 16; ++kk) {
            float av[6];
#pragma unroll
            for (int i = 0; i < 6; ++i) av[i] = As[kk][ty * 4 + i];
            const f32x4 b4 = *(const f32x4*)&Ba[kk][tx * 4]; const f32x4 v4 = *(const f32x4*)&Bv[kk][tx * 4];
#pragma unroll
            for (int i = 0; i < 6; ++i)
#pragma unroll
                for (int j = 0; j < 4; ++j) aa[i][j] += av[i] * b4[j];
#pragma unroll
            for (int i = 0; i < 4; ++i)
#pragma unroll
                for (int j = 0; j < 4; ++j) vv[i][j] += av[i + 1] * v4[j];
        }
        __syncthreads();
    }
    const float* cw = P.ffn_cw + (size_t)layer * 3 * DFF; const float* cb = P.ffn_cb + (size_t)layer * DFF;
#pragma unroll
    for (int i = 0; i < 4; ++i) {
        const int row = m0 + ty * 4 + i; unsigned o[4];
#pragma unroll
        for (int j = 0; j < 4; ++j) { const int f = n0 + tx * 4 + j;
            const float ac = aa[i][j] * cw[f] + aa[i + 1][j] * cw[DFF + f] + aa[i + 2][j] * cw[2 * DFF + f] + cb[f];
            o[j] = f2bf(ac / (1.0f + expf(-ac)) * vv[i][j]); }
        v2u w; w.x = o[0] | (o[1] << 16); w.y = o[2] | (o[3] << 16);
        *(v2u*)(P.BIG + (size_t)row * DFF + n0 + tx * 4) = w;
    }
}

__global__ void __launch_bounds__(256) k_gate(GP P, const float* aw1, const float* aw2, const float* ab, _Float16* G, float* hwdump) {
    __shared__ float part[8][32];
    __shared__ float hw[32];
    const int row = blockIdx.x, tid = threadIdx.x;
    const int j32 = tid & 31, kg = tid >> 5; const int dir = j32 >> 4, j = j32 & 15;
    const bf16* h = P.H + (size_t)row * D;
    const float* w1 = aw1 + (size_t)dir * D * 16 + j;
    float s = 0.f;
    for (int k = kg * 128; k < kg * 128 + 128; ++k) s += bf2f(h[k]) * w1[(size_t)k * 16];
    part[kg][j32] = s;
    __syncthreads();
    if (tid < 32) { float t = 0.f; for (int g = 0; g < 8; ++g) t += part[g][tid]; hw[tid] = t; hwdump[(size_t)row * 32 + tid] = t; }
    __syncthreads();
    for (int e = tid; e < 1024; e += 256) {
        const int d2 = e >> 9, c = e & 511; const int oc = (c & ~127) + qk_src(c & 127);
        float xg = ab[d2 * 512 + oc];
        for (int jj = 0; jj < 16; ++jj) xg += hw[d2 * 16 + jj] * aw2[((size_t)d2 * 16 + jj) * 512 + oc];
        const float ls = fminf(xg, 0.f) - log1pf(expf(-fabsf(xg)));
        G[((size_t)d2 * T + row) * 512 + c] = (_Float16)(ls * (1.0f / 16.0f) * LOG2E);
    }
}

__global__ void __launch_bounds__(256) k_gdiff(const _Float16* Ga, const _Float16* Gb, float* acc, int mode) {
    float mx = 0.f; unsigned bad = 0, tot = 0;
    const int sub = mode >= 10 ? mode - 10 : mode;
    for (size_t i = (size_t)blockIdx.x * 256 + threadIdx.x; i < (size_t)2 * T * 512; i += (size_t)gridDim.x * 256) {
        const int c = (int)(i & 511); const size_t rr = i >> 9; const int row = (int)(rr % T), dir = (int)(rr / T);
        bool sel = true;
        if (sub == 1) sel = dir == 0; if (sub == 2) sel = dir == 1; if (sub == 3) sel = (row % TB) < LCTX; if (sub == 4) sel = (c & 127) < 8; if (sub == 5) sel = c < 256; if (sub == 6) sel = (row & 7) == 0;
        if (sub == 7) sel = (c & 3) == 0; if (sub == 8) sel = row < 2048; if (sub == 9) sel = (c & 255) < 4;
        if (sel) { const float d = fabsf((float)Ga[i] - (float)Gb[i]); mx = fmaxf(mx, d); tot++; bad += d > 0.02f; }
    }
    if (mode < 10) { for (int o = 32; o > 0; o >>= 1) mx = fmaxf(mx, __shfl_xor(mx, o));
        if ((threadIdx.x & 63) == 0) atomicMax((unsigned*)acc, __float_as_uint(mx)); }
    else { atomicAdd((unsigned*)acc + 1, bad); atomicAdd((unsigned*)acc + 2, tot); }
}

__global__ void __launch_bounds__(256) k_hwdiff(const float* a, const float* b, float* acc) {
    float mx = 0.f;
    for (size_t i = (size_t)blockIdx.x * 256 + threadIdx.x; i < (size_t)T * 32; i += (size_t)gridDim.x * 256) mx = fmaxf(mx, fabsf(a[i] - b[i]));
    for (int o = 32; o > 0; o >>= 1) mx = fmaxf(mx, __shfl_xor(mx, o));
    if ((threadIdx.x & 63) == 0) atomicMax((unsigned*)acc + 3, __float_as_uint(mx));
}
__global__ void k_gdiff_apply(float* out, const float* acc, int mode) { if (mode == 60) out[0] += 1000.0f + (float)((const unsigned*)acc)[4]; else if (mode == 50) out[0] += 1000.0f * acc[3]; else if (mode < 10) out[0] += 1000.0f * acc[0]; else { const unsigned* u = (const unsigned*)acc; out[0] += 1000.0f * (float)u[1] / fmaxf((float)u[2], 1.0f); } }
}
#endif

extern "C" void kernel_launch(void* const* d_in, const int* in_sizes, int n_in, void* d_out, int out_size, void* d_ws, size_t ws_size, hipStream_t stream) {
    static int grid = 0;
    if (grid == 0) {
        if (n_in != 22 || out_size != NB * NSEQ * D || ws_size < WS_END) { fprintf(stderr, "kernel_launch: unexpected shapes (n_in %d out %d ws %zu)\n", n_in, out_size, ws_size); grid = -1; return; }
        int dev = 0, cus = 0, per_cu = 0;
        if (hipGetDevice(&dev) != hipSuccess || hipDeviceGetAttribute(&cus, hipDeviceAttributeMultiprocessorCount, dev) != hipSuccess) { grid = -1; return; }
        if (hipFuncSetAttribute((const void*)mega_fwd, hipFuncAttributeMaxDynamicSharedMemorySize, LDS_BYTES) != hipSuccess) { fprintf(stderr, "kernel_launch: hipFuncSetAttribute failed\n"); grid = -1; return; }
        if (hipOccupancyMaxActiveBlocksPerMultiprocessor(&per_cu, (const void*)mega_fwd, NTHR, LDS_BYTES) != hipSuccess || per_cu < 1) { fprintf(stderr, "kernel_launch: occupancy query says %d blocks per CU\n", per_cu); (void)hipGetLastError(); grid = -1; return; }
        grid = cus;
    }
    if (grid < 0) return;
    (void)hipMemsetAsync((char*)d_ws + WS_CTL, 0, CTL_ZERO_BYTES, stream);
    Args a{};
    for (int i = 0; i < 22; ++i) a.in[i] = (const float*)d_in[i];
    a.out = (float*)d_out; a.ws = (unsigned char*)d_ws;
#if MK_HYBRID
    gold::GP gp{}; gp.x_in = a.in[I_X]; gp.ctx_in = a.in[I_CTX]; gp.ffn_w_in = a.in[I_FFN_WIN]; gp.ffn_cw = a.in[I_FFN_CW]; gp.ffn_cb = a.in[I_FFN_CB]; gp.ffn_w_out = a.in[I_FFN_WOUT];
    gp.gla_w_in = a.in[I_GLA_WIN]; gp.gla_w_out = a.in[I_GLA_WOUT]; gp.na_w_qkv = a.in[I_NA_WQKV]; gp.na_w_out = a.in[I_NA_WOUT];
    gp.xlat = (float*)d_out; gp.xctx = (float*)((char*)d_ws + WS_XCTX); gp.mod = (float*)((char*)d_ws + WS_TAB + TAB_MOD); gp.H = (bf16*)((char*)d_ws + WS_H); gp.BIG = (bf16*)((char*)d_ws + WS_BIG);
    for (int p = 0; p < NPHASE; ++p) {
#if GOLD_FFN_IN
        if (p == 7 || p == 14) { gold::k_ffn_in<<<dim3(DFF / 64, T / 64), 256, 0, stream>>>(gp, p == 7 ? 0 : 1); continue; }
#endif
#if GOLD_FFN_OUT
        if (p == 8 || p == 15) { const int L = p == 8 ? 0 : 1; gold::k_gemm<gold::EpiResidG><<<dim3(1024 / 64, T / 64), 256, 0, stream>>>(gp.BIG, DFF, gp.ffn_w_out + (size_t)L * DFF * D, 1024, DFF, gold::EpiResidG{gp, L, 5, L, 0}); continue; }
#endif
#if GOLD_WOUT
        if (p == 5) { gold::k_gemm<gold::EpiResidG><<<dim3(1024 / 64, T / 64), 256, 0, stream>>>(gp.H, D, gp.gla_w_out, 1024, D, gold::EpiResidG{gp, 0, 2, 0, 1}); continue; }
        if (p == 12) { gold::k_gemm<gold::EpiResidG><<<dim3(1024 / 64, T / 64), 256, 0, stream>>>(gp.H, D, gp.na_w_out, 1024, D, gold::EpiResidG{gp, 1, 2, 1, 0}); continue; }
#endif
        a.ph_lo = p; a.ph_hi = p + 1; hipLaunchKernelGGL(mega_fwd, dim3(grid), dim3(NTHR), LDS_BYTES, stream, a);
#if GOLD_GATE
#if GOLD_GATE == 1
        if (p == 1) gold::k_gate<<<T, 256, 0, stream>>>(gp, a.in[I_GLA_AW1], a.in[I_GLA_AW2], a.in[I_GLA_AB], (_Float16*)((char*)d_ws + WS_G), (float*)((char*)d_ws + WS_BIG + 4 * MiB));
#else
        if (p == 1) { _Float16* G2 = (_Float16*)((char*)d_ws + WS_END); float* dacc = (float*)((char*)d_ws + WS_CTL + 32768);
            hipMemcpyAsync(G2, (char*)d_ws + WS_G, (size_t)2 * T * 512 * 2, hipMemcpyDeviceToDevice, stream);
            gold::k_gate<<<T, 256, 0, stream>>>(gp, a.in[I_GLA_AW1], a.in[I_GLA_AW2], a.in[I_GLA_AB], (_Float16*)((char*)d_ws + WS_G), (float*)((char*)d_ws + WS_BIG + 4 * MiB));
            gold::k_gdiff<<<1024, 256, 0, stream>>>((_Float16*)((char*)d_ws + WS_G), G2, dacc, GOLD_GATE - 2);
            gold::k_hwdiff<<<256, 256, 0, stream>>>((float*)((char*)d_ws + WS_BIG), (float*)((char*)d_ws + WS_BIG + 4 * MiB), dacc); }
        if (p == NPHASE - 1) gold::k_gdiff_apply<<<1, 1, 0, stream>>>((float*)d_out, (float*)((char*)d_ws + WS_CTL + 32768), GOLD_GATE - 2);
#endif
#endif
    }
#else
    a.ph_lo = 0; a.ph_hi = NPHASE;
    void* kargs[] = {&a};
    hipError_t e = hipLaunchCooperativeKernel((const void*)mega_fwd, dim3(grid), dim3(NTHR), kargs, LDS_BYTES, stream);
    if (e != hipSuccess) fprintf(stderr, "kernel_launch: cooperative launch failed: %s (grid %d)\n", hipGetErrorString(e), grid);
#endif
}
```

```cpp
#include <hip/hip_runtime.h>
#include <hip/hip_fp16.h>
#include <cstdint>
#include <cstdio>
#ifndef MK_HYBRID
#define MK_HYBRID 0
#endif
#ifndef GOLD_FFN_IN
#define GOLD_FFN_IN 0
#endif
#ifndef GOLD_FFN_OUT
#define GOLD_FFN_OUT 0
#endif
#ifndef GOLD_WOUT
#define GOLD_WOUT 0
#endif
#ifndef GOLD_GATE
#define GOLD_GATE 0
#endif
#ifndef GATE_NAIVE
#define GATE_NAIVE 0
#endif
#ifndef GATE_CHECK
#define GATE_CHECK 0
#endif
#ifndef GLA_TEST
#define GLA_TEST 0
#endif
#ifndef GLA_NOSTATE
#define GLA_NOSTATE 0
#endif
#ifndef GLA_CHECK
#define GLA_CHECK 0
#endif
#ifndef GLA_CHECK_DIR
#define GLA_CHECK_DIR 0
#endif
namespace pg8 {
#define PG8_LAS __attribute__((address_space(3)))
typedef unsigned short bf16_t;
typedef short bf16x8 __attribute__((ext_vector_type(8)));
typedef float f32x4 __attribute__((ext_vector_type(4)));
typedef unsigned u32x4 __attribute__((ext_vector_type(4)));
constexpr int BM = 256, BK = 64, HALF = 128, HTB = HALF * BK * 2  , STAGE_BYTES = 8 * HTB, NXCD = 8, WGM = 8;

__host__ __device__ __forceinline__ int lds_byte(int r, int c) { const int st = (r >> 4) * 2 + (c >> 5), rr = r & 15, cc = c & 31, ob = rr * 64 + cc * 2; return st * 1024 + (ob ^ (((ob >> 9) & 1) << 5)); }
__host__ __device__ __forceinline__ void stage_rc(int b, int& R, int& C) { const int st = b / 1024, sb = b % 1024, swz = sb ^ (((sb >> 9) & 1) << 5); R = (st >> 1) * 16 + swz / 64; C = (st & 1) * 32 + (swz % 64) / 2; }
__host__ __device__ __forceinline__ int perm32(int rho) { const int n = rho >> 4, i = rho & 15; return 8 * (i >> 2) + 4 * n + (i & 3); }

struct Unit { int pm, pn, arow; };
struct Gemm { const bf16_t* A; const bf16_t* Bt; int M, N, K; };

__device__ __forceinline__ unsigned cvt_pk_bf16(float lo, float hi) { unsigned r; asm volatile("v_cvt_pk_bf16_f32 %0, %1, %2" : "=v"(r) : "v"(lo), "v"(hi)); return r; }

template <class Epi, class Sched, bool ALIGN_EPI = false, bool SP2 = false>
__device__ __forceinline__ void gemm_phase(PG8_LAS unsigned char* lds, const Gemm g, const Sched& S, const Epi& E) {
    const int tid = threadIdx.x, wid = __builtin_amdgcn_readfirstlane(tid >> 6), lane = tid & 63, wr = wid >> 2, wc = wid & 3, fr = lane & 15, fq = lane >> 4;
    const int K = g.K, nt = K / BK;
    unsigned voffA[2], voffB[2];
#pragma unroll
    for (int i = 0; i < 2; ++i) { int R, C; stage_rc(tid * 16 + i * 8192, R, C); const int Rb = Epi::PERM ? ((R & ~31) + perm32(R & 31)) : R;
        voffA[i] = (unsigned)(R * K + C) * 2u; voffB[i] = (unsigned)(Rb * K + C) * 2u; }
    const size_t kstep = (size_t)(BK * 2);
    const size_t hstep = (size_t)HALF * K * 2;
    const size_t tstep = 2 * hstep;
    const unsigned ldsw = (unsigned)wid * 1024u;
    const int aoff = lds_byte(wr * 64 + fr, fq * 8), boff = lds_byte(wc * 32 + fr, fq * 8);
#define PG8_SA(b, h) (((b) * 2 + (h)) * HTB)
#define PG8_SB(b, h) ((4 + (b) * 2 + (h)) * HTB)
#define PG8_STAGE(bufoff, gbase, voff) do { _Pragma("unroll") for (int _i = 0; _i < 2; ++_i) \
        __builtin_amdgcn_global_load_lds((const unsigned*)((const char*)(gbase) + (voff)[_i]), (PG8_LAS unsigned*)(lds + (bufoff) + ldsw + _i * 8192), 16, 0, 0); } while (0)
#define PG8_LDA(dst, b, h) do { _Pragma("unroll") for (int m = 0; m < 4; ++m) _Pragma("unroll") for (int k = 0; k < 2; ++k) dst[m][k] = *(const PG8_LAS bf16x8*)(lds + PG8_SA(b, h) + aoff + m * 2048 + k * 1024); } while (0)
#define PG8_LDB(dst, b, h) do { _Pragma("unroll") for (int n = 0; n < 2; ++n) _Pragma("unroll") for (int k = 0; k < 2; ++k) dst[n][k] = *(const PG8_LAS bf16x8*)(lds + PG8_SB(b, h) + boff + n * 2048 + k * 1024); } while (0)
#define PG8_MMA(ai, bj, At, Bt) do { __builtin_amdgcn_s_setprio(1); _Pragma("unroll") for (int m = 0; m < 4; ++m) _Pragma("unroll") for (int n = 0; n < 2; ++n) _Pragma("unroll") for (int k = 0; k < 2; ++k) \
        acc[ai][bj][m][n] = __builtin_amdgcn_mfma_f32_16x16x32_bf16(Bt[n][k], At[m][k], acc[ai][bj][m][n], 0, 0, 0); __builtin_amdgcn_s_setprio(0); } while (0)
#define PG8_WAIT_V(n) asm volatile("s_waitcnt vmcnt(" #n ")" ::: "memory")
#define PG8_WAIT_L(n) asm volatile("s_waitcnt lgkmcnt(" #n ")" ::: "memory")
#define PG8_BAR __builtin_amdgcn_s_barrier()
#define PG8_SCHED __builtin_amdgcn_sched_barrier(0)
    Unit cur, nxt; int ui = 0;
    if (!S.next(0, cur)) return;
    f32x4 acc[2][2][4][2];
#pragma unroll
    for (int a = 0; a < 2; ++a)
#pragma unroll
        for (int b = 0; b < 2; ++b)
#pragma unroll
            for (int m = 0; m < 4; ++m)
#pragma unroll
                for (int n = 0; n < 2; ++n) acc[a][b][m][n] = (f32x4){0.f, 0.f, 0.f, 0.f};
    bf16x8 At[4][2], B0[2][2], B1[2][2];
    const char* cA = (const char*)g.A + (size_t)cur.arow * (size_t)(K * 2); const char* cB = (const char*)g.Bt + (size_t)cur.pn * tstep;
    S.a_ready(cur);
    if constexpr (SP2) {
        PG8_STAGE(PG8_SB(0, 0), cB, voffB); PG8_STAGE(PG8_SB(0, 1), cB + hstep, voffB); PG8_STAGE(PG8_SA(0, 0), cA, voffA); PG8_STAGE(PG8_SA(0, 1), cA + hstep, voffA);
        if (wr == 1) PG8_BAR;
        PG8_WAIT_V(2); PG8_BAR;
        PG8_STAGE(PG8_SB(1, 0), cB + kstep, voffB); PG8_STAGE(PG8_SA(1, 0), cA + kstep, voffA); PG8_STAGE(PG8_SB(1, 1), cB + hstep + kstep, voffB);
        PG8_WAIT_V(6); PG8_BAR;
    } else {
        PG8_STAGE(PG8_SB(0, 0), cB, voffB); PG8_STAGE(PG8_SA(0, 0), cA, voffA); PG8_STAGE(PG8_SB(0, 1), cB + hstep, voffB); PG8_STAGE(PG8_SA(0, 1), cA + hstep, voffA);
        if (wr == 1) PG8_BAR;
        PG8_WAIT_V(4); PG8_BAR;
        PG8_STAGE(PG8_SB(1, 0), cB + kstep, voffB); PG8_STAGE(PG8_SA(1, 0), cA + kstep, voffA); PG8_STAGE(PG8_SB(1, 1), cB + hstep + kstep, voffB);
        PG8_WAIT_V(6); PG8_BAR;
    }
    for (;;) {
        const bool has_next = S.next(ui + 1, nxt);
        const char* nA = has_next ? (const char*)g.A + (size_t)nxt.arow * (size_t)(K * 2) : cA; const char* nB = has_next ? (const char*)g.Bt + (size_t)nxt.pn * tstep : cB;
        for (int t = 0; t < nt; t += 2) {
            const bool last = (t == nt - 2);
            const char* a1 = cA + (size_t)(t + 1) * kstep;
            const char* a2 = last ? nA : cA + (size_t)(t + 2) * kstep; const char* b2 = last ? nB : cB + (size_t)(t + 2) * kstep;
            const char* a3 = a2 + kstep; const char* b3 = b2 + kstep;
            if (last && has_next) S.a_ready(nxt);
            if constexpr (SP2) {
            PG8_LDB(B0, 0, 0); PG8_LDB(B1, 0, 1); PG8_SCHED; PG8_LDA(At, 0, 0); PG8_STAGE(PG8_SA(1, 1), a1 + hstep, voffA);
            PG8_WAIT_V(8); PG8_WAIT_L(0); PG8_BAR; PG8_MMA(0, 0, At, B0); PG8_MMA(0, 1, At, B1); PG8_BAR; PG8_SCHED;
            PG8_LDA(At, 0, 1); PG8_STAGE(PG8_SB(0, 0), b2, voffB); PG8_STAGE(PG8_SB(0, 1), b2 + hstep, voffB); PG8_STAGE(PG8_SA(0, 0), a2, voffA);
            PG8_WAIT_V(8); PG8_WAIT_L(0); PG8_BAR; PG8_MMA(1, 0, At, B0); PG8_MMA(1, 1, At, B1); PG8_BAR; PG8_SCHED;
            PG8_LDB(B0, 1, 0); PG8_LDB(B1, 1, 1); PG8_SCHED; PG8_LDA(At, 1, 0); PG8_STAGE(PG8_SA(0, 1), a2 + hstep, voffA);
            PG8_WAIT_V(8); PG8_WAIT_L(0); PG8_BAR; PG8_MMA(0, 0, At, B0); PG8_MMA(0, 1, At, B1); PG8_BAR; PG8_SCHED;
            PG8_LDA(At, 1, 1); PG8_STAGE(PG8_SB(1, 0), b3, voffB); PG8_STAGE(PG8_SB(1, 1), b3 + hstep, voffB); PG8_STAGE(PG8_SA(1, 0), a3, voffA);
            PG8_WAIT_V(8); PG8_WAIT_L(0); PG8_BAR; PG8_MMA(1, 0, At, B0); PG8_MMA(1, 1, At, B1); PG8_BAR; PG8_SCHED;
            } else {
            PG8_LDB(B0, 0, 0); PG8_SCHED; PG8_LDA(At, 0, 0); PG8_STAGE(PG8_SA(1, 1), a1 + hstep, voffA);
            PG8_WAIT_L(8); PG8_BAR; PG8_WAIT_L(0); PG8_MMA(0, 0, At, B0); PG8_BAR; PG8_SCHED;
            PG8_LDB(B1, 0, 1); PG8_STAGE(PG8_SB(0, 0), b2, voffB);
            PG8_BAR; PG8_WAIT_L(0); PG8_MMA(0, 1, At, B1); PG8_BAR;
            PG8_LDA(At, 0, 1); PG8_STAGE(PG8_SA(0, 0), a2, voffA);
            PG8_BAR; PG8_WAIT_L(0); PG8_MMA(1, 0, At, B0); PG8_BAR; PG8_SCHED;
            PG8_STAGE(PG8_SB(0, 1), b2 + hstep, voffB);
            PG8_WAIT_V(6); PG8_BAR; PG8_MMA(1, 1, At, B1); PG8_BAR;
            PG8_LDB(B0, 1, 0); PG8_SCHED; PG8_LDA(At, 1, 0); PG8_STAGE(PG8_SA(0, 1), a2 + hstep, voffA);
            PG8_WAIT_L(8); PG8_BAR; PG8_WAIT_L(0); PG8_MMA(0, 0, At, B0); PG8_BAR; PG8_SCHED;
            PG8_LDB(B1, 1, 1); PG8_STAGE(PG8_SB(1, 0), b3, voffB);
            PG8_BAR; PG8_WAIT_L(0); PG8_MMA(0, 1, At, B1); PG8_BAR;
            PG8_LDA(At, 1, 1); PG8_STAGE(PG8_SA(1, 0), a3, voffA);
            PG8_BAR; PG8_WAIT_L(0); PG8_MMA(1, 0, At, B0); PG8_BAR; PG8_SCHED;
            PG8_STAGE(PG8_SB(1, 1), b3 + hstep, voffB);
            PG8_WAIT_V(6); PG8_BAR; PG8_MMA(1, 1, At, B1); PG8_BAR;
            }
        }
        if constexpr (ALIGN_EPI) { if (wr == 0) PG8_BAR; }
        if constexpr (!Epi::AFTER_DRAIN) { E(acc, cur, wr, wc, fr, fq); S.done(cur); }
        if (!has_next) break;
#pragma unroll
        for (int a = 0; a < 2; ++a)
#pragma unroll
            for (int b = 0; b < 2; ++b)
#pragma unroll
                for (int m = 0; m < 4; ++m)
#pragma unroll
                    for (int n = 0; n < 2; ++n) acc[a][b][m][n] = (f32x4){0.f, 0.f, 0.f, 0.f};
        cur = nxt; cA = nA; cB = nB; ++ui;
        if constexpr (ALIGN_EPI) { if (wr == 1) PG8_BAR; }
    }
    PG8_WAIT_V(0);
    if constexpr (!ALIGN_EPI) { if (wr == 0) PG8_BAR; }
    PG8_BAR;
    if constexpr (Epi::AFTER_DRAIN) { E.fused(acc, cur, wr, wc, fr, fq, lds, wid, lane); S.done(cur); }
#undef PG8_SA
#undef PG8_SB
#undef PG8_STAGE
#undef PG8_LDA
#undef PG8_LDB
#undef PG8_MMA
#undef PG8_WAIT_V
#undef PG8_WAIT_L
#undef PG8_BAR
#undef PG8_SCHED
}
}

#ifndef PG8_SP2
#define PG8_SP2 true
#endif
#ifndef PG8_ALIGN
#define PG8_ALIGN true
#endif

constexpr int NWAVES = 8, NTHR = 512;
constexpr int D = 1024, NB = 2, NSEQ = 8192, LCTX = 256, TB = LCTX + NSEQ  , T = NB * TB  ;
constexpr int DFF = 2816, GW = 64;
constexpr float EPS = 1e-6f;
constexpr float LOG2E = 1.4426950408889634f;

#define LAS __attribute__((address_space(3)))
#define GAS __attribute__((address_space(1)))
typedef unsigned short bf16;
typedef unsigned v4u __attribute__((ext_vector_type(4)));
typedef unsigned v2u __attribute__((ext_vector_type(2)));
typedef float f32x4 __attribute__((ext_vector_type(4)));
typedef _Float16 h2 __attribute__((ext_vector_type(2)));
typedef GAS unsigned gu32;
#define RLX_AGENT __ATOMIC_RELAXED, __HIP_MEMORY_SCOPE_AGENT
#define LDS_WAIT() asm volatile("s_waitcnt lgkmcnt(0)" ::: "memory")
#define VM_WAIT() asm volatile("s_waitcnt vmcnt(0)" ::: "memory")

constexpr size_t MiB = 1u << 20;
constexpr size_t WS_CTL = 0, CTL_ZERO_BYTES = 64 * 1024;
constexpr size_t WS_TAB = 1 * MiB;
constexpr size_t TAB_COS = 0, TAB_SIN = 16384, TAB_MOD = 32768;
constexpr size_t WS_XCTX = 2 * MiB;
constexpr size_t WS_OCTX = 4 * MiB;
constexpr size_t WS_WT = 6 * MiB;
constexpr size_t WT_GLA_IN = 0, WT_GLA_OUT = 6 * MiB, WT_FFN_IN0 = 8 * MiB, WT_FFN_IN1 = 19 * MiB, WT_FFN_OUT0 = 30 * MiB, WT_FFN_OUT1 = 30 * MiB + 5632 * 1024, WT_NA_QKV = 41 * MiB, WT_NA_OUT = 47 * MiB;
constexpr size_t WS_H = 55 * MiB;
constexpr size_t WS_G = WS_H + 33 * MiB + MiB / 2;
constexpr size_t WS_BIG = WS_G + 33 * MiB;
constexpr size_t WS_END = WS_BIG + 99 * MiB;
static_assert(WS_END <= 256 * MiB, "ws map");
constexpr int CW_BAR = 1024;

constexpr int RING_BYTES = 131072;
constexpr int EDGE_OFF = RING_BYTES;
constexpr int MISC_OFF = RING_BYTES + 8192;
constexpr int LDS_BYTES = 147456;

__device__ __forceinline__ unsigned f2bf(float f) { unsigned u = __builtin_bit_cast(unsigned, f); return (u + 0x7fffu + ((u >> 16) & 1u)) >> 16; }
__device__ __forceinline__ unsigned pk2(float lo, float hi) { return f2bf(lo) | (f2bf(hi) << 16); }
__device__ __forceinline__ float bf2f(unsigned v) { return __builtin_bit_cast(float, v << 16); }
__device__ __forceinline__ float wave_sum(float v) {
#pragma unroll
    for (int o = 1; o < 64; o <<= 1) v += __shfl_xor(v, o);
    return v;
}
__device__ __forceinline__ float fast_silu(float x) { return x * __builtin_amdgcn_rcpf(1.0f + __builtin_amdgcn_exp2f(-x * LOG2E)); }


__device__ __forceinline__ h2 as_h2(unsigned u) { return __builtin_bit_cast(h2, u); }
#ifndef USE_FDOT2
#define USE_FDOT2 1
#endif
__device__ __forceinline__ float dot2_impl(h2 a, h2 b, float c) {
#if USE_FDOT2
    return __builtin_amdgcn_fdot2(a, b, c, false);
#else
    return c + (float)a[0] * (float)b[0] + (float)a[1] * (float)b[1];
#endif
}
#define DOT2(a, b, c, cl) dot2_impl((a), (b), (c))

#define XB_TMO      128
#define XB_XCNT(j)  (256  + 64 * (j))
#define XB_XSUB(j)  (1280 + 64 * (j))
#define XB_XGEN(j)  (2304 + 64 * (j))
#define XB_TOP      3328
#define XB_TOPGEN   3392
#define XCD_BAR_WORDS 3456
#define XB_SPIN_CAP (1u << 23)
__device__ __forceinline__ unsigned xb_ld(unsigned* p)              { return __hip_atomic_load(p, __ATOMIC_RELAXED, __HIP_MEMORY_SCOPE_AGENT); }
__device__ __forceinline__ unsigned xb_add(unsigned* p, unsigned v) { return __hip_atomic_fetch_add(p, v, __ATOMIC_RELAXED, __HIP_MEMORY_SCOPE_AGENT); }
__device__ __forceinline__ unsigned xb_xcc_id() { return (unsigned)__builtin_amdgcn_s_getreg((3 << 11) | 20) & 0xFu; }
#define XB_SPIN(cond, bar) do { unsigned _sp = 0; while (cond) { __builtin_amdgcn_s_sleep(1); \
    if ((++_sp & 255u) == 0u) { if (xb_ld(&(bar)[XB_TMO])) break; if (_sp > XB_SPIN_CAP) { atomicAdd(&(bar)[XB_TMO], 1u); break; } } } } while (0)
struct XcdBarrier { unsigned* bar; unsigned x; volatile LAS unsigned* st; };
__device__ __forceinline__ XcdBarrier xcd_barrier_post(unsigned* bar, volatile LAS unsigned* st) {
    XcdBarrier b; b.bar = bar; b.x = xb_xcc_id(); b.st = st;
    if (threadIdx.x == 0) (void)xb_add(&bar[XB_XCNT(b.x)], 1u);
    return b;
}
__device__ __forceinline__ void xcd_barrier_complete(unsigned* bar, unsigned x, unsigned& nloc, unsigned& nx) {
    const unsigned G = gridDim.x * gridDim.y * gridDim.z;
    unsigned sum, cnt, mine, sp = 0u;
    for (;;) {
        sum = 0u; cnt = 0u; mine = 0u;
#pragma unroll
        for (unsigned j = 0; j < 16; ++j) { const unsigned c = xb_ld(&bar[XB_XCNT(j)]); sum += c; cnt += (c > 0u) ? 1u : 0u; mine = (j == x) ? c : mine; }
        if (sum == G) break;
        __builtin_amdgcn_s_sleep(1);
        if ((++sp & 255u) == 0u) { if (xb_ld(&bar[XB_TMO])) break; if (sp > XB_SPIN_CAP) { atomicAdd(&bar[XB_TMO], 1u); break; } }
    }
    nloc = mine > 0u ? mine : 1u; nx = cnt > 0u ? cnt : 1u;
}
__device__ __forceinline__ void xcd_barrier(const XcdBarrier& b) {
    asm volatile("s_waitcnt vmcnt(0)" ::: "memory");
    __syncthreads();
    if (threadIdx.x == 0) {
        unsigned* bar = b.bar;
        __builtin_amdgcn_s_waitcnt(0);
        unsigned nloc = b.st[0], nx = b.st[1];
        if (nloc == 0u) { xcd_barrier_complete(bar, b.x, nloc, nx); b.st[0] = nloc; b.st[1] = nx; }
        const unsigned old = xb_add(&bar[XB_XSUB(b.x)], 1u);
        const unsigned gen = old / nloc;
        if (old + 1u == (gen + 1u) * nloc) {
            __builtin_amdgcn_fence(__ATOMIC_RELEASE, "agent");
            asm volatile("s_waitcnt vmcnt(0)" ::: "memory");
            const unsigned og = xb_add(&bar[XB_TOP], 1u);
            const unsigned tg = og / nx;
            if (og + 1u == (tg + 1u) * nx) xb_add(&bar[XB_TOPGEN], 1u);
            else XB_SPIN(xb_ld(&bar[XB_TOPGEN]) == tg, bar);
            __builtin_amdgcn_fence(__ATOMIC_ACQUIRE, "agent");
            xb_add(&bar[XB_XGEN(b.x)], 1u);
            asm volatile("s_waitcnt vmcnt(0)" ::: "memory");
        } else {
            XB_SPIN(xb_ld(&bar[XB_XGEN(b.x)]) == gen, bar);
            __builtin_amdgcn_fence(__ATOMIC_ACQUIRE, "agent");
            asm volatile("s_waitcnt vmcnt(0)" ::: "memory");
        }
    }
    __syncthreads();
}

struct Args { const float* in[22]; float* out; unsigned char* ws; int ph_lo, ph_hi; };
enum { I_X = 0, I_C, I_CTX, I_CCTX, I_ADA_W, I_ADA_B, I_N1G, I_N2G, I_FFN_WIN, I_FFN_CW, I_FFN_CB, I_FFN_WOUT, I_GLA_WIN, I_GLA_AW1, I_GLA_AW2, I_GLA_AB, I_GLA_NG, I_GLA_WOUT, I_NA_WQKV, I_NA_RPB, I_NA_WOUT, I_FINAL_G };

struct Frame {
    LAS unsigned char* lds;
    int tid, lane, wave, G, bid;
    const float* const* in;
    float* xlat; float* xctx; float* octx;
    float *rcos, *rsin, *mod;
    bf16 *wt; bf16 *H; _Float16* Gt; bf16* BIG;
};
__device__ __forceinline__ float* xrow(const Frame& F, int row) { const int b = row / TB, p = row % TB; return p < LCTX ? F.xctx + (size_t)(b * LCTX + p) * D : F.xlat + (size_t)(b * NSEQ + p - LCTX) * D; }
__device__ __forceinline__ float* orow(const Frame& F, int row) { const int b = row / TB, p = row % TB; return p < LCTX ? F.octx + (size_t)(b * LCTX + p) * D : F.xlat + (size_t)(b * NSEQ + p - LCTX) * D; }
__device__ __forceinline__ const float* xinrow(const Frame& F, int row) { const int b = row / TB, p = row % TB; return p < LCTX ? F.in[I_CTX] + (size_t)(b * LCTX + p) * D : F.in[I_X] + (size_t)(b * NSEQ + p - LCTX) * D; }
__device__ __forceinline__ int modrow(int row) { const int b = row / TB, p = row % TB; return p < LCTX ? 2 : b; }
__device__ __forceinline__ int qk_src(int cl) { const int grp = cl >> 3, within = cl & 7, pi = grp * 4 + (within & 3), x2 = within >> 2; return (pi >> 5) * 64 + x2 * 32 + (pi & 31); }

__device__ __forceinline__ void phase_fence(Frame& F) { asm volatile("" : "+v"(F.tid), "+v"(F.lane)); }
namespace pg8 {
enum RowMap { RM_ALL66 = 0, RM_LAT64 = 1, RM_WIN68 = 2, RM_WIN66 = 3 };
struct Sched {
    int nM, nN, nwg, G, c, rm;
    __device__ __forceinline__ void init(int rm_, int N, int G_, int c_) { rm = rm_; nM = rm_ == RM_ALL66 ? 66 : rm_ == RM_LAT64 ? 64 : rm_ == RM_WIN68 ? 68 : 66; nN = N / BM; nwg = nM * nN; G = G_; c = c_; }
    __device__ __forceinline__ int rowmap(int pm) const {
        if (rm == RM_ALL66) return pm * 256;
        if (rm == RM_LAT64) return (pm >> 5) * TB + LCTX + (pm & 31) * 256;
        if (rm == RM_WIN68) { const int b = pm / 34, j = pm % 34; return b * TB + (j == 0 ? 0 : LCTX + 254 * (j - 1)); }
        { const int b = pm / 33, j = pm % 33; return b * TB + LCTX + 254 * j; }
    }
    __device__ __forceinline__ bool next(int i, Unit& u) const {
        const long L = (long)i * G + c; if (L >= nwg) return false;
        int wgid = (int)L; { const int q = nwg / NXCD, r = nwg % NXCD, xcd = wgid % NXCD, off = wgid / NXCD; wgid = (xcd < r ? xcd * (q + 1) : r * (q + 1) + (xcd - r) * q) + off; }
        const int nig = WGM * nN, gid = wgid / nig, fm = gid * WGM, gsz = (nM - fm) < WGM ? (nM - fm) : WGM;
        u.pm = fm + ((wgid % nig) % gsz); u.pn = (wgid % nig) / gsz; u.arow = rowmap(u.pm); return true;
    }
    __device__ __forceinline__ void a_ready(const Unit&) const {}
    __device__ __forceinline__ void done(const Unit&) const {}
};

__device__ __forceinline__ u32x4 pack8(const f32x4& a, const f32x4& b) { u32x4 w; w.x = cvt_pk_bf16(a[0], a[1]); w.y = cvt_pk_bf16(a[2], a[3]); w.z = cvt_pk_bf16(b[0], b[1]); w.w = cvt_pk_bf16(b[2], b[3]); return w; }

struct EpiGlaIn {
    static constexpr bool PERM = true, AFTER_DRAIN = false;
    bf16_t *Q, *K, *V, *R; const float *rcos, *rsin;
    __device__ __forceinline__ void operator()(const f32x4 (&acc)[2][2][4][2], const Unit& u, int wr, int wc, int fr, int fq) const {
        const int row0 = u.arow + wr * 64 + fr;
        if (u.pn >= 4) {
            bf16_t* base = u.pn < 8 ? V : R; const int col0 = ((u.pn & 3) * 256) + wc * 32 + 8 * fq;
#pragma unroll
            for (int ai = 0; ai < 2; ++ai)
#pragma unroll
                for (int m = 0; m < 4; ++m) { bf16_t* rowp = base + (size_t)(row0 + ai * HALF + m * 16) * 1024 + col0;
#pragma unroll
                    for (int bj = 0; bj < 2; ++bj) *(u32x4*)(rowp + bj * HALF) = pack8(acc[ai][bj][m][0], acc[ai][bj][m][1]); }
        } else {
            const bool isq = u.pn < 2; bf16_t* base = isq ? Q : K; const int col0 = (u.pn & 1) * 256 + wc * 32 + 8 * fq;
            const float sc = isq ? 0.08838834764831845f : 1.0f;
            const bool lat = (u.arow % TB) >= LCTX;
            const int half = wc >> 1, i0 = 16 * (wc & 1) + 4 * fq;
#pragma unroll
            for (int ai = 0; ai < 2; ++ai)
#pragma unroll
                for (int m = 0; m < 4; ++m) { const int row = row0 + ai * HALF + m * 16; bf16_t* rowp = base + (size_t)row * 512 + col0;
                    f32x4 cs = (f32x4){1.f, 1.f, 1.f, 1.f}, sn = (f32x4){0.f, 0.f, 0.f, 0.f};
                    if (lat) { const int pos = (row % TB) - LCTX; const int pr = half == 0 ? (pos >> 6) : (pos & 63); cs = *(const f32x4*)(rcos + pr * 32 + i0); sn = *(const f32x4*)(rsin + pr * 32 + i0); }
#pragma unroll
                    for (int bj = 0; bj < 2; ++bj) { const f32x4 x1 = acc[ai][bj][m][0], x2 = acc[ai][bj][m][1];
                        const f32x4 y1 = (x1 * cs - x2 * sn) * sc, y2 = (x1 * sn + x2 * cs) * sc;
                        *(u32x4*)(rowp + bj * HALF) = pack8(y1, y2); } }
        }
    }
};
struct EpiResid {
    static constexpr bool PERM = false, AFTER_DRAIN = false;
    const float *src_lat, *src_ctx; float *dst_lat, *dst_ctx; const float* gate;
    __device__ __forceinline__ void operator()(const f32x4 (&acc)[2][2][4][2], const Unit& u, int wr, int wc, int fr, int fq) const {
        const int b = u.arow / TB, p0 = u.arow % TB; const bool ctx = p0 < LCTX;
        const size_t rbase = ctx ? (size_t)b * LCTX : (size_t)b * NSEQ + (p0 - LCTX);
        const float* s = (ctx ? src_ctx : src_lat) + rbase * D; float* d = (ctx ? dst_ctx : dst_lat) + rbase * D;
        const float* g = gate + (ctx ? 2 : b) * 6144;
        const int col0 = u.pn * BM + wc * 32 + 4 * fq;
        f32x4 gv[2][2];
#pragma unroll
        for (int bj = 0; bj < 2; ++bj)
#pragma unroll
            for (int n = 0; n < 2; ++n) gv[bj][n] = *(const f32x4*)(g + col0 + bj * HALF + n * 16);
#pragma unroll
        for (int ai = 0; ai < 2; ++ai)
#pragma unroll
            for (int m = 0; m < 4; ++m) { const size_t off = (size_t)(ai * HALF + wr * 64 + m * 16 + fr) * D + col0;
#pragma unroll
                for (int bj = 0; bj < 2; ++bj)
#pragma unroll
                    for (int n = 0; n < 2; ++n) *(f32x4*)(d + off + bj * HALF + n * 16) = *(const f32x4*)(s + off + bj * HALF + n * 16) + gv[bj][n] * acc[ai][bj][m][n]; }
    }
};
struct EpiNaQkv {
    static constexpr bool PERM = true, AFTER_DRAIN = false;
    bf16_t* base;
    __device__ __forceinline__ void operator()(const f32x4 (&acc)[2][2][4][2], const Unit& u, int wr, int wc, int fr, int fq) const {
        const int t = u.pn >> 2; bf16_t* o = base + (size_t)t * T * 1024; const float sc = t == 0 ? 0.125f : 1.0f;
        const int row0 = u.arow + wr * 64 + fr, col0 = (u.pn & 3) * 256 + wc * 32 + 8 * fq;
#pragma unroll
        for (int ai = 0; ai < 2; ++ai)
#pragma unroll
            for (int m = 0; m < 4; ++m) { bf16_t* rowp = o + (size_t)(row0 + ai * HALF + m * 16) * 1024 + col0;
#pragma unroll
                for (int bj = 0; bj < 2; ++bj) *(u32x4*)(rowp + bj * HALF) = pack8(acc[ai][bj][m][0] * sc, acc[ai][bj][m][1] * sc); }
    }
};
__device__ __forceinline__ float dpp_ror1(float v) { return __builtin_bit_cast(float, __builtin_amdgcn_update_dpp(0, __builtin_bit_cast(int, v), 0x121, 0xf, 0xf, false)); }
__device__ __forceinline__ float dpp_rol1(float v) { return __builtin_bit_cast(float, __builtin_amdgcn_update_dpp(0, __builtin_bit_cast(int, v), 0x12F, 0xf, 0xf, false)); }
struct EpiFfnIn {
    static constexpr bool PERM = true, AFTER_DRAIN = false;
    bf16_t* U; const float *cw, *cb; PG8_LAS float* edge;
    __device__ __forceinline__ void operator()(f32x4 (&acc)[2][2][4][2], const Unit& u, int wr, int wc, int fr, int fq) const {
        const int b = u.arow / TB, p0 = u.arow % TB; const bool ctx = p0 < LCTX;
        const int seq_lo = b * TB + (ctx ? 0 : LCTX), seq_hi = b * TB + (ctx ? LCTX : TB);
        const int cl = wc * 32 + 8 * fq;
#pragma unroll
        for (int ai = 0; ai < 2; ++ai)
#pragma unroll
            for (int m = 0; m < 4; ++m) { const int row = u.arow + ai * HALF + wr * 64 + m * 16 + fr; const bool ok = row >= seq_lo && row < seq_hi;
                if (!ok) { acc[ai][0][m][0] = (f32x4){0.f, 0.f, 0.f, 0.f}; acc[ai][0][m][1] = (f32x4){0.f, 0.f, 0.f, 0.f}; } }
#pragma unroll
        for (int ai = 0; ai < 2; ++ai) { const int g = 2 * ai + wr;
            if (fr == 0) { *(PG8_LAS f32x4*)(edge + (2 * g) * 128 + cl) = acc[ai][0][0][0]; *(PG8_LAS f32x4*)(edge + (2 * g) * 128 + cl + 4) = acc[ai][0][0][1]; }
            if (fr == 15) { *(PG8_LAS f32x4*)(edge + (2 * g + 1) * 128 + cl) = acc[ai][0][3][0]; *(PG8_LAS f32x4*)(edge + (2 * g + 1) * 128 + cl + 4) = acc[ai][0][3][1]; } }
        asm volatile("s_waitcnt lgkmcnt(0)" ::: "memory"); __builtin_amdgcn_s_barrier(); asm volatile("" ::: "memory");
        const int f0 = u.pn * 128 + cl;
        f32x4 w0[2], w1[2], w2[2], bb[2];
#pragma unroll
        for (int n = 0; n < 2; ++n) { w0[n] = *(const f32x4*)(cw + f0 + 4 * n); w1[n] = *(const f32x4*)(cw + DFF + f0 + 4 * n); w2[n] = *(const f32x4*)(cw + 2 * DFF + f0 + 4 * n); bb[n] = *(const f32x4*)(cb + f0 + 4 * n); }
#pragma unroll
        for (int ai = 0; ai < 2; ++ai) { const int g = 2 * ai + wr;
            f32x4 ep[2], en[2];
#pragma unroll
            for (int n = 0; n < 2; ++n) { ep[n] = g > 0 ? *(const PG8_LAS f32x4*)(edge + (2 * (g - 1) + 1) * 128 + cl + 4 * n) : (f32x4){0.f, 0.f, 0.f, 0.f};
                                          en[n] = g < 3 ? *(const PG8_LAS f32x4*)(edge + (2 * (g + 1)) * 128 + cl + 4 * n) : (f32x4){0.f, 0.f, 0.f, 0.f}; }
#pragma unroll
            for (int m = 0; m < 4; ++m) { const int wrow = ai * HALF + wr * 64 + m * 16 + fr, row = u.arow + wrow;
                float o[8];
#pragma unroll
                for (int n = 0; n < 2; ++n)
#pragma unroll
                    for (int j = 0; j < 4; ++j) { const float cur = acc[ai][0][m][n][j];
                        const float sp = (m > 0 && fr == 15) ? acc[ai][0][m > 0 ? m - 1 : 0][n][j] : cur;
                        float pv = dpp_ror1(sp); if (m == 0) pv = fr == 0 ? ep[n][j] : pv;
                        const float sn = (m < 3 && fr == 0) ? acc[ai][0][m < 3 ? m + 1 : 3][n][j] : cur;
                        float nv = dpp_rol1(sn); if (m == 3) nv = fr == 15 ? en[n][j] : nv;
                        const float ac = pv * w0[n][j] + cur * w1[n][j] + nv * w2[n][j] + bb[n][j];
                        o[4 * n + j] = ac * __builtin_amdgcn_rcpf(1.0f + __builtin_amdgcn_exp2f(-ac * 1.4426950408889634f)) * acc[ai][1][m][n][j]; }
                const bool ok = row >= seq_lo && row < seq_hi && (wrow >= 1 || row == seq_lo) && (wrow <= 254 || row == seq_hi - 1);
                if (ok) { u32x4 w; w.x = cvt_pk_bf16(o[0], o[1]); w.y = cvt_pk_bf16(o[2], o[3]); w.z = cvt_pk_bf16(o[4], o[5]); w.w = cvt_pk_bf16(o[6], o[7]); *(u32x4*)(U + (size_t)row * DFF + f0) = w; } } }
    }
};
}

template <class CMap>
__device__ __forceinline__ void p0_transpose_item(const float* W, int K, int N, bf16* WT, LAS float* scr, int item, int lane, CMap cmap) {
    const int nblk = N / 32, kb = item / nblk, nb = item % nblk, k0 = 64 * kb, n0 = 32 * nb;
    const int srcc = cmap(n0 + (lane & 31));
#pragma unroll 8
    for (int i = 0; i < 32; ++i) { const int kk = 2 * i + (lane >> 5); scr[kk * 33 + (lane & 31)] = W[(size_t)(k0 + kk) * N + srcc]; }
    LDS_WAIT(); asm volatile("" ::: "memory");
    const int c = lane & 7;
#pragma unroll
    for (int j = 0; j < 4; ++j) { const int n = (lane >> 3) + 8 * j; const LAS float* s = scr + (8 * c) * 33 + n;
        v4u o; o.x = pk2(s[0 * 33], s[1 * 33]); o.y = pk2(s[2 * 33], s[3 * 33]); o.z = pk2(s[4 * 33], s[5 * 33]); o.w = pk2(s[6 * 33], s[7 * 33]);
        *(GAS v4u*)(WT + (size_t)(n0 + n) * K + k0 + 8 * c) = o; }
    LDS_WAIT(); asm volatile("" ::: "memory");
}
struct CmId { __device__ __forceinline__ int operator()(int c) const { return c; } };
struct CmGlaIn { __device__ __forceinline__ int operator()(int c) const { return c < 1024 ? (c & ~127) + qk_src(c & 127) : c; } };
struct CmFfnIn { __device__ __forceinline__ int operator()(int c) const { const int t = c >> 8, cl = c & 255; return cl < 128 ? 128 * t + cl : DFF + 128 * t + (cl - 128); } };

__device__ __forceinline__ void p0_prologue(Frame& F) {
    if (F.bid < 192) {
        LAS float* s = (LAS float*)F.lds;
        LAS float* part = (LAS float*)(F.lds + 12288);
        for (int e = F.tid; e < 3 * D; e += NTHR) { const int r = e / D, k = e % D; const float v = r < 2 ? F.in[I_C][r * D + k] : F.in[I_CCTX][k]; s[e] = v / (1.0f + expf(-v)); }
        __syncthreads();
        const int layer = F.bid / 96, n = (F.bid % 96) * 64 + (F.tid & 63), ks = F.tid >> 6;
        const float* w = F.in[I_ADA_W] + (size_t)layer * D * 6144 + n;
        float a0 = 0.f, a1 = 0.f, a2 = 0.f;
#pragma unroll 8
        for (int k = ks * 128; k < ks * 128 + 128; ++k) { const float wv = w[(size_t)k * 6144]; a0 += s[k] * wv; a1 += s[D + k] * wv; a2 += s[2 * D + k] * wv; }
        part[(ks * 3 + 0) * 64 + (F.tid & 63)] = a0; part[(ks * 3 + 1) * 64 + (F.tid & 63)] = a1; part[(ks * 3 + 2) * 64 + (F.tid & 63)] = a2;
        __syncthreads();
        if (F.tid < 192) { const int r = F.tid >> 6, cc = F.tid & 63; float t = 0.f;
#pragma unroll
            for (int q = 0; q < 8; ++q) t += part[(q * 3 + r) * 64 + cc];
            const int nn = (F.bid % 96) * 64 + cc;
            F.mod[((size_t)layer * 3 + r) * 6144 + nn] = t + F.in[I_ADA_B][layer * 6144 + nn]; }
        __syncthreads();
    } else if (F.bid < 200) {
        const int e = (F.bid - 192) * NTHR + F.tid; const int pos = e >> 5, i = e & 31;
        const float inv = 1.0f / powf(10000.0f, (float)(2 * i) / 64.0f); const float ang = (float)pos * inv;
        F.rcos[e] = cosf(ang); F.rsin[e] = sinf(ang);
    }
    LAS float* scr = (LAS float*)(F.lds + F.wave * 16384);
    const int gw = F.bid * NWAVES + F.wave, NGW = F.G * NWAVES;
    constexpr int I_GI = 16 * 96, I_GO = 16 * 32, I_FI = 16 * 176, I_FO = 44 * 32, I_NQ = 16 * 96, I_NO = 16 * 32;
    constexpr int NITEMS = I_GI + I_GO + 2 * I_FI + 2 * I_FO + I_NQ + I_NO;
    for (int it = gw; it < NITEMS; it += NGW) {
        int r = it;
        if (r < I_GI) { p0_transpose_item(F.in[I_GLA_WIN], D, 3072, (bf16*)((char*)F.wt + WT_GLA_IN), scr, r, F.lane, CmGlaIn{}); continue; } r -= I_GI;
        if (r < I_GO) { p0_transpose_item(F.in[I_GLA_WOUT], D, 1024, (bf16*)((char*)F.wt + WT_GLA_OUT), scr, r, F.lane, CmId{}); continue; } r -= I_GO;
        if (r < I_FI) { p0_transpose_item(F.in[I_FFN_WIN], D, 5632, (bf16*)((char*)F.wt + WT_FFN_IN0), scr, r, F.lane, CmFfnIn{}); continue; } r -= I_FI;
        if (r < I_FI) { p0_transpose_item(F.in[I_FFN_WIN] + (size_t)D * 5632, D, 5632, (bf16*)((char*)F.wt + WT_FFN_IN1), scr, r, F.lane, CmFfnIn{}); continue; } r -= I_FI;
        if (r < I_FO) { p0_transpose_item(F.in[I_FFN_WOUT], DFF, 1024, (bf16*)((char*)F.wt + WT_FFN_OUT0), scr, r, F.lane, CmId{}); continue; } r -= I_FO;
        if (r < I_FO) { p0_transpose_item(F.in[I_FFN_WOUT] + (size_t)DFF * 1024, DFF, 1024, (bf16*)((char*)F.wt + WT_FFN_OUT1), scr, r, F.lane, CmId{}); continue; } r -= I_FO;
        if (r < I_NQ) { p0_transpose_item(F.in[I_NA_WQKV], D, 3072, (bf16*)((char*)F.wt + WT_NA_QKV), scr, r, F.lane, CmId{}); continue; } r -= I_NQ;
        p0_transpose_item(F.in[I_NA_WOUT], D, 1024, (bf16*)((char*)F.wt + WT_NA_OUT), scr, r, F.lane, CmId{});
    }
}

template <bool GATE, bool FROM_INPUT>
__device__ __forceinline__ void modulate_phase(Frame& F, int layer, int which) {
    LAS _Float16* W1p = (LAS _Float16*)F.lds;
    LAS unsigned* W2p = (LAS unsigned*)(F.lds + 65536);
    LAS float* B2 = (LAS float*)(F.lds + 65536 + 32768);
    LAS _Float16* hrow = (LAS _Float16*)(F.lds + 65536 + 32768 + 4096) + F.wave * 1024;
    if (GATE) {
        const float* w1 = F.in[I_GLA_AW1];
        for (int s = F.tid; s < 32768; s += NTHR) { const int dir = s >> 14, k = (s >> 4) & 1023, j = s & 15; W1p[((k >> 3) * 32 + dir * 16 + j) * 8 + (k & 7)] = (_Float16)w1[s]; }
        const float* w2 = F.in[I_GLA_AW2];
        for (int s = F.tid; s < 8192; s += NTHR) { const int djp = s >> 9, c = s & 511, dir = djp >> 3, jp = djp & 7; const int oc = (c & ~127) + qk_src(c & 127);
            const h2 pr = (h2){(_Float16)w2[(dir * 16 + 2 * jp) * 512 + oc], (_Float16)w2[(dir * 16 + 2 * jp + 1) * 512 + oc]}; W2p[s] = __builtin_bit_cast(unsigned, pr); }
        for (int s = F.tid; s < 1024; s += NTHR) { const int dir = s >> 9, c = s & 511; B2[s] = F.in[I_GLA_AB][dir * 512 + (c & ~127) + qk_src(c & 127)]; }
        __syncthreads();
#if GATE_CHECK
        { unsigned bad = 0;
          for (int s = F.tid; s < 32768; s += NTHR) { const int dir = s >> 14, k = (s >> 4) & 1023, j = s & 15; const float got = (float)W1p[((k >> 3) * 32 + dir * 16 + j) * 8 + (k & 7)]; bad += fabsf(got - w1[s]) > 1e-3f; }
          if (bad) atomicAdd((unsigned*)((char*)F.wt - WS_WT + WS_CTL + 32768) + 4, bad); }
        __syncthreads();
#endif
    }
    const float* gn = F.in[which == 0 ? I_N1G : I_N2G] + layer * D;
    const int gw = F.bid * NWAVES + F.wave, NGW = F.G * NWAVES;
    for (int row = gw; row < T; row += NGW) {
        const float* x = FROM_INPUT ? xinrow(F, row) : (const float*)xrow(F, row);
        const float* m = F.mod + ((size_t)layer * 3 + modrow(row)) * 6144;
        const float* sh = m + (which == 0 ? 0 : 3) * D; const float* sc = m + (which == 0 ? 1 : 4) * D;
        f32x4 v[4]; float ss = 0.f;
#pragma unroll
        for (int j = 0; j < 4; ++j) { v[j] = *(const f32x4*)(x + F.lane * 4 + 256 * j); ss += (v[j][0] * v[j][0] + v[j][1] * v[j][1]) + (v[j][2] * v[j][2] + v[j][3] * v[j][3]); }
        const float rs = rsqrtf(wave_sum(ss) * (1.0f / D) + EPS);
#pragma unroll
        for (int j = 0; j < 4; ++j) { const int n = F.lane * 4 + 256 * j; const f32x4 g4 = *(const f32x4*)(gn + n), s4 = *(const f32x4*)(sc + n), h4 = *(const f32x4*)(sh + n);
            v[j] = (v[j] * rs * g4) * (s4 + 1.0f) + h4;
            v2u w; w.x = pk2(v[j][0], v[j][1]); w.y = pk2(v[j][2], v[j][3]); *(v2u*)(F.H + (size_t)row * D + n) = w;
            if (GATE) { const h2 a = (h2){(_Float16)v[j][0], (_Float16)v[j][1]}, b = (h2){(_Float16)v[j][2], (_Float16)v[j][3]};
                v2u hw2; hw2.x = __builtin_bit_cast(unsigned, a); hw2.y = __builtin_bit_cast(unsigned, b); *(LAS v2u*)(hrow + n) = hw2; } }
        if (GATE) {
            LDS_WAIT(); asm volatile("" ::: "memory");
#if GATE_CHECK == 2
            { unsigned bad = 0; const int ol = (F.lane + 1) & 63;
              for (int j = 0; j < 4; ++j) for (int t = 0; t < 4; ++t) { const float want = __shfl(v[j][t], ol); const float got = (float)hrow[ol * 4 + 256 * j + t]; bad += fabsf(got - want) > 0.01f + 0.01f * fabsf(want); }
              if (bad) atomicAdd((unsigned*)((char*)F.wt - WS_WT + WS_CTL + 32768) + 4, bad); }
#endif
            const int mo = F.lane & 31, kh = F.lane >> 5;
            float a0 = 0.f, a1 = 0.f;
#pragma unroll 8
            for (int i = 0; i < 64; ++i) { const int k8 = kh * 64 + i;
                const v4u hv = *(const LAS v4u*)(hrow + k8 * 8); const v4u wv = *(const LAS v4u*)(W1p + (k8 * 32 + mo) * 8);
                a0 = DOT2(as_h2(hv.x), as_h2(wv.x), a0, false); a1 = DOT2(as_h2(hv.y), as_h2(wv.y), a1, false);
                a0 = DOT2(as_h2(hv.z), as_h2(wv.z), a0, false); a1 = DOT2(as_h2(hv.w), as_h2(wv.w), a1, false); }
            float hsum = a0 + a1; hsum += __shfl_xor(hsum, 32);
#if GATE_NAIVE
            { float mine = 0.f;
              for (int mm = 0; mm < 32; ++mm) { float p = 0.f; const float* wq = F.in[I_GLA_AW1] + (size_t)(mm >> 4) * D * 16 + (mm & 15);
                  for (int j = 0; j < 4; ++j) for (int t = 0; t < 4; ++t) p += v[j][t] * wq[(size_t)(F.lane * 4 + 256 * j + t) * 16];
                  p = wave_sum(p); if (mo == mm) mine = p; }
              hsum = mine; }
#endif
#if MK_HYBRID
            if (F.lane < 32) ((float*)F.BIG)[(size_t)row * 32 + F.lane] = hsum;
#endif
            unsigned hwp[16];
#pragma unroll
            for (int q = 0; q < 16; ++q) { const float e0 = __builtin_bit_cast(float, __builtin_amdgcn_readlane(__builtin_bit_cast(int, hsum), 2 * q)), e1 = __builtin_bit_cast(float, __builtin_amdgcn_readlane(__builtin_bit_cast(int, hsum), 2 * q + 1));
                hwp[q] = __builtin_bit_cast(unsigned, (h2){(_Float16)e0, (_Float16)e1}); }
#pragma unroll
            for (int grp = 0; grp < 4; ++grp) { const int dir = grp >> 1, c4 = F.lane * 4 + 256 * (grp & 1);
                f32x4 xg = *(const LAS f32x4*)(B2 + dir * 512 + c4);
#pragma unroll
                for (int jp = 0; jp < 8; ++jp) { const v4u wv = *(const LAS v4u*)(W2p + (dir * 8 + jp) * 512 + c4); const h2 hp = as_h2(hwp[dir * 8 + jp]);
                    xg[0] = DOT2(hp, as_h2(wv.x), xg[0], false); xg[1] = DOT2(hp, as_h2(wv.y), xg[1], false);
                    xg[2] = DOT2(hp, as_h2(wv.z), xg[2], false); xg[3] = DOT2(hp, as_h2(wv.w), xg[3], false); }
                _Float16 o[4];
#pragma unroll
                for (int t = 0; t < 4; ++t) { const float xv = xg[t]; const float tt = __builtin_amdgcn_exp2f(-fabsf(xv) * LOG2E);
                    o[t] = (_Float16)((fminf(xv, 0.f) * LOG2E - __builtin_amdgcn_logf(1.0f + tt)) * (1.0f / 16.0f)); }
                v2u w; w.x = (unsigned)__builtin_bit_cast(unsigned short, o[0]) | ((unsigned)__builtin_bit_cast(unsigned short, o[1]) << 16); w.y = (unsigned)__builtin_bit_cast(unsigned short, o[2]) | ((unsigned)__builtin_bit_cast(unsigned short, o[3]) << 16);
                *(v2u*)(F.Gt + ((size_t)dir * T + row) * 512 + c4) = w; }
            LDS_WAIT(); asm volatile("" ::: "memory");
        }
    }
}

__device__ __forceinline__ void gla_golden_phase(Frame& F) {
    if (F.bid >= 128) return;
    LAS float* red = (LAS float*)F.lds;
    const int tid = F.tid, e = tid & 15, dg = tid >> 4;
    const int sl = F.bid & 15, h = (F.bid >> 4) & 3, b = F.bid >> 6;
    const int vcol = h * 256 + sl * 16;
    const bf16* Q = F.BIG; const bf16* K = Q + (size_t)T * 512; const bf16* V = K + (size_t)T * 512;
    for (int dir = 0; dir < 2; ++dir) {
        float S[4] = {0.f, 0.f, 0.f, 0.f};
        int par = 0;
        for (int seg = 0; seg < 2; ++seg) {
            const int n = seg == 0 ? LCTX : NSEQ; const int base = b * TB + (seg == 0 ? 0 : LCTX);
            for (int s = 0; s < n; ++s) {
                const int row = base + (dir == 0 ? s : n - 1 - s);
#if GLA_NOSTATE
                if ((s & 63) == 0) { S[0] = 0.f; S[1] = 0.f; S[2] = 0.f; S[3] = 0.f; }
#endif
                const v2u qw = *(const v2u*)(Q + (size_t)row * 512 + h * 128 + dg * 4);
                const v2u kw = *(const v2u*)(K + (size_t)row * 512 + h * 128 + dg * 4);
                const v2u gw = *(const v2u*)(F.Gt + ((size_t)dir * T + row) * 512 + h * 128 + dg * 4);
                const float v = bf2f(V[(size_t)row * 1024 + vcol + e]);
                const unsigned qa[2] = {qw.x, qw.y}, ka[2] = {kw.x, kw.y}, ga[2] = {gw.x, gw.y};
                float part = 0.f;
#pragma unroll
                for (int i = 0; i < 4; ++i) {
                    const float q = bf2f((qa[i >> 1] >> ((i & 1) * 16)) & 0xffffu), k = bf2f((ka[i >> 1] >> ((i & 1) * 16)) & 0xffffu);
                    const float g = (float)__builtin_bit_cast(_Float16, (unsigned short)((ga[i >> 1] >> ((i & 1) * 16)) & 0xffffu));
                    S[i] = __builtin_amdgcn_exp2f(g) * S[i] + k * v; part += q * S[i];
                }
                red[(par * 32 + dg) * 17 + e] = part;
                __syncthreads();
                if (tid < 16) { float o = 0.f;
#pragma unroll
                    for (int g2 = 0; g2 < 32; ++g2) o += red[(par * 32 + g2) * 17 + tid];
                    float* dst = orow(F, row) + vcol + tid;
                    if (dir == 0) *dst = o; else *dst += o; }
                par ^= 1;
            }
        }
        __syncthreads();
    }
}
__device__ __forceinline__ void gla_post_phase(Frame& F) {
    const bf16* R = F.BIG + (size_t)T * 2048;
    const float* ng = F.in[I_GLA_NG];
    const int gw = F.bid * NWAVES + F.wave, NGW = F.G * NWAVES;
    for (int row = gw; row < T; row += NGW) {
        const float* o = orow(F, row);
#pragma unroll
        for (int j = 0; j < 4; ++j) { const f32x4 v = *(const f32x4*)(o + F.lane * 4 + 256 * j);
            const float rs = rsqrtf(wave_sum((v[0] * v[0] + v[1] * v[1]) + (v[2] * v[2] + v[3] * v[3])) * (1.0f / 256.0f) + EPS);
            const f32x4 g4 = *(const f32x4*)(ng + F.lane * 4); const v2u rw = *(const v2u*)(R + (size_t)row * 1024 + F.lane * 4 + 256 * j);
            const float r0 = bf2f(rw.x & 0xffffu), r1 = bf2f(rw.x >> 16), r2 = bf2f(rw.y & 0xffffu), r3 = bf2f(rw.y >> 16);
            v2u w; w.x = pk2(v[0] * rs * g4[0] * fast_silu(r0), v[1] * rs * g4[1] * fast_silu(r1)); w.y = pk2(v[2] * rs * g4[2] * fast_silu(r2), v[3] * rs * g4[3] * fast_silu(r3));
            *(v2u*)(F.H + (size_t)row * D + F.lane * 4 + 256 * j) = w; }
    }
}
__device__ __forceinline__ void na_golden_phase(Frame& F) {
    const int grp = F.tid >> 7, t = F.tid & 127;
    LAS float* q = (LAS float*)F.lds + grp * 1024;
    LAS float* pr = q + 64;
    LAS int* krow = (LAS int*)(q + 448);
    LAS float* red = q + 832;
    const bf16* NQ = F.BIG; const bf16* NK = NQ + (size_t)T * 1024; const bf16* NV = NK + (size_t)T * 1024;
    const float* rpb = F.in[I_NA_RPB];
    const int nitems = NB * NSEQ * 16, stride = F.G * 4;
    for (int it0 = F.bid * 4; it0 < nitems; it0 += stride) {
        const int item = it0 + grp; const bool act = item < nitems;
        const int h = item & 15, tok = act ? item >> 4 : 0;
        const int b = tok / NSEQ, pos = tok % NSEQ, r = pos / GW, c = pos % GW, row = b * TB + LCTX + pos;
        int rs = r - 4; rs = rs < 0 ? 0 : (rs > 120 ? 120 : rs);
        int cs = c - 8; cs = cs < 0 ? 0 : (cs > 48 ? 48 : cs);
        if (t < 64) q[t] = bf2f(NQ[(size_t)row * 1024 + h * 64 + t]);
        __syncthreads();
        float sc[3]; float mx = -3.0e38f;
        for (int m = 0; m < 3; ++m) {
            const int idx = t + 128 * m; int kr; float bias = 0.f;
            if (idx < 128) { const int i = idx >> 4, j = idx & 15; kr = b * TB + LCTX + (rs + i) * GW + (cs + j); bias = rpb[((size_t)h * 15 + (rs + i - r + 7)) * 31 + (cs + j - c + 15)]; }
            else kr = b * TB + (idx - 128);
            krow[idx] = kr;
            const bf16* kp = NK + (size_t)kr * 1024 + h * 64;
            float s = 0.f;
            for (int d8 = 0; d8 < 8; ++d8) { const v4u w = *(const v4u*)(kp + d8 * 8);
                s += q[d8 * 8 + 0] * bf2f(w.x & 0xffffu) + q[d8 * 8 + 1] * bf2f(w.x >> 16) + q[d8 * 8 + 2] * bf2f(w.y & 0xffffu) + q[d8 * 8 + 3] * bf2f(w.y >> 16)
                   + q[d8 * 8 + 4] * bf2f(w.z & 0xffffu) + q[d8 * 8 + 5] * bf2f(w.z >> 16) + q[d8 * 8 + 6] * bf2f(w.w & 0xffffu) + q[d8 * 8 + 7] * bf2f(w.w >> 16); }
            s += bias; sc[m] = s; mx = fmaxf(mx, s);
        }
        for (int o = 32; o > 0; o >>= 1) mx = fmaxf(mx, __shfl_xor(mx, o));
        if ((t & 63) == 0) red[t >> 6] = mx;
        __syncthreads();
        mx = fmaxf(red[0], red[1]);
        __syncthreads();
        float sum = 0.f;
        for (int m = 0; m < 3; ++m) { const float e = __builtin_amdgcn_exp2f((sc[m] - mx) * LOG2E); pr[t + 128 * m] = e; sum += e; }
        for (int o = 32; o > 0; o >>= 1) sum += __shfl_xor(sum, o);
        if ((t & 63) == 0) red[t >> 6] = sum;
        __syncthreads();
        const float inv = 1.0f / (red[0] + red[1]);
        if (t < 64 && act) { float o = 0.f;
            for (int idx = 0; idx < 384; ++idx) o += pr[idx] * bf2f(NV[(size_t)krow[idx] * 1024 + h * 64 + t]);
            F.H[(size_t)row * 1024 + h * 64 + t] = (bf16)f2bf(o * inv); }
        __syncthreads();
    }
}
__device__ __forceinline__ void final_phase(Frame& F) {
    const float* fg = F.in[I_FINAL_G];
    const int gw = F.bid * NWAVES + F.wave, NGW = F.G * NWAVES;
    for (int row = gw; row < NB * NSEQ; row += NGW) {
        float* x = F.xlat + (size_t)row * D;
        f32x4 v[4]; float ss = 0.f;
#pragma unroll
        for (int j = 0; j < 4; ++j) { v[j] = *(const f32x4*)(x + F.lane * 4 + 256 * j); ss += (v[j][0] * v[j][0] + v[j][1] * v[j][1]) + (v[j][2] * v[j][2] + v[j][3] * v[j][3]); }
        const float rs = rsqrtf(wave_sum(ss) * (1.0f / D) + EPS);
#pragma unroll
        for (int j = 0; j < 4; ++j) *(f32x4*)(x + F.lane * 4 + 256 * j) = v[j] * rs * *(const f32x4*)(fg + F.lane * 4 + 256 * j);
    }
}


namespace gla {
typedef short s16x4 __attribute__((ext_vector_type(4)));
typedef short s16x8 __attribute__((ext_vector_type(8)));
typedef _Float16 f16x8 __attribute__((ext_vector_type(8)));
constexpr int PQ = 272, PV = 528, PA = 144;
constexpr int L_Q = 0, L_K = 17408, L_G = 34816, L_V = 52224, L_A = 86016, L_D = 95232, L_R = 95744, L_M = 97792;
constexpr int NSC = 33;
constexpr size_t ST_SLOT = 32768;

__device__ __forceinline__ s16x4 trread(LAS unsigned char* p) { return __builtin_amdgcn_ds_read_tr16_b64_v4i16((LAS s16x4*)p); }
__device__ __forceinline__ s16x8 cat8(s16x4 a, s16x4 b) { return __builtin_shufflevector(a, b, 0, 1, 2, 3, 4, 5, 6, 7); }
__device__ __forceinline__ f32x4 mfma_bf16(s16x8 a, s16x8 b, f32x4 c) { return __builtin_amdgcn_mfma_f32_16x16x32_bf16(a, b, c, 0, 0, 0); }
__device__ __forceinline__ f32x4 mfma_f16(f16x8 a, f16x8 b, f32x4 c) { return __builtin_amdgcn_mfma_f32_16x16x32_f16(a, b, c, 0, 0, 0); }
__device__ __forceinline__ float ex2(float x) { return __builtin_amdgcn_exp2f(x); }
typedef float f32x2_t __attribute__((ext_vector_type(2)));
typedef __bf16 bf16x2_t __attribute__((ext_vector_type(2)));
__device__ __forceinline__ unsigned cvt2(float lo, float hi) { const f32x2_t v = {lo, hi}; const bf16x2_t b = __builtin_convertvector(v, bf16x2_t); return __builtin_bit_cast(unsigned, b); }
__device__ __forceinline__ v2u pack4(float a, float b, float c, float d) { v2u w; w.x = cvt2(a, b); w.y = cvt2(c, d); return w; }
#define GLA_BAR() do { asm volatile("s_waitcnt lgkmcnt(0)" ::: "memory"); __builtin_amdgcn_s_barrier(); asm volatile("" ::: "memory"); } while (0)

__device__ __forceinline__ void mask_fill(const Frame& F) {
    for (int idx = F.tid; idx < 4096; idx += NTHR) { const int ii = idx >> 6, jj = idx & 63;
        *(LAS _Float16*)(F.lds + L_M + ii * PA + jj * 2) = jj <= ii ? (_Float16)1.0f : (_Float16)0.0f;
        *(LAS _Float16*)(F.lds + L_M + 64 * PA + ii * PA + jj * 2) = jj >= ii ? (_Float16)1.0f : (_Float16)0.0f; }
    __syncthreads();
}
__device__ __forceinline__ int opq(int v) { asm volatile("" : "+v"(v)); return v; }
struct Raw { v4u q[2], k[2], g[2], v[4]; };
template <bool NEEDQ, int PART  >
__device__ __forceinline__ void raw_load(Raw& R, const Frame& F, const bf16* Q, const bf16* K, const bf16* V, int dir, int row0, int h) {
    const int tid = opq(F.tid);
#pragma unroll
    for (int x = 0; x < 2; ++x) { const int p = tid + 512 * x, r = p >> 4, c = p & 15; const size_t o = (size_t)(row0 + r) * 512 + h * 128 + c * 8;
        if (NEEDQ && PART != 0) R.q[x] = *(const v4u*)(Q + o);
        if (PART != 1) R.k[x] = *(const v4u*)(K + o);
        if (PART != 0) R.g[x] = *(const v4u*)(F.Gt + (size_t)dir * T * 512 + o); }
    if (PART != 0) {
#pragma unroll
        for (int x = 0; x < 4; ++x) { const int p = tid + 512 * x, r = p >> 5, c = p & 31; R.v[x] = *(const v4u*)(V + (size_t)(row0 + r) * 1024 + h * 256 + c * 8); } }
}
template <bool NEEDQ>
__device__ __forceinline__ void raw_store(const Raw& R, const Frame& F) {
    const int tid = opq(F.tid);
#pragma unroll
    for (int x = 0; x < 2; ++x) { const int p = tid + 512 * x, r = p >> 4, c = p & 15; const int o = r * PQ + c * 16;
        if (NEEDQ) *(LAS v4u*)(F.lds + L_Q + o) = R.q[x];
        *(LAS v4u*)(F.lds + L_K + o) = R.k[x];
        *(LAS v4u*)(F.lds + L_G + o) = R.g[x]; }
#pragma unroll
    for (int x = 0; x < 4; ++x) { const int p = tid + 512 * x, r = p >> 5, c = p & 31; *(LAS v4u*)(F.lds + L_V + r * PV + c * 16) = R.v[x]; }
}

template <bool NEEDQ>
__device__ __forceinline__ void decay_step(const Frame& F, bool fwd, f32x4& blsum) {
    const int ln = opq(F.lane); const int w = F.wave, i = ln & 15, q4 = ln >> 4;
    f32x4 bacc[4];
#pragma unroll
    for (int it = 0; it < 4; ++it) bacc[it] = (f32x4){0.f, 0.f, 0.f, 0.f};
    s16x8 ga[2];
#pragma unroll
    for (int kb = 0; kb < 2; ++kb) { LAS unsigned char* p = F.lds + L_G + (32 * kb + 8 * q4 + (i >> 2)) * PQ + (16 * w + 4 * (i & 3)) * 2;
        const s16x4 lo = trread(p), hi = trread(p + 4 * PQ); ga[kb] = cat8(lo, hi); }
#pragma unroll
    for (int it = 0; it < 4; ++it)
#pragma unroll
        for (int kb = 0; kb < 2; ++kb) {
            const bool skip = fwd ? (kb == 1 && it < 2) : (kb == 0 && it >= 2);
            if (!skip) { const f16x8 m = *(const LAS f16x8*)(F.lds + L_M + (fwd ? 0 : 64 * PA) + (16 * it + i) * PA + (32 * kb + 8 * q4) * 2);
                bacc[it] = mfma_f16(__builtin_bit_cast(f16x8, ga[kb]), m, bacc[it]); }
        }
    const int srcl = (ln & 48) | (fwd ? 15 : 0);
    f32x4 bl; { const f32x4 t3 = bacc[3], t0 = bacc[0];
#pragma unroll
        for (int r = 0; r < 4; ++r) bl[r] = __shfl(fwd ? t3[r] : t0[r], srcl); }
    if (!NEEDQ) blsum += bl;
    if (i == 0) { f32x4 d;
#pragma unroll
        for (int r = 0; r < 4; ++r) d[r] = ex2(bl[r]);
        *(LAS f32x4*)(F.lds + L_D + (16 * w + 4 * q4) * 4) = d; }
#pragma unroll
    for (int it = 0; it < 4; ++it) { const int o = (16 * it + i) * PQ + (16 * w + 4 * q4) * 2;
        const v2u kv = *(const LAS v2u*)(F.lds + L_K + o);
        const unsigned kx = kv.x, ky = kv.y;
        const float k0 = bf2f(kx & 0xffffu), k1 = bf2f(kx >> 16), k2 = bf2f(ky & 0xffffu), k3 = bf2f(ky >> 16);
        const f32x4 b = bacc[it];
        const float e20 = ex2(-b[0]), e21 = ex2(-b[1]), e22 = ex2(-b[2]), e23 = ex2(-b[3]);
        const float e30 = ex2(bl[0] - b[0]), e31 = ex2(bl[1] - b[1]), e32 = ex2(bl[2] - b[2]), e33 = ex2(bl[3] - b[3]);
        if (NEEDQ) { const v2u qv = *(const LAS v2u*)(F.lds + L_Q + o); const unsigned qx = qv.x, qy = qv.y;
            const float q0 = bf2f(qx & 0xffffu), q1 = bf2f(qx >> 16), q2 = bf2f(qy & 0xffffu), q3 = bf2f(qy >> 16);
            *(LAS v2u*)(F.lds + L_Q + o) = pack4(q0 * ex2(b[0]), q1 * ex2(b[1]), q2 * ex2(b[2]), q3 * ex2(b[3]));
            *(LAS v2u*)(F.lds + L_K + o) = pack4(k0 * e20, k1 * e21, k2 * e22, k3 * e23); }
        *(LAS v2u*)(F.lds + L_G + o) = pack4(k0 * e30, k1 * e31, k2 * e32, k3 * e33); }
}
__device__ __forceinline__ void load_vf(const Frame& F, s16x8 (&vf)[2][2]) {
    const int ln = opq(F.lane); const int w = F.wave, i = ln & 15, q4 = ln >> 4;
#pragma unroll
    for (int kb = 0; kb < 2; ++kb)
#pragma unroll
        for (int ee = 0; ee < 2; ++ee) { LAS unsigned char* p = F.lds + L_V + (32 * kb + 8 * q4 + (i >> 2)) * PV + (16 * (2 * w + ee) + 4 * (i & 3)) * 2;
            vf[kb][ee] = cat8(trread(p), trread(p + 4 * PV)); }
}
__device__ __forceinline__ void state_update(const Frame& F, f32x4 (&S)[8][2], const s16x8 (&vf)[2][2]) {
    const int ln = opq(F.lane); const int i = ln & 15, q4 = ln >> 4;
#pragma unroll
    for (int dt = 0; dt < 8; ++dt) { const f32x4 dl = *(const LAS f32x4*)(F.lds + L_D + (16 * dt + 4 * q4) * 4);
        S[dt][0] *= dl; S[dt][1] *= dl;
#pragma unroll
        for (int kb = 0; kb < 2; ++kb) { LAS unsigned char* p = F.lds + L_G + (32 * kb + 8 * q4 + (i >> 2)) * PQ + (16 * dt + 4 * (i & 3)) * 2;
            const s16x8 kd = cat8(trread(p), trread(p + 4 * PQ));
            S[dt][0] = mfma_bf16(kd, vf[kb][0], S[dt][0]); S[dt][1] = mfma_bf16(kd, vf[kb][1], S[dt][1]); }
        if (dt & 1) asm volatile("" ::: "memory"); }
}
__device__ __forceinline__ void state_store(const Frame& F, bf16* slot, const f32x4 (&S)[8][2]) {
#pragma unroll
    for (int dt = 0; dt < 8; ++dt)
#pragma unroll
        for (int ee = 0; ee < 2; ++ee) { const f32x4 s = S[dt][ee]; *(v2u*)(slot + ((size_t)(F.wave * 16 + dt * 2 + ee) * 64 + F.lane) * 4) = pack4(s[0], s[1], s[2], s[3]); }
}
__device__ __forceinline__ void state_load(const Frame& F, const bf16* slot, f32x4 (&S)[8][2]) {
#pragma unroll
    for (int dt = 0; dt < 8; ++dt)
#pragma unroll
        for (int ee = 0; ee < 2; ++ee) { const v2u s = *(const v2u*)(slot + ((size_t)(F.wave * 16 + dt * 2 + ee) * 64 + F.lane) * 4); const unsigned sx = s.x, sy = s.y;
            S[dt][ee] = (f32x4){bf2f(sx & 0xffffu), bf2f(sx >> 16), bf2f(sy & 0xffffu), bf2f(sy >> 16)}; }
}

__device__ __forceinline__ void s1_phase(Frame& F, bf16* ST, float* DT) {
    const bf16* Q = F.BIG; const bf16* K = Q + (size_t)T * 512; const bf16* V = K + (size_t)T * 512;
    const int nitems = 16 * NSC;
    mask_fill(F);
    for (int item = F.bid; item < nitems; item += F.G) {
        const int sc = item % NSC, bhd = item / NSC, dir = bhd & 1, h = (bhd >> 1) & 3, b = bhd >> 3;
        const bool fwd = dir == 0; const int row0 = b * TB + 256 * sc;
        f32x4 S[8][2];
#pragma unroll
        for (int dt = 0; dt < 8; ++dt) { S[dt][0] = (f32x4){0.f, 0.f, 0.f, 0.f}; S[dt][1] = (f32x4){0.f, 0.f, 0.f, 0.f}; }
        f32x4 blsum = (f32x4){0.f, 0.f, 0.f, 0.f};
        Raw R; raw_load<false, 2>(R, F, Q, K, V, dir, row0 + 64 * (fwd ? 0 : 3), h);
        for (int s = 0; s < 4; ++s) {
            GLA_BAR();
            raw_store<false>(R, F);
            if (s < 3) raw_load<false, 2>(R, F, Q, K, V, dir, row0 + 64 * (fwd ? s + 1 : 2 - s), h);
            GLA_BAR();
            decay_step<false>(F, fwd, blsum);
            GLA_BAR();
            s16x8 vf[2][2]; load_vf(F, vf);
            state_update(F, S, vf);
        }
        state_store(F, ST + ((size_t)bhd * NSC + sc) * ST_SLOT, S);
        if ((F.lane & 15) == 0) { f32x4 d;
#pragma unroll
            for (int r = 0; r < 4; ++r) d[r] = ex2(blsum[r]);
            *(f32x4*)(DT + ((size_t)bhd * NSC + sc) * 128 + 16 * F.wave + 4 * (F.lane >> 4)) = d; }
    }
}
__device__ __forceinline__ int sc_order(int dir, int n) { return n == 0 ? 0 : (dir == 0 ? n : NSC - n); }
__device__ __forceinline__ void s2_phase(Frame& F, bf16* ST, const float* DT) {
    const int total = 16 * 8 * 16 * 64;
    for (int g = F.bid * NTHR + F.tid; g < total; g += F.G * NTHR) {
        const int bhd = g >> 13, rem = g & 8191, tile = (rem >> 6) & 15, lane = rem & 63, dir = bhd & 1;
        const int d0 = 16 * (tile >> 1) + 4 * (lane >> 4);
        bf16* base = ST + (size_t)bhd * NSC * ST_SLOT + (size_t)rem * 4;
        const float* dtb = DT + (size_t)bhd * NSC * 128 + d0;
        f32x4 S = (f32x4){0.f, 0.f, 0.f, 0.f};
        v2u cur = *(const v2u*)(base + (size_t)sc_order(dir, 0) * ST_SLOT);
        f32x4 dcur = *(const f32x4*)(dtb + sc_order(dir, 0) * 128);
        for (int n = 0; n < NSC; ++n) {
            const int sc = sc_order(dir, n);
            v2u nxt = cur; f32x4 dn = dcur;
            if (n + 1 < NSC) { const int s2 = sc_order(dir, n + 1); nxt = *(const v2u*)(base + (size_t)s2 * ST_SLOT); dn = *(const f32x4*)(dtb + s2 * 128); }
            *(v2u*)(base + (size_t)sc * ST_SLOT) = pack4(S[0], S[1], S[2], S[3]);
            const unsigned cx = cur.x, cy = cur.y;
            S = dcur * S + (f32x4){bf2f(cx & 0xffffu), bf2f(cx >> 16), bf2f(cy & 0xffffu), bf2f(cy >> 16)};
            cur = nxt; dcur = dn;
        }
    }
}
__device__ __forceinline__ void c_phase(Frame& F, const bf16* ST) {
    const bf16* Q = F.BIG; const bf16* K = Q + (size_t)T * 512; const bf16* V = K + (size_t)T * 512; const bf16* Rg = V + (size_t)T * 1024;
    const float* ng = F.in[I_GLA_NG];
    const int w = F.wave;
    const int nitems = 8 * NSC;
    mask_fill(F);
    for (int item = F.bid; item < nitems; item += F.G) {
        const int sc = item % NSC, bh = item / NSC, h = bh & 3, b = bh >> 2;
        const int row0 = b * TB + 256 * sc;
        for (int dir = 0; dir < 2; ++dir) {
            const bool fwd = dir == 0; const int bhd = bh * 2 + dir;
            f32x4 S[8][2]; state_load(F, ST + ((size_t)bhd * NSC + sc) * ST_SLOT, S);
#if GLA_NOSTATE
#pragma unroll
            for (int dt = 0; dt < 8; ++dt) { S[dt][0] = (f32x4){0.f, 0.f, 0.f, 0.f}; S[dt][1] = (f32x4){0.f, 0.f, 0.f, 0.f}; }
#endif
            f32x4 blsum = (f32x4){0.f, 0.f, 0.f, 0.f};
            Raw R; raw_load<true, 2>(R, F, Q, K, V, dir, row0 + 64 * (fwd ? 0 : 3), h);
            for (int s = 0; s < 4; ++s) {
                const int c = fwd ? s : 3 - s, crow0 = row0 + 64 * c;
                GLA_BAR();
                raw_store<true>(R, F);
                if (s < 3) raw_load<true, 0>(R, F, Q, K, V, dir, row0 + 64 * (fwd ? s + 1 : 2 - s), h);
                GLA_BAR();
                decay_step<true>(F, fwd, blsum);
                GLA_BAR();
#if GLA_CHECK
                if (item == 0 && dir == GLA_CHECK_DIR && s == 0) {
                    unsigned bad = 0;
                    for (int idx = F.tid; idx < 64 * 128; idx += NTHR) { const int ii = idx >> 7, dd = idx & 127; float bsum = 0.f, btot = 0.f;
                        for (int jj = 0; jj < 64; ++jj) { const float gv = (float)F.Gt[((size_t)dir * T + crow0 + jj) * 512 + h * 128 + dd]; btot += gv; if (fwd ? (jj <= ii) : (jj >= ii)) bsum += gv; }
                        const float qv = bf2f(Q[(size_t)(crow0 + ii) * 512 + h * 128 + dd]), kv = bf2f(K[(size_t)(crow0 + ii) * 512 + h * 128 + dd]);
                        const float qs = bf2f(*(const LAS bf16*)(F.lds + L_Q + ii * PQ + dd * 2)), ks = bf2f(*(const LAS bf16*)(F.lds + L_K + ii * PQ + dd * 2)), kd = bf2f(*(const LAS bf16*)(F.lds + L_G + ii * PQ + dd * 2));
                        const float eq = qv * exp2f(bsum), ek = kv * exp2f(-bsum), ed = kv * exp2f(btot - bsum);
                        bad += fabsf(qs - eq) > 0.02f * fabsf(eq) + 1e-3f; bad += fabsf(ks - ek) > 0.02f * fabsf(ek) + 1e-3f; bad += fabsf(kd - ed) > 0.02f * fabsf(ed) + 1e-3f;
                        if (ii == 0) bad += fabsf(*(const LAS float*)(F.lds + L_D + dd * 4) - exp2f(btot)) > 0.01f; }
                    if (bad) atomicOr((unsigned*)((char*)F.mod - (WS_TAB + TAB_MOD) + WS_CTL + 32768 + 64), 1u);
                }
#endif
                { const int ln = opq(F.lane); const int i = ln & 15, q4 = ln >> 4; const int jt = w >> 1;
#pragma unroll
                  for (int t2 = 0; t2 < 2; ++t2) { const int it = 2 * (w & 1) + t2; f32x4 a = (f32x4){0.f, 0.f, 0.f, 0.f};
                      const bool dead = fwd ? (jt > it) : (jt < it);
                      if (!dead) {
#pragma unroll
                          for (int kb = 0; kb < 4; ++kb) { const s16x8 kf = *(const LAS s16x8*)(F.lds + L_K + (16 * jt + i) * PQ + (32 * kb + 8 * q4) * 2); const s16x8 qf = *(const LAS s16x8*)(F.lds + L_Q + (16 * it + i) * PQ + (32 * kb + 8 * q4) * 2);
                              a = mfma_bf16(kf, qf, a); }
                          if (jt == it) {
#pragma unroll
                              for (int r = 0; r < 4; ++r) { const int j = 4 * q4 + r; if (fwd ? (j > i) : (j < i)) a[r] = 0.f; } } }
                      *(LAS v2u*)(F.lds + L_A + (16 * it + i) * PA + (16 * jt + 4 * q4) * 2) = pack4(a[0], a[1], a[2], a[3]); } }
                GLA_BAR();
#if GLA_CHECK
                if (item == 0 && dir == GLA_CHECK_DIR && s == 0) {
                    unsigned bad = 0;
                    for (int idx = F.tid; idx < 64 * 64; idx += NTHR) { const int ii = idx >> 6, jj = idx & 63; float a = 0.f;
                        for (int dd = 0; dd < 128; ++dd) a += bf2f(*(const LAS bf16*)(F.lds + L_Q + ii * PQ + dd * 2)) * bf2f(*(const LAS bf16*)(F.lds + L_K + jj * PQ + dd * 2));
                        if (!(fwd ? (jj <= ii) : (jj >= ii))) a = 0.f;
                        const float got = bf2f(*(const LAS bf16*)(F.lds + L_A + ii * PA + jj * 2));
                        bad += fabsf(got - a) > 0.02f * fabsf(a) + 2e-2f; }
                    if (bad) atomicOr((unsigned*)((char*)F.mod - (WS_TAB + TAB_MOD) + WS_CTL + 32768 + 64), 2u);
                }
#endif
                s16x8 vf[2][2]; load_vf(F, vf);
#pragma unroll 1
                for (int hf = 0; hf < 4; ++hf) {
                    const int ln = opq(F.lane); const int i = ln & 15, q4 = ln >> 4;
                    f32x4 o[2][1];
#pragma unroll
                    for (int ee = 0; ee < 2; ++ee)
#pragma unroll
                        for (int t2 = 0; t2 < 1; ++t2) o[ee][t2] = (f32x4){0.f, 0.f, 0.f, 0.f};
#pragma unroll
                    for (int t2 = 0; t2 < 1; ++t2)
#pragma unroll
                        for (int kb = 0; kb < 2; ++kb) { const s16x8 af = *(const LAS s16x8*)(F.lds + L_A + (16 * (hf + t2) + i) * PA + (32 * kb + 8 * q4) * 2);
                            o[0][t2] = mfma_bf16(vf[kb][0], af, o[0][t2]); o[1][t2] = mfma_bf16(vf[kb][1], af, o[1][t2]); }
#if GLA_CHECK
                    if (item == 0 && dir == GLA_CHECK_DIR && s == 0) {
                        unsigned bad = 0;
                        for (int ee = 0; ee < 2; ++ee) for (int r = 0; r < 4; ++r) { const int tok = 16 * hf + i, e = 16 * (2 * w + ee) + 4 * q4 + r; float a = 0.f;
                            for (int jj = 0; jj < 64; ++jj) a += bf2f(*(const LAS bf16*)(F.lds + L_A + tok * PA + jj * 2)) * bf2f(*(const LAS bf16*)(F.lds + L_V + jj * PV + e * 2));
                            const f32x4 ov = o[ee][0]; bad += fabsf(ov[r] - a) > 0.02f * fabsf(a) + 2e-2f; }
                        if (bad) atomicOr((unsigned*)((char*)F.mod - (WS_TAB + TAB_MOD) + WS_CTL + 32768 + 64), 4u);
                    }
#endif
#pragma unroll
                    for (int kb = 0; kb < 4; ++kb) {
                        s16x8 sf[2];
#pragma unroll
                        for (int ee = 0; ee < 2; ++ee) { const f32x4 lo = S[2 * kb][ee], hi = S[2 * kb + 1][ee]; v4u t; t.x = cvt2(lo[0], lo[1]); t.y = cvt2(lo[2], lo[3]); t.z = cvt2(hi[0], hi[1]); t.w = cvt2(hi[2], hi[3]); sf[ee] = __builtin_bit_cast(s16x8, t); }
#pragma unroll
                        for (int t2 = 0; t2 < 1; ++t2) { LAS unsigned char* p = F.lds + L_Q + (16 * (hf + t2) + i) * PQ + (32 * kb + 4 * q4) * 2;
                            const s16x4 lo = *(const LAS s16x4*)p, hi = *(const LAS s16x4*)(p + 32); const s16x8 qf = cat8(lo, hi);
                            o[0][t2] = mfma_bf16(sf[0], qf, o[0][t2]); o[1][t2] = mfma_bf16(sf[1], qf, o[1][t2]); } }
                    if (dir == 0) {
#pragma unroll
                        for (int t2 = 0; t2 < 1; ++t2) { float* op = orow(F, crow0 + 16 * (hf + t2) + i) + h * 256 + 16 * (2 * w) + 4 * q4;
                            *(f32x4*)op = o[0][t2]; *(f32x4*)(op + 16) = o[1][t2]; }
                    } else {
                        float ssq[1];
#pragma unroll
                        for (int t2 = 0; t2 < 1; ++t2) { const float* op = orow(F, crow0 + 16 * (hf + t2) + i) + h * 256 + 16 * (2 * w) + 4 * q4;
                            o[0][t2] += *(const f32x4*)op; o[1][t2] += *(const f32x4*)(op + 16);
                            const f32x4 a = o[0][t2], c2 = o[1][t2];
                            float ss = (a[0] * a[0] + a[1] * a[1]) + (a[2] * a[2] + a[3] * a[3]) + (c2[0] * c2[0] + c2[1] * c2[1]) + (c2[2] * c2[2] + c2[3] * c2[3]);
                            ss += __shfl_xor(ss, 16); ss += __shfl_xor(ss, 32); ssq[t2] = ss; }
                        if (q4 == 0) {
#pragma unroll
                            for (int t2 = 0; t2 < 1; ++t2) *(LAS float*)(F.lds + L_R + (w * 64 + 16 * (hf + t2) + i) * 4) = ssq[t2]; }
                        GLA_BAR();
#pragma unroll
                        for (int t2 = 0; t2 < 1; ++t2) { float tot = 0.f;
#pragma unroll
                            for (int ww = 0; ww < 8; ++ww) tot += *(const LAS float*)(F.lds + L_R + (ww * 64 + 16 * (hf + t2) + i) * 4);
                            const float rs = rsqrtf(tot * (1.0f / 256.0f) + EPS);
                            const int row = crow0 + 16 * (hf + t2) + i;
#pragma unroll
                            for (int ee = 0; ee < 2; ++ee) { const int e = 16 * (2 * w + ee) + 4 * q4; const f32x4 g4 = *(const f32x4*)(ng + e);
                                const v2u rw = *(const v2u*)(Rg + (size_t)row * 1024 + h * 256 + e); const unsigned rx = rw.x, ry = rw.y;
                                const f32x4 ov = o[ee][t2];
                                *(v2u*)(F.H + (size_t)row * D + h * 256 + e) = pack4(ov[0] * rs * g4[0] * fast_silu(bf2f(rx & 0xffffu)), ov[1] * rs * g4[1] * fast_silu(bf2f(rx >> 16)),
                                                                                   ov[2] * rs * g4[2] * fast_silu(bf2f(ry & 0xffffu)), ov[3] * rs * g4[3] * fast_silu(bf2f(ry >> 16))); } }
                    }
                }
                if (s < 3) { raw_load<true, 1>(R, F, Q, K, V, dir, row0 + 64 * (fwd ? s + 1 : 2 - s), h);
#if !GLA_NOSTATE
                    state_update(F, S, vf);
#endif
                }
            }
            GLA_BAR();
        }
    }
}
}

constexpr int NPHASE = 18;
enum { P_PRO = 0, P_MOD0, P_GIN, P_GLA_S1, P_GLA_S2, P_GLA_C, P_GOUT, P_MOD1, P_FIN0, P_FOUT0, P_MOD2, P_NQKV, P_NA, P_NOUT, P_MOD3, P_FIN1, P_FOUT1, P_FINAL, P_GOLD_GLA = 30, P_GOLD_POST = 31 };
constexpr size_t WS_ST = WS_END;
constexpr size_t TAB_DT = 256 * 1024;
static_assert(WS_ST + (size_t)16 * 33 * 32768 * 2 <= 256 * MiB, "GLA states fit");
__global__ void __launch_bounds__(NTHR, 2) mega_fwd(Args args) {
    extern __shared__ __attribute__((aligned(16))) unsigned char lds[];
    Frame F;
    F.lds = (LAS unsigned char*)lds;
    F.tid = threadIdx.x; F.lane = F.tid & 63; F.wave = __builtin_amdgcn_readfirstlane(F.tid >> 6);
    F.G = gridDim.x; F.bid = blockIdx.x;
    F.in = args.in; F.xlat = args.out;
    unsigned char* ws = args.ws;
    F.xctx = (float*)(ws + WS_XCTX); F.octx = (float*)(ws + WS_OCTX);
    F.rcos = (float*)(ws + WS_TAB + TAB_COS); F.rsin = (float*)(ws + WS_TAB + TAB_SIN); F.mod = (float*)(ws + WS_TAB + TAB_MOD);
    F.wt = (bf16*)(ws + WS_WT); F.H = (bf16*)(ws + WS_H); F.Gt = (_Float16*)(ws + WS_G); F.BIG = (bf16*)(ws + WS_BIG);
    volatile LAS unsigned* MISC = (volatile LAS unsigned*)(F.lds + MISC_OFF);
    for (int u = F.tid; u < (LDS_BYTES - MISC_OFF) / 4; u += NTHR) ((LAS unsigned*)(F.lds + MISC_OFF))[u] = 0u;
    __syncthreads();
    const int lo = args.ph_lo, hi = args.ph_hi;
    const bool multi = (hi - lo) > 1;
    XcdBarrier bar; bar.bar = (unsigned*)(ws + WS_CTL) + CW_BAR; bar.x = 0; bar.st = nullptr;
    if (multi) bar = xcd_barrier_post((unsigned*)(ws + WS_CTL) + CW_BAR, MISC + 8);
#define IN(k) (phase_fence(F), (lo <= (k) && (k) < hi))
#define SEAM(k) do { if (IN(k) && IN((k) + 1)) xcd_barrier(bar); } while (0)
    bf16* Q = F.BIG; bf16* Kq = Q + (size_t)T * 512; bf16* V = Kq + (size_t)T * 512; bf16* R = V + (size_t)T * 1024;
    PG8_LAS unsigned char* ring = (PG8_LAS unsigned char*)F.lds;
    PG8_LAS float* edge = (PG8_LAS float*)(F.lds + EDGE_OFF);
    bf16* ST = (bf16*)(ws + WS_ST); float* DT = (float*)(ws + WS_TAB + TAB_DT);

    if (IN(P_PRO)) { p0_prologue(F); } SEAM(P_PRO);
    if (IN(P_MOD0)) { modulate_phase<true, true>(F, 0, 0); } SEAM(P_MOD0);
    if (IN(P_GIN)) { pg8::Gemm g{F.H, (const bf16*)((const char*)F.wt + WT_GLA_IN), T, 3072, D}; pg8::Sched S; S.init(pg8::RM_ALL66, 3072, F.G, F.bid);
        pg8::EpiGlaIn E{Q, Kq, V, R, F.rcos, F.rsin};
        pg8::gemm_phase<pg8::EpiGlaIn, pg8::Sched, PG8_ALIGN, PG8_SP2>(ring, g, S, E); } SEAM(P_GIN);
    if (IN(P_GLA_S1)) { gla::s1_phase(F, ST, DT); } SEAM(P_GLA_S1);
    if (IN(P_GLA_S2)) { gla::s2_phase(F, ST, DT); } SEAM(P_GLA_S2);
    if (IN(P_GLA_C)) { gla::c_phase(F, ST); } SEAM(P_GLA_C);
#if MK_HYBRID
    if (IN(P_GOLD_GLA)) { gla_golden_phase(F); }
    if (IN(P_GOLD_POST)) { gla_post_phase(F); }
#endif
    if (IN(P_GOUT)) { pg8::Gemm g{F.H, (const bf16*)((const char*)F.wt + WT_GLA_OUT), T, 1024, D}; pg8::Sched S; S.init(pg8::RM_ALL66, 1024, F.G, F.bid);
        pg8::EpiResid E{F.in[I_X], F.in[I_CTX], F.xlat, F.xctx, F.mod + 0 * 3 * 6144 + 2 * D};
        pg8::gemm_phase<pg8::EpiResid, pg8::Sched, PG8_ALIGN, PG8_SP2>(ring, g, S, E); } SEAM(P_GOUT);
    if (IN(P_MOD1)) { modulate_phase<false, false>(F, 0, 1); } SEAM(P_MOD1);
    if (IN(P_FIN0)) { pg8::Gemm g{F.H, (const bf16*)((const char*)F.wt + WT_FFN_IN0), T, 5632, D}; pg8::Sched S; S.init(pg8::RM_WIN68, 5632, F.G, F.bid);
        pg8::EpiFfnIn E{F.BIG, F.in[I_FFN_CW], F.in[I_FFN_CB], edge};
        pg8::gemm_phase<pg8::EpiFfnIn, pg8::Sched, true, PG8_SP2>(ring, g, S, E); } SEAM(P_FIN0);
    if (IN(P_FOUT0)) { pg8::Gemm g{F.BIG, (const bf16*)((const char*)F.wt + WT_FFN_OUT0), T, 1024, DFF}; pg8::Sched S; S.init(pg8::RM_ALL66, 1024, F.G, F.bid);
        pg8::EpiResid E{F.xlat, F.xctx, F.xlat, F.xctx, F.mod + 0 * 3 * 6144 + 5 * D};
        pg8::gemm_phase<pg8::EpiResid, pg8::Sched, PG8_ALIGN, PG8_SP2>(ring, g, S, E); } SEAM(P_FOUT0);
    if (IN(P_MOD2)) { modulate_phase<false, false>(F, 1, 0); } SEAM(P_MOD2);
    if (IN(P_NQKV)) { pg8::Gemm g{F.H, (const bf16*)((const char*)F.wt + WT_NA_QKV), T, 3072, D}; pg8::Sched S; S.init(pg8::RM_ALL66, 3072, F.G, F.bid);
        pg8::EpiNaQkv E{F.BIG};
        pg8::gemm_phase<pg8::EpiNaQkv, pg8::Sched, PG8_ALIGN, PG8_SP2>(ring, g, S, E); } SEAM(P_NQKV);
    if (IN(P_NA)) { na_golden_phase(F); } SEAM(P_NA);
    if (IN(P_NOUT)) { pg8::Gemm g{F.H, (const bf16*)((const char*)F.wt + WT_NA_OUT), T, 1024, D}; pg8::Sched S; S.init(pg8::RM_LAT64, 1024, F.G, F.bid);
        pg8::EpiResid E{F.xlat, F.xctx, F.xlat, F.xctx, F.mod + 1 * 3 * 6144 + 2 * D};
        pg8::gemm_phase<pg8::EpiResid, pg8::Sched, PG8_ALIGN, PG8_SP2>(ring, g, S, E); } SEAM(P_NOUT);
    if (IN(P_MOD3)) { modulate_phase<false, false>(F, 1, 1); } SEAM(P_MOD3);
    if (IN(P_FIN1)) { pg8::Gemm g{F.H, (const bf16*)((const char*)F.wt + WT_FFN_IN1), T, 5632, D}; pg8::Sched S; S.init(pg8::RM_WIN66, 5632, F.G, F.bid);
        pg8::EpiFfnIn E{F.BIG, F.in[I_FFN_CW] + 3 * DFF, F.in[I_FFN_CB] + DFF, edge};
        pg8::gemm_phase<pg8::EpiFfnIn, pg8::Sched, true, PG8_SP2>(ring, g, S, E); } SEAM(P_FIN1);
    if (IN(P_FOUT1)) { pg8::Gemm g{F.BIG, (const bf16*)((const char*)F.wt + WT_FFN_OUT1), T, 1024, DFF}; pg8::Sched S; S.init(pg8::RM_LAT64, 1024, F.G, F.bid);
        pg8::EpiResid E{F.xlat, F.xctx, F.xlat, F.xctx, F.mod + 1 * 3 * 6144 + 5 * D};
        pg8::gemm_phase<pg8::EpiResid, pg8::Sched, PG8_ALIGN, PG8_SP2>(ring, g, S, E); } SEAM(P_FOUT1);
    if (IN(P_FINAL)) { final_phase(F); }
#undef IN
#undef SEAM
}


#if MK_HYBRID
namespace gold {
__global__ void __launch_bounds__(256) k_ydiff(const bf16* a, const bf16* b, float* acc, int mode) {
    float mx = 0.f;
    for (size_t i = (size_t)blockIdx.x * 256 + threadIdx.x; i < (size_t)T * D; i += (size_t)gridDim.x * 256) {
        const int row = (int)(i >> 10), col = (int)(i & 1023); bool sel = true;
        if (mode == 2) sel = (row % TB) < LCTX; if (mode == 3) sel = (row % TB) >= LCTX && (row % TB) < LCTX + 256; if (mode == 4) sel = col < 256; if (mode == 5) sel = (row % TB) >= TB - 256;
        if (sel) mx = fmaxf(mx, fabsf(bf2f(a[i]) - bf2f(b[i])));
    }
    for (int o = 32; o > 0; o >>= 1) mx = fmaxf(mx, __shfl_xor(mx, o));
    if ((threadIdx.x & 63) == 0) atomicMax((unsigned*)acc, __float_as_uint(mx));
}
__global__ void k_apply(float* out, const float* acc, float scale) { out[0] = scale * acc[0]; }
__global__ void k_apply_flags(float* out, const unsigned* flags) { out[0] = 1000.0f * (float)flags[0]; }
}
#endif

extern "C" void kernel_launch(void* const* d_in, const int* in_sizes, int n_in, void* d_out, int out_size, void* d_ws, size_t ws_size, hipStream_t stream) {
    static int grid = 0;
    if (grid == 0) {
        if (n_in != 22 || out_size != NB * NSEQ * D || ws_size < WS_END) { fprintf(stderr, "kernel_launch: unexpected shapes (n_in %d out %d ws %zu)\n", n_in, out_size, ws_size); grid = -1; return; }
        int dev = 0, cus = 0, per_cu = 0;
        if (hipGetDevice(&dev) != hipSuccess || hipDeviceGetAttribute(&cus, hipDeviceAttributeMultiprocessorCount, dev) != hipSuccess) { grid = -1; return; }
        if (hipFuncSetAttribute((const void*)mega_fwd, hipFuncAttributeMaxDynamicSharedMemorySize, LDS_BYTES) != hipSuccess) { fprintf(stderr, "kernel_launch: hipFuncSetAttribute failed\n"); grid = -1; return; }
        if (hipOccupancyMaxActiveBlocksPerMultiprocessor(&per_cu, (const void*)mega_fwd, NTHR, LDS_BYTES) != hipSuccess || per_cu < 1) { fprintf(stderr, "kernel_launch: occupancy query says %d blocks per CU\n", per_cu); (void)hipGetLastError(); grid = -1; return; }
        grid = cus;
    }
    if (grid < 0) return;
    (void)hipMemsetAsync((char*)d_ws + WS_CTL, 0, CTL_ZERO_BYTES, stream);
    Args a{};
    for (int i = 0; i < 22; ++i) a.in[i] = (const float*)d_in[i];
    a.out = (float*)d_out; a.ws = (unsigned char*)d_ws;
#if MK_HYBRID
    auto run = [&](int p) { a.ph_lo = p; a.ph_hi = p + 1; hipLaunchKernelGGL(mega_fwd, dim3(grid), dim3(NTHR), LDS_BYTES, stream, a); };
#if GLA_TEST
    float* dacc = (float*)((char*)d_ws + WS_CTL + 32768);
    run(P_PRO); run(P_MOD0); run(P_GIN); run(P_GOLD_GLA); run(P_GOLD_POST);
    (void)hipMemcpyAsync((char*)d_ws + WS_WT, (char*)d_ws + WS_H, (size_t)T * D * 2, hipMemcpyDeviceToDevice, stream);
    run(P_GLA_S1); run(P_GLA_S2); run(P_GLA_C);
    gold::k_ydiff<<<1024, 256, 0, stream>>>((const bf16*)((char*)d_ws + WS_H), (const bf16*)((char*)d_ws + WS_WT), dacc, GLA_TEST);
    (void)hipMemsetAsync(d_out, 0, (size_t)NB * NSEQ * D * 4, stream);
#if GLA_CHECK
    gold::k_apply_flags<<<1, 1, 0, stream>>>((float*)d_out, (const unsigned*)((char*)d_ws + WS_CTL + 32768 + 64));
#else
    gold::k_apply<<<1, 1, 0, stream>>>((float*)d_out, dacc, 10000.0f);
#endif
#else
    for (int p = 0; p < NPHASE; ++p) run(p);
#endif
#else
    a.ph_lo = 0; a.ph_hi = NPHASE;
    void* kargs[] = {&a};
    hipError_t e = hipLaunchCooperativeKernel((const void*)mega_fwd, dim3(grid), dim3(NTHR), kargs, LDS_BYTES, stream);
    if (e != hipSuccess) fprintf(stderr, "kernel_launch: cooperative launch failed: %s (grid %d)\n", hipGetErrorString(e), grid);
#endif
}
```

```cpp
#include <hip/hip_runtime.h>
#include <hip/hip_fp16.h>
#include <cstdint>
#include <cstdio>
#ifndef MK_HYBRID
#define MK_HYBRID 0
#endif
#ifndef GOLD_FFN_IN
#define GOLD_FFN_IN 0
#endif
#ifndef GOLD_FFN_OUT
#define GOLD_FFN_OUT 0
#endif
#ifndef GOLD_WOUT
#define GOLD_WOUT 0
#endif
#ifndef GOLD_GATE
#define GOLD_GATE 0
#endif
#ifndef GATE_NAIVE
#define GATE_NAIVE 0
#endif
#ifndef GATE_CHECK
#define GATE_CHECK 0
#endif
#ifndef GLA_TEST
#define GLA_TEST 0
#endif
#ifndef GLA_NOSTATE
#define GLA_NOSTATE 0
#endif
#ifndef GLA_CHECK
#define GLA_CHECK 0
#endif
#ifndef GLA_CHECK_DIR
#define GLA_CHECK_DIR 0
#endif
#ifndef NA_TEST
#define NA_TEST 0
#endif
namespace pg8 {
#define PG8_LAS __attribute__((address_space(3)))
typedef unsigned short bf16_t;
typedef short bf16x8 __attribute__((ext_vector_type(8)));
typedef float f32x4 __attribute__((ext_vector_type(4)));
typedef unsigned u32x4 __attribute__((ext_vector_type(4)));
constexpr int BM = 256, BK = 64, HALF = 128, HTB = HALF * BK * 2  , STAGE_BYTES = 8 * HTB, NXCD = 8, WGM = 8;

__host__ __device__ __forceinline__ int lds_byte(int r, int c) { const int st = (r >> 4) * 2 + (c >> 5), rr = r & 15, cc = c & 31, ob = rr * 64 + cc * 2; return st * 1024 + (ob ^ (((ob >> 9) & 1) << 5)); }
__host__ __device__ __forceinline__ void stage_rc(int b, int& R, int& C) { const int st = b / 1024, sb = b % 1024, swz = sb ^ (((sb >> 9) & 1) << 5); R = (st >> 1) * 16 + swz / 64; C = (st & 1) * 32 + (swz % 64) / 2; }
__host__ __device__ __forceinline__ int perm32(int rho) { const int n = rho >> 4, i = rho & 15; return 8 * (i >> 2) + 4 * n + (i & 3); }

struct Unit { int pm, pn, arow; };
struct Gemm { const bf16_t* A; const bf16_t* Bt; int M, N, K; };

__device__ __forceinline__ unsigned cvt_pk_bf16(float lo, float hi) { unsigned r; asm volatile("v_cvt_pk_bf16_f32 %0, %1, %2" : "=v"(r) : "v"(lo), "v"(hi)); return r; }

template <class Epi, class Sched, bool ALIGN_EPI = false, bool SP2 = false>
__device__ __forceinline__ void gemm_phase(PG8_LAS unsigned char* lds, const Gemm g, const Sched& S, const Epi& E) {
    const int tid = threadIdx.x, wid = __builtin_amdgcn_readfirstlane(tid >> 6), lane = tid & 63, wr = wid >> 2, wc = wid & 3, fr = lane & 15, fq = lane >> 4;
    const int K = g.K, nt = K / BK;
    unsigned voffA[2], voffB[2];
#pragma unroll
    for (int i = 0; i < 2; ++i) { int R, C; stage_rc(tid * 16 + i * 8192, R, C); const int Rb = Epi::PERM ? ((R & ~31) + perm32(R & 31)) : R;
        voffA[i] = (unsigned)(R * K + C) * 2u; voffB[i] = (unsigned)(Rb * K + C) * 2u; }
    const size_t kstep = (size_t)(BK * 2);
    const size_t hstep = (size_t)HALF * K * 2;
    const size_t tstep = 2 * hstep;
    const unsigned ldsw = (unsigned)wid * 1024u;
    const int aoff = lds_byte(wr * 64 + fr, fq * 8), boff = lds_byte(wc * 32 + fr, fq * 8);
#define PG8_SA(b, h) (((b) * 2 + (h)) * HTB)
#define PG8_SB(b, h) ((4 + (b) * 2 + (h)) * HTB)
#define PG8_STAGE(bufoff, gbase, voff) do { _Pragma("unroll") for (int _i = 0; _i < 2; ++_i) \
        __builtin_amdgcn_global_load_lds((const unsigned*)((const char*)(gbase) + (voff)[_i]), (PG8_LAS unsigned*)(lds + (bufoff) + ldsw + _i * 8192), 16, 0, 0); } while (0)
#define PG8_LDA(dst, b, h) do { _Pragma("unroll") for (int m = 0; m < 4; ++m) _Pragma("unroll") for (int k = 0; k < 2; ++k) dst[m][k] = *(const PG8_LAS bf16x8*)(lds + PG8_SA(b, h) + aoff + m * 2048 + k * 1024); } while (0)
#define PG8_LDB(dst, b, h) do { _Pragma("unroll") for (int n = 0; n < 2; ++n) _Pragma("unroll") for (int k = 0; k < 2; ++k) dst[n][k] = *(const PG8_LAS bf16x8*)(lds + PG8_SB(b, h) + boff + n * 2048 + k * 1024); } while (0)
#define PG8_MMA(ai, bj, At, Bt) do { __builtin_amdgcn_s_setprio(1); _Pragma("unroll") for (int m = 0; m < 4; ++m) _Pragma("unroll") for (int n = 0; n < 2; ++n) _Pragma("unroll") for (int k = 0; k < 2; ++k) \
        acc[ai][bj][m][n] = __builtin_amdgcn_mfma_f32_16x16x32_bf16(Bt[n][k], At[m][k], acc[ai][bj][m][n], 0, 0, 0); __builtin_amdgcn_s_setprio(0); } while (0)
#define PG8_WAIT_V(n) asm volatile("s_waitcnt vmcnt(" #n ")" ::: "memory")
#define PG8_WAIT_L(n) asm volatile("s_waitcnt lgkmcnt(" #n ")" ::: "memory")
#define PG8_BAR __builtin_amdgcn_s_barrier()
#define PG8_SCHED __builtin_amdgcn_sched_barrier(0)
    Unit cur, nxt; int ui = 0;
    if (!S.next(0, cur)) return;
    f32x4 acc[2][2][4][2];
#pragma unroll
    for (int a = 0; a < 2; ++a)
#pragma unroll
        for (int b = 0; b < 2; ++b)
#pragma unroll
            for (int m = 0; m < 4; ++m)
#pragma unroll
                for (int n = 0; n < 2; ++n) acc[a][b][m][n] = (f32x4){0.f, 0.f, 0.f, 0.f};
    bf16x8 At[4][2], B0[2][2], B1[2][2];
    const char* cA = (const char*)g.A + (size_t)cur.arow * (size_t)(K * 2); const char* cB = (const char*)g.Bt + (size_t)cur.pn * tstep;
    S.a_ready(cur);
    if constexpr (SP2) {
        PG8_STAGE(PG8_SB(0, 0), cB, voffB); PG8_STAGE(PG8_SB(0, 1), cB + hstep, voffB); PG8_STAGE(PG8_SA(0, 0), cA, voffA); PG8_STAGE(PG8_SA(0, 1), cA + hstep, voffA);
        if (wr == 1) PG8_BAR;
        PG8_WAIT_V(2); PG8_BAR;
        PG8_STAGE(PG8_SB(1, 0), cB + kstep, voffB); PG8_STAGE(PG8_SA(1, 0), cA + kstep, voffA); PG8_STAGE(PG8_SB(1, 1), cB + hstep + kstep, voffB);
        PG8_WAIT_V(6); PG8_BAR;
    } else {
        PG8_STAGE(PG8_SB(0, 0), cB, voffB); PG8_STAGE(PG8_SA(0, 0), cA, voffA); PG8_STAGE(PG8_SB(0, 1), cB + hstep, voffB); PG8_STAGE(PG8_SA(0, 1), cA + hstep, voffA);
        if (wr == 1) PG8_BAR;
        PG8_WAIT_V(4); PG8_BAR;
        PG8_STAGE(PG8_SB(1, 0), cB + kstep, voffB); PG8_STAGE(PG8_SA(1, 0), cA + kstep, voffA); PG8_STAGE(PG8_SB(1, 1), cB + hstep + kstep, voffB);
        PG8_WAIT_V(6); PG8_BAR;
    }
    for (;;) {
        const bool has_next = S.next(ui + 1, nxt);
        const char* nA = has_next ? (const char*)g.A + (size_t)nxt.arow * (size_t)(K * 2) : cA; const char* nB = has_next ? (const char*)g.Bt + (size_t)nxt.pn * tstep : cB;
        for (int t = 0; t < nt; t += 2) {
            const bool last = (t == nt - 2);
            const char* a1 = cA + (size_t)(t + 1) * kstep;
            const char* a2 = last ? nA : cA + (size_t)(t + 2) * kstep; const char* b2 = last ? nB : cB + (size_t)(t + 2) * kstep;
            const char* a3 = a2 + kstep; const char* b3 = b2 + kstep;
            if (last && has_next) S.a_ready(nxt);
            if constexpr (SP2) {
            PG8_LDB(B0, 0, 0); PG8_LDB(B1, 0, 1); PG8_SCHED; PG8_LDA(At, 0, 0); PG8_STAGE(PG8_SA(1, 1), a1 + hstep, voffA);
            PG8_WAIT_V(8); PG8_WAIT_L(0); PG8_BAR; PG8_MMA(0, 0, At, B0); PG8_MMA(0, 1, At, B1); PG8_BAR; PG8_SCHED;
            PG8_LDA(At, 0, 1); PG8_STAGE(PG8_SB(0, 0), b2, voffB); PG8_STAGE(PG8_SB(0, 1), b2 + hstep, voffB); PG8_STAGE(PG8_SA(0, 0), a2, voffA);
            PG8_WAIT_V(8); PG8_WAIT_L(0); PG8_BAR; PG8_MMA(1, 0, At, B0); PG8_MMA(1, 1, At, B1); PG8_BAR; PG8_SCHED;
            PG8_LDB(B0, 1, 0); PG8_LDB(B1, 1, 1); PG8_SCHED; PG8_LDA(At, 1, 0); PG8_STAGE(PG8_SA(0, 1), a2 + hstep, voffA);
            PG8_WAIT_V(8); PG8_WAIT_L(0); PG8_BAR; PG8_MMA(0, 0, At, B0); PG8_MMA(0, 1, At, B1); PG8_BAR; PG8_SCHED;
            PG8_LDA(At, 1, 1); PG8_STAGE(PG8_SB(1, 0), b3, voffB); PG8_STAGE(PG8_SB(1, 1), b3 + hstep, voffB); PG8_STAGE(PG8_SA(1, 0), a3, voffA);
            PG8_WAIT_V(8); PG8_WAIT_L(0); PG8_BAR; PG8_MMA(1, 0, At, B0); PG8_MMA(1, 1, At, B1); PG8_BAR; PG8_SCHED;
            } else {
            PG8_LDB(B0, 0, 0); PG8_SCHED; PG8_LDA(At, 0, 0); PG8_STAGE(PG8_SA(1, 1), a1 + hstep, voffA);
            PG8_WAIT_L(8); PG8_BAR; PG8_WAIT_L(0); PG8_MMA(0, 0, At, B0); PG8_BAR; PG8_SCHED;
            PG8_LDB(B1, 0, 1); PG8_STAGE(PG8_SB(0, 0), b2, voffB);
            PG8_BAR; PG8_WAIT_L(0); PG8_MMA(0, 1, At, B1); PG8_BAR;
            PG8_LDA(At, 0, 1); PG8_STAGE(PG8_SA(0, 0), a2, voffA);
            PG8_BAR; PG8_WAIT_L(0); PG8_MMA(1, 0, At, B0); PG8_BAR; PG8_SCHED;
            PG8_STAGE(PG8_SB(0, 1), b2 + hstep, voffB);
            PG8_WAIT_V(6); PG8_BAR; PG8_MMA(1, 1, At, B1); PG8_BAR;
            PG8_LDB(B0, 1, 0); PG8_SCHED; PG8_LDA(At, 1, 0); PG8_STAGE(PG8_SA(0, 1), a2 + hstep, voffA);
            PG8_WAIT_L(8); PG8_BAR; PG8_WAIT_L(0); PG8_MMA(0, 0, At, B0); PG8_BAR; PG8_SCHED;
            PG8_LDB(B1, 1, 1); PG8_STAGE(PG8_SB(1, 0), b3, voffB);
            PG8_BAR; PG8_WAIT_L(0); PG8_MMA(0, 1, At, B1); PG8_BAR;
            PG8_LDA(At, 1, 1); PG8_STAGE(PG8_SA(1, 0), a3, voffA);
            PG8_BAR; PG8_WAIT_L(0); PG8_MMA(1, 0, At, B0); PG8_BAR; PG8_SCHED;
            PG8_STAGE(PG8_SB(1, 1), b3 + hstep, voffB);
            PG8_WAIT_V(6); PG8_BAR; PG8_MMA(1, 1, At, B1); PG8_BAR;
            }
        }
        if constexpr (ALIGN_EPI) { if (wr == 0) PG8_BAR; }
        if constexpr (!Epi::AFTER_DRAIN) { E(acc, cur, wr, wc, fr, fq); S.done(cur); }
        if (!has_next) break;
#pragma unroll
        for (int a = 0; a < 2; ++a)
#pragma unroll
            for (int b = 0; b < 2; ++b)
#pragma unroll
                for (int m = 0; m < 4; ++m)
#pragma unroll
                    for (int n = 0; n < 2; ++n) acc[a][b][m][n] = (f32x4){0.f, 0.f, 0.f, 0.f};
        cur = nxt; cA = nA; cB = nB; ++ui;
        if constexpr (ALIGN_EPI) { if (wr == 1) PG8_BAR; }
    }
    PG8_WAIT_V(0);
    if constexpr (!ALIGN_EPI) { if (wr == 0) PG8_BAR; }
    PG8_BAR;
    if constexpr (Epi::AFTER_DRAIN) { E.fused(acc, cur, wr, wc, fr, fq, lds, wid, lane); S.done(cur); }
#undef PG8_SA
#undef PG8_SB
#undef PG8_STAGE
#undef PG8_LDA
#undef PG8_LDB
#undef PG8_MMA
#undef PG8_WAIT_V
#undef PG8_WAIT_L
#undef PG8_BAR
#undef PG8_SCHED
}
}

#ifndef PG8_SP2
#define PG8_SP2 true
#endif
#ifndef PG8_ALIGN
#define PG8_ALIGN true
#endif

constexpr int NWAVES = 8, NTHR = 512;
constexpr int D = 1024, NB = 2, NSEQ = 8192, LCTX = 256, TB = LCTX + NSEQ  , T = NB * TB  ;
constexpr int DFF = 2816, GW = 64;
constexpr float EPS = 1e-6f;
constexpr float LOG2E = 1.4426950408889634f;

#define LAS __attribute__((address_space(3)))
#define GAS __attribute__((address_space(1)))
typedef unsigned short bf16;
typedef unsigned v4u __attribute__((ext_vector_type(4)));
typedef unsigned v2u __attribute__((ext_vector_type(2)));
typedef float f32x4 __attribute__((ext_vector_type(4)));
typedef _Float16 h2 __attribute__((ext_vector_type(2)));
typedef GAS unsigned gu32;
#define RLX_AGENT __ATOMIC_RELAXED, __HIP_MEMORY_SCOPE_AGENT
#define LDS_WAIT() asm volatile("s_waitcnt lgkmcnt(0)" ::: "memory")
#define VM_WAIT() asm volatile("s_waitcnt vmcnt(0)" ::: "memory")

constexpr size_t MiB = 1u << 20;
constexpr size_t WS_CTL = 0, CTL_ZERO_BYTES = 64 * 1024;
constexpr size_t WS_TAB = 1 * MiB;
constexpr size_t TAB_COS = 0, TAB_SIN = 16384, TAB_MOD = 32768;
constexpr size_t WS_XCTX = 2 * MiB;
constexpr size_t WS_OCTX = 4 * MiB;
constexpr size_t WS_WT = 6 * MiB;
constexpr size_t WT_GLA_IN = 0, WT_GLA_OUT = 6 * MiB, WT_FFN_IN0 = 8 * MiB, WT_FFN_IN1 = 19 * MiB, WT_FFN_OUT0 = 30 * MiB, WT_FFN_OUT1 = 30 * MiB + 5632 * 1024, WT_NA_QKV = 41 * MiB, WT_NA_OUT = 47 * MiB;
constexpr size_t WS_H = 55 * MiB;
constexpr size_t WS_G = WS_H + 33 * MiB + MiB / 2;
constexpr size_t WS_BIG = WS_G + 33 * MiB;
constexpr size_t WS_END = WS_BIG + 99 * MiB;
static_assert(WS_END <= 256 * MiB, "ws map");
constexpr int CW_BAR = 1024;

constexpr int RING_BYTES = 131072;
constexpr int EDGE_OFF = RING_BYTES;
constexpr int MISC_OFF = RING_BYTES + 8192;
constexpr int LDS_BYTES = 147456;

__device__ __forceinline__ unsigned f2bf(float f) { unsigned u = __builtin_bit_cast(unsigned, f); return (u + 0x7fffu + ((u >> 16) & 1u)) >> 16; }
__device__ __forceinline__ unsigned pk2(float lo, float hi) { return f2bf(lo) | (f2bf(hi) << 16); }
__device__ __forceinline__ float bf2f(unsigned v) { return __builtin_bit_cast(float, v << 16); }
__device__ __forceinline__ float wave_sum(float v) {
#pragma unroll
    for (int o = 1; o < 64; o <<= 1) v += __shfl_xor(v, o);
    return v;
}
__device__ __forceinline__ float fast_silu(float x) { return x * __builtin_amdgcn_rcpf(1.0f + __builtin_amdgcn_exp2f(-x * LOG2E)); }


__device__ __forceinline__ h2 as_h2(unsigned u) { return __builtin_bit_cast(h2, u); }
#ifndef USE_FDOT2
#define USE_FDOT2 1
#endif
__device__ __forceinline__ float dot2_impl(h2 a, h2 b, float c) {
#if USE_FDOT2
    return __builtin_amdgcn_fdot2(a, b, c, false);
#else
    return c + (float)a[0] * (float)b[0] + (float)a[1] * (float)b[1];
#endif
}
#define DOT2(a, b, c, cl) dot2_impl((a), (b), (c))

#define XB_TMO      128
#define XB_XCNT(j)  (256  + 64 * (j))
#define XB_XSUB(j)  (1280 + 64 * (j))
#define XB_XGEN(j)  (2304 + 64 * (j))
#define XB_TOP      3328
#define XB_TOPGEN   3392
#define XCD_BAR_WORDS 3456
#define XB_SPIN_CAP (1u << 23)
__device__ __forceinline__ unsigned xb_ld(unsigned* p)              { return __hip_atomic_load(p, __ATOMIC_RELAXED, __HIP_MEMORY_SCOPE_AGENT); }
__device__ __forceinline__ unsigned xb_add(unsigned* p, unsigned v) { return __hip_atomic_fetch_add(p, v, __ATOMIC_RELAXED, __HIP_MEMORY_SCOPE_AGENT); }
__device__ __forceinline__ unsigned xb_xcc_id() { return (unsigned)__builtin_amdgcn_s_getreg((3 << 11) | 20) & 0xFu; }
#define XB_SPIN(cond, bar) do { unsigned _sp = 0; while (cond) { __builtin_amdgcn_s_sleep(1); \
    if ((++_sp & 255u) == 0u) { if (xb_ld(&(bar)[XB_TMO])) break; if (_sp > XB_SPIN_CAP) { atomicAdd(&(bar)[XB_TMO], 1u); break; } } } } while (0)
struct XcdBarrier { unsigned* bar; unsigned x; volatile LAS unsigned* st; };
__device__ __forceinline__ XcdBarrier xcd_barrier_post(unsigned* bar, volatile LAS unsigned* st) {
    XcdBarrier b; b.bar = bar; b.x = xb_xcc_id(); b.st = st;
    if (threadIdx.x == 0) (void)xb_add(&bar[XB_XCNT(b.x)], 1u);
    return b;
}
__device__ __forceinline__ void xcd_barrier_complete(unsigned* bar, unsigned x, unsigned& nloc, unsigned& nx) {
    const unsigned G = gridDim.x * gridDim.y * gridDim.z;
    unsigned sum, cnt, mine, sp = 0u;
    for (;;) {
        sum = 0u; cnt = 0u; mine = 0u;
#pragma unroll
        for (unsigned j = 0; j < 16; ++j) { const unsigned c = xb_ld(&bar[XB_XCNT(j)]); sum += c; cnt += (c > 0u) ? 1u : 0u; mine = (j == x) ? c : mine; }
        if (sum == G) break;
        __builtin_amdgcn_s_sleep(1);
        if ((++sp & 255u) == 0u) { if (xb_ld(&bar[XB_TMO])) break; if (sp > XB_SPIN_CAP) { atomicAdd(&bar[XB_TMO], 1u); break; } }
    }
    nloc = mine > 0u ? mine : 1u; nx = cnt > 0u ? cnt : 1u;
}
__device__ __forceinline__ void xcd_barrier(const XcdBarrier& b) {
    asm volatile("s_waitcnt vmcnt(0)" ::: "memory");
    __syncthreads();
    if (threadIdx.x == 0) {
        unsigned* bar = b.bar;
        __builtin_amdgcn_s_waitcnt(0);
        unsigned nloc = b.st[0], nx = b.st[1];
        if (nloc == 0u) { xcd_barrier_complete(bar, b.x, nloc, nx); b.st[0] = nloc; b.st[1] = nx; }
        const unsigned old = xb_add(&bar[XB_XSUB(b.x)], 1u);
        const unsigned gen = old / nloc;
        if (old + 1u == (gen + 1u) * nloc) {
            __builtin_amdgcn_fence(__ATOMIC_RELEASE, "agent");
            asm volatile("s_waitcnt vmcnt(0)" ::: "memory");
            const unsigned og = xb_add(&bar[XB_TOP], 1u);
            const unsigned tg = og / nx;
            if (og + 1u == (tg + 1u) * nx) xb_add(&bar[XB_TOPGEN], 1u);
            else XB_SPIN(xb_ld(&bar[XB_TOPGEN]) == tg, bar);
            __builtin_amdgcn_fence(__ATOMIC_ACQUIRE, "agent");
            xb_add(&bar[XB_XGEN(b.x)], 1u);
            asm volatile("s_waitcnt vmcnt(0)" ::: "memory");
        } else {
            XB_SPIN(xb_ld(&bar[XB_XGEN(b.x)]) == gen, bar);
            __builtin_amdgcn_fence(__ATOMIC_ACQUIRE, "agent");
            asm volatile("s_waitcnt vmcnt(0)" ::: "memory");
        }
    }
    __syncthreads();
}

struct Args { const float* in[22]; float* out; unsigned char* ws; int ph_lo, ph_hi; };
enum { I_X = 0, I_C, I_CTX, I_CCTX, I_ADA_W, I_ADA_B, I_N1G, I_N2G, I_FFN_WIN, I_FFN_CW, I_FFN_CB, I_FFN_WOUT, I_GLA_WIN, I_GLA_AW1, I_GLA_AW2, I_GLA_AB, I_GLA_NG, I_GLA_WOUT, I_NA_WQKV, I_NA_RPB, I_NA_WOUT, I_FINAL_G };

struct Frame {
    LAS unsigned char* lds;
    int tid, lane, wave, G, bid;
    const float* const* in;
    float* xlat; float* xctx; float* octx;
    float *rcos, *rsin, *mod;
    bf16 *wt; bf16 *H; _Float16* Gt; bf16* BIG;
};
__device__ __forceinline__ float* xrow(const Frame& F, int row) { const int b = row / TB, p = row % TB; return p < LCTX ? F.xctx + (size_t)(b * LCTX + p) * D : F.xlat + (size_t)(b * NSEQ + p - LCTX) * D; }
__device__ __forceinline__ float* orow(const Frame& F, int row) { const int b = row / TB, p = row % TB; return p < LCTX ? F.octx + (size_t)(b * LCTX + p) * D : F.xlat + (size_t)(b * NSEQ + p - LCTX) * D; }
__device__ __forceinline__ const float* xinrow(const Frame& F, int row) { const int b = row / TB, p = row % TB; return p < LCTX ? F.in[I_CTX] + (size_t)(b * LCTX + p) * D : F.in[I_X] + (size_t)(b * NSEQ + p - LCTX) * D; }
__device__ __forceinline__ int modrow(int row) { const int b = row / TB, p = row % TB; return p < LCTX ? 2 : b; }
__device__ __forceinline__ int qk_src(int cl) { const int grp = cl >> 3, within = cl & 7, pi = grp * 4 + (within & 3), x2 = within >> 2; return (pi >> 5) * 64 + x2 * 32 + (pi & 31); }

__device__ __forceinline__ void phase_fence(Frame& F) { asm volatile("" : "+v"(F.tid), "+v"(F.lane)); }
namespace pg8 {
enum RowMap { RM_ALL66 = 0, RM_LAT64 = 1, RM_WIN68 = 2, RM_WIN66 = 3 };
struct Sched {
    int nM, nN, nwg, G, c, rm;
    __device__ __forceinline__ void init(int rm_, int N, int G_, int c_) { rm = rm_; nM = rm_ == RM_ALL66 ? 66 : rm_ == RM_LAT64 ? 64 : rm_ == RM_WIN68 ? 68 : 66; nN = N / BM; nwg = nM * nN; G = G_; c = c_; }
    __device__ __forceinline__ int rowmap(int pm) const {
        if (rm == RM_ALL66) return pm * 256;
        if (rm == RM_LAT64) return (pm >> 5) * TB + LCTX + (pm & 31) * 256;
        if (rm == RM_WIN68) { const int b = pm / 34, j = pm % 34; return b * TB + (j == 0 ? 0 : LCTX + 254 * (j - 1)); }
        { const int b = pm / 33, j = pm % 33; return b * TB + LCTX + 254 * j; }
    }
    __device__ __forceinline__ bool next(int i, Unit& u) const {
        const long L = (long)i * G + c; if (L >= nwg) return false;
        int wgid = (int)L; { const int q = nwg / NXCD, r = nwg % NXCD, xcd = wgid % NXCD, off = wgid / NXCD; wgid = (xcd < r ? xcd * (q + 1) : r * (q + 1) + (xcd - r) * q) + off; }
        const int nig = WGM * nN, gid = wgid / nig, fm = gid * WGM, gsz = (nM - fm) < WGM ? (nM - fm) : WGM;
        u.pm = fm + ((wgid % nig) % gsz); u.pn = (wgid % nig) / gsz; u.arow = rowmap(u.pm); return true;
    }
    __device__ __forceinline__ void a_ready(const Unit&) const {}
    __device__ __forceinline__ void done(const Unit&) const {}
};

__device__ __forceinline__ u32x4 pack8(const f32x4& a, const f32x4& b) { u32x4 w; w.x = cvt_pk_bf16(a[0], a[1]); w.y = cvt_pk_bf16(a[2], a[3]); w.z = cvt_pk_bf16(b[0], b[1]); w.w = cvt_pk_bf16(b[2], b[3]); return w; }

struct EpiGlaIn {
    static constexpr bool PERM = true, AFTER_DRAIN = false;
    bf16_t *Q, *K, *V, *R; const float *rcos, *rsin;
    __device__ __forceinline__ void operator()(const f32x4 (&acc)[2][2][4][2], const Unit& u, int wr, int wc, int fr, int fq) const {
        const int row0 = u.arow + wr * 64 + fr;
        if (u.pn >= 4) {
            bf16_t* base = u.pn < 8 ? V : R; const int col0 = ((u.pn & 3) * 256) + wc * 32 + 8 * fq;
#pragma unroll
            for (int ai = 0; ai < 2; ++ai)
#pragma unroll
                for (int m = 0; m < 4; ++m) { bf16_t* rowp = base + (size_t)(row0 + ai * HALF + m * 16) * 1024 + col0;
#pragma unroll
                    for (int bj = 0; bj < 2; ++bj) *(u32x4*)(rowp + bj * HALF) = pack8(acc[ai][bj][m][0], acc[ai][bj][m][1]); }
        } else {
            const bool isq = u.pn < 2; bf16_t* base = isq ? Q : K; const int col0 = (u.pn & 1) * 256 + wc * 32 + 8 * fq;
            const float sc = isq ? 0.08838834764831845f : 1.0f;
            const bool lat = (u.arow % TB) >= LCTX;
            const int half = wc >> 1, i0 = 16 * (wc & 1) + 4 * fq;
#pragma unroll
            for (int ai = 0; ai < 2; ++ai)
#pragma unroll
                for (int m = 0; m < 4; ++m) { const int row = row0 + ai * HALF + m * 16; bf16_t* rowp = base + (size_t)row * 512 + col0;
                    f32x4 cs = (f32x4){1.f, 1.f, 1.f, 1.f}, sn = (f32x4){0.f, 0.f, 0.f, 0.f};
                    if (lat) { const int pos = (row % TB) - LCTX; const int pr = half == 0 ? (pos >> 6) : (pos & 63); cs = *(const f32x4*)(rcos + pr * 32 + i0); sn = *(const f32x4*)(rsin + pr * 32 + i0); }
#pragma unroll
                    for (int bj = 0; bj < 2; ++bj) { const f32x4 x1 = acc[ai][bj][m][0], x2 = acc[ai][bj][m][1];
                        const f32x4 y1 = (x1 * cs - x2 * sn) * sc, y2 = (x1 * sn + x2 * cs) * sc;
                        *(u32x4*)(rowp + bj * HALF) = pack8(y1, y2); } }
        }
    }
};
struct EpiResid {
    static constexpr bool PERM = false, AFTER_DRAIN = false;
    const float *src_lat, *src_ctx; float *dst_lat, *dst_ctx; const float* gate;
    __device__ __forceinline__ void operator()(const f32x4 (&acc)[2][2][4][2], const Unit& u, int wr, int wc, int fr, int fq) const {
        const int b = u.arow / TB, p0 = u.arow % TB; const bool ctx = p0 < LCTX;
        const size_t rbase = ctx ? (size_t)b * LCTX : (size_t)b * NSEQ + (p0 - LCTX);
        const float* s = (ctx ? src_ctx : src_lat) + rbase * D; float* d = (ctx ? dst_ctx : dst_lat) + rbase * D;
        const float* g = gate + (ctx ? 2 : b) * 6144;
        const int col0 = u.pn * BM + wc * 32 + 4 * fq;
        f32x4 gv[2][2];
#pragma unroll
        for (int bj = 0; bj < 2; ++bj)
#pragma unroll
            for (int n = 0; n < 2; ++n) gv[bj][n] = *(const f32x4*)(g + col0 + bj * HALF + n * 16);
#pragma unroll
        for (int ai = 0; ai < 2; ++ai)
#pragma unroll
            for (int m = 0; m < 4; ++m) { const size_t off = (size_t)(ai * HALF + wr * 64 + m * 16 + fr) * D + col0;
#pragma unroll
                for (int bj = 0; bj < 2; ++bj)
#pragma unroll
                    for (int n = 0; n < 2; ++n) *(f32x4*)(d + off + bj * HALF + n * 16) = *(const f32x4*)(s + off + bj * HALF + n * 16) + gv[bj][n] * acc[ai][bj][m][n]; }
    }
};
struct EpiNaQkv {
    static constexpr bool PERM = true, AFTER_DRAIN = false;
    bf16_t* base;
    __device__ __forceinline__ void operator()(const f32x4 (&acc)[2][2][4][2], const Unit& u, int wr, int wc, int fr, int fq) const {
        const int t = u.pn >> 2; bf16_t* o = base + (size_t)t * T * 1024; const float sc = t == 0 ? 0.125f : 1.0f;
        const int row0 = u.arow + wr * 64 + fr, col0 = (u.pn & 3) * 256 + wc * 32 + 8 * fq;
#pragma unroll
        for (int ai = 0; ai < 2; ++ai)
#pragma unroll
            for (int m = 0; m < 4; ++m) { bf16_t* rowp = o + (size_t)(row0 + ai * HALF + m * 16) * 1024 + col0;
#pragma unroll
                for (int bj = 0; bj < 2; ++bj) *(u32x4*)(rowp + bj * HALF) = pack8(acc[ai][bj][m][0] * sc, acc[ai][bj][m][1] * sc); }
    }
};
__device__ __forceinline__ float dpp_ror1(float v) { return __builtin_bit_cast(float, __builtin_amdgcn_update_dpp(0, __builtin_bit_cast(int, v), 0x121, 0xf, 0xf, false)); }
__device__ __forceinline__ float dpp_rol1(float v) { return __builtin_bit_cast(float, __builtin_amdgcn_update_dpp(0, __builtin_bit_cast(int, v), 0x12F, 0xf, 0xf, false)); }
struct EpiFfnIn {
    static constexpr bool PERM = true, AFTER_DRAIN = false;
    bf16_t* U; const float *cw, *cb; PG8_LAS float* edge;
    __device__ __forceinline__ void operator()(f32x4 (&acc)[2][2][4][2], const Unit& u, int wr, int wc, int fr, int fq) const {
        const int b = u.arow / TB, p0 = u.arow % TB; const bool ctx = p0 < LCTX;
        const int seq_lo = b * TB + (ctx ? 0 : LCTX), seq_hi = b * TB + (ctx ? LCTX : TB);
        const int cl = wc * 32 + 8 * fq;
#pragma unroll
        for (int ai = 0; ai < 2; ++ai)
#pragma unroll
            for (int m = 0; m < 4; ++m) { const int row = u.arow + ai * HALF + wr * 64 + m * 16 + fr; const bool ok = row >= seq_lo && row < seq_hi;
                if (!ok) { acc[ai][0][m][0] = (f32x4){0.f, 0.f, 0.f, 0.f}; acc[ai][0][m][1] = (f32x4){0.f, 0.f, 0.f, 0.f}; } }
#pragma unroll
        for (int ai = 0; ai < 2; ++ai) { const int g = 2 * ai + wr;
            if (fr == 0) { *(PG8_LAS f32x4*)(edge + (2 * g) * 128 + cl) = acc[ai][0][0][0]; *(PG8_LAS f32x4*)(edge + (2 * g) * 128 + cl + 4) = acc[ai][0][0][1]; }
            if (fr == 15) { *(PG8_LAS f32x4*)(edge + (2 * g + 1) * 128 + cl) = acc[ai][0][3][0]; *(PG8_LAS f32x4*)(edge + (2 * g + 1) * 128 + cl + 4) = acc[ai][0][3][1]; } }
        asm volatile("s_waitcnt lgkmcnt(0)" ::: "memory"); __builtin_amdgcn_s_barrier(); asm volatile("" ::: "memory");
        const int f0 = u.pn * 128 + cl;
        f32x4 w0[2], w1[2], w2[2], bb[2];
#pragma unroll
        for (int n = 0; n < 2; ++n) { w0[n] = *(const f32x4*)(cw + f0 + 4 * n); w1[n] = *(const f32x4*)(cw + DFF + f0 + 4 * n); w2[n] = *(const f32x4*)(cw + 2 * DFF + f0 + 4 * n); bb[n] = *(const f32x4*)(cb + f0 + 4 * n); }
#pragma unroll
        for (int ai = 0; ai < 2; ++ai) { const int g = 2 * ai + wr;
            f32x4 ep[2], en[2];
#pragma unroll
            for (int n = 0; n < 2; ++n) { ep[n] = g > 0 ? *(const PG8_LAS f32x4*)(edge + (2 * (g - 1) + 1) * 128 + cl + 4 * n) : (f32x4){0.f, 0.f, 0.f, 0.f};
                                          en[n] = g < 3 ? *(const PG8_LAS f32x4*)(edge + (2 * (g + 1)) * 128 + cl + 4 * n) : (f32x4){0.f, 0.f, 0.f, 0.f}; }
#pragma unroll
            for (int m = 0; m < 4; ++m) { const int wrow = ai * HALF + wr * 64 + m * 16 + fr, row = u.arow + wrow;
                float o[8];
#pragma unroll
                for (int n = 0; n < 2; ++n)
#pragma unroll
                    for (int j = 0; j < 4; ++j) { const float cur = acc[ai][0][m][n][j];
                        const float sp = (m > 0 && fr == 15) ? acc[ai][0][m > 0 ? m - 1 : 0][n][j] : cur;
                        float pv = dpp_ror1(sp); if (m == 0) pv = fr == 0 ? ep[n][j] : pv;
                        const float sn = (m < 3 && fr == 0) ? acc[ai][0][m < 3 ? m + 1 : 3][n][j] : cur;
                        float nv = dpp_rol1(sn); if (m == 3) nv = fr == 15 ? en[n][j] : nv;
                        const float ac = pv * w0[n][j] + cur * w1[n][j] + nv * w2[n][j] + bb[n][j];
                        o[4 * n + j] = ac * __builtin_amdgcn_rcpf(1.0f + __builtin_amdgcn_exp2f(-ac * 1.4426950408889634f)) * acc[ai][1][m][n][j]; }
                const bool ok = row >= seq_lo && row < seq_hi && (wrow >= 1 || row == seq_lo) && (wrow <= 254 || row == seq_hi - 1);
                if (ok) { u32x4 w; w.x = cvt_pk_bf16(o[0], o[1]); w.y = cvt_pk_bf16(o[2], o[3]); w.z = cvt_pk_bf16(o[4], o[5]); w.w = cvt_pk_bf16(o[6], o[7]); *(u32x4*)(U + (size_t)row * DFF + f0) = w; } } }
    }
};
}

template <class CMap>
__device__ __forceinline__ void p0_transpose_item(const float* W, int K, int N, bf16* WT, LAS float* scr, int item, int lane, CMap cmap) {
    const int nblk = N / 32, kb = item / nblk, nb = item % nblk, k0 = 64 * kb, n0 = 32 * nb;
    const int srcc = cmap(n0 + (lane & 31));
#pragma unroll 8
    for (int i = 0; i < 32; ++i) { const int kk = 2 * i + (lane >> 5); scr[kk * 33 + (lane & 31)] = W[(size_t)(k0 + kk) * N + srcc]; }
    LDS_WAIT(); asm volatile("" ::: "memory");
    const int c = lane & 7;
#pragma unroll
    for (int j = 0; j < 4; ++j) { const int n = (lane >> 3) + 8 * j; const LAS float* s = scr + (8 * c) * 33 + n;
        v4u o; o.x = pk2(s[0 * 33], s[1 * 33]); o.y = pk2(s[2 * 33], s[3 * 33]); o.z = pk2(s[4 * 33], s[5 * 33]); o.w = pk2(s[6 * 33], s[7 * 33]);
        *(GAS v4u*)(WT + (size_t)(n0 + n) * K + k0 + 8 * c) = o; }
    LDS_WAIT(); asm volatile("" ::: "memory");
}
struct CmId { __device__ __forceinline__ int operator()(int c) const { return c; } };
struct CmGlaIn { __device__ __forceinline__ int operator()(int c) const { return c < 1024 ? (c & ~127) + qk_src(c & 127) : c; } };
struct CmFfnIn { __device__ __forceinline__ int operator()(int c) const { const int t = c >> 8, cl = c & 255; return cl < 128 ? 128 * t + cl : DFF + 128 * t + (cl - 128); } };

__device__ __forceinline__ void p0_prologue(Frame& F) {
    if (F.bid < 192) {
        LAS float* s = (LAS float*)F.lds;
        LAS float* part = (LAS float*)(F.lds + 12288);
        for (int e = F.tid; e < 3 * D; e += NTHR) { const int r = e / D, k = e % D; const float v = r < 2 ? F.in[I_C][r * D + k] : F.in[I_CCTX][k]; s[e] = v / (1.0f + expf(-v)); }
        __syncthreads();
        const int layer = F.bid / 96, n = (F.bid % 96) * 64 + (F.tid & 63), ks = F.tid >> 6;
        const float* w = F.in[I_ADA_W] + (size_t)layer * D * 6144 + n;
        float a0 = 0.f, a1 = 0.f, a2 = 0.f;
#pragma unroll 8
        for (int k = ks * 128; k < ks * 128 + 128; ++k) { const float wv = w[(size_t)k * 6144]; a0 += s[k] * wv; a1 += s[D + k] * wv; a2 += s[2 * D + k] * wv; }
        part[(ks * 3 + 0) * 64 + (F.tid & 63)] = a0; part[(ks * 3 + 1) * 64 + (F.tid & 63)] = a1; part[(ks * 3 + 2) * 64 + (F.tid & 63)] = a2;
        __syncthreads();
        if (F.tid < 192) { const int r = F.tid >> 6, cc = F.tid & 63; float t = 0.f;
#pragma unroll
            for (int q = 0; q < 8; ++q) t += part[(q * 3 + r) * 64 + cc];
            const int nn = (F.bid % 96) * 64 + cc;
            F.mod[((size_t)layer * 3 + r) * 6144 + nn] = t + F.in[I_ADA_B][layer * 6144 + nn]; }
        __syncthreads();
    } else if (F.bid < 200) {
        const int e = (F.bid - 192) * NTHR + F.tid; const int pos = e >> 5, i = e & 31;
        const float inv = 1.0f / powf(10000.0f, (float)(2 * i) / 64.0f); const float ang = (float)pos * inv;
        F.rcos[e] = cosf(ang); F.rsin[e] = sinf(ang);
    }
    LAS float* scr = (LAS float*)(F.lds + F.wave * 16384);
    const int gw = F.bid * NWAVES + F.wave, NGW = F.G * NWAVES;
    constexpr int I_GI = 16 * 96, I_GO = 16 * 32, I_FI = 16 * 176, I_FO = 44 * 32, I_NQ = 16 * 96, I_NO = 16 * 32;
    constexpr int NITEMS = I_GI + I_GO + 2 * I_FI + 2 * I_FO + I_NQ + I_NO;
    for (int it = gw; it < NITEMS; it += NGW) {
        int r = it;
        if (r < I_GI) { p0_transpose_item(F.in[I_GLA_WIN], D, 3072, (bf16*)((char*)F.wt + WT_GLA_IN), scr, r, F.lane, CmGlaIn{}); continue; } r -= I_GI;
        if (r < I_GO) { p0_transpose_item(F.in[I_GLA_WOUT], D, 1024, (bf16*)((char*)F.wt + WT_GLA_OUT), scr, r, F.lane, CmId{}); continue; } r -= I_GO;
        if (r < I_FI) { p0_transpose_item(F.in[I_FFN_WIN], D, 5632, (bf16*)((char*)F.wt + WT_FFN_IN0), scr, r, F.lane, CmFfnIn{}); continue; } r -= I_FI;
        if (r < I_FI) { p0_transpose_item(F.in[I_FFN_WIN] + (size_t)D * 5632, D, 5632, (bf16*)((char*)F.wt + WT_FFN_IN1), scr, r, F.lane, CmFfnIn{}); continue; } r -= I_FI;
        if (r < I_FO) { p0_transpose_item(F.in[I_FFN_WOUT], DFF, 1024, (bf16*)((char*)F.wt + WT_FFN_OUT0), scr, r, F.lane, CmId{}); continue; } r -= I_FO;
        if (r < I_FO) { p0_transpose_item(F.in[I_FFN_WOUT] + (size_t)DFF * 1024, DFF, 1024, (bf16*)((char*)F.wt + WT_FFN_OUT1), scr, r, F.lane, CmId{}); continue; } r -= I_FO;
        if (r < I_NQ) { p0_transpose_item(F.in[I_NA_WQKV], D, 3072, (bf16*)((char*)F.wt + WT_NA_QKV), scr, r, F.lane, CmId{}); continue; } r -= I_NQ;
        p0_transpose_item(F.in[I_NA_WOUT], D, 1024, (bf16*)((char*)F.wt + WT_NA_OUT), scr, r, F.lane, CmId{});
    }
}

template <bool GATE, bool FROM_INPUT>
__device__ __forceinline__ void modulate_phase(Frame& F, int layer, int which) {
    LAS _Float16* W1p = (LAS _Float16*)F.lds;
    LAS unsigned* W2p = (LAS unsigned*)(F.lds + 65536);
    LAS float* B2 = (LAS float*)(F.lds + 65536 + 32768);
    LAS _Float16* hrow = (LAS _Float16*)(F.lds + 65536 + 32768 + 4096) + F.wave * 1024;
    if (GATE) {
        const float* w1 = F.in[I_GLA_AW1];
        for (int s = F.tid; s < 32768; s += NTHR) { const int dir = s >> 14, k = (s >> 4) & 1023, j = s & 15; W1p[((k >> 3) * 32 + dir * 16 + j) * 8 + (k & 7)] = (_Float16)w1[s]; }
        const float* w2 = F.in[I_GLA_AW2];
        for (int s = F.tid; s < 8192; s += NTHR) { const int djp = s >> 9, c = s & 511, dir = djp >> 3, jp = djp & 7; const int oc = (c & ~127) + qk_src(c & 127);
            const h2 pr = (h2){(_Float16)w2[(dir * 16 + 2 * jp) * 512 + oc], (_Float16)w2[(dir * 16 + 2 * jp + 1) * 512 + oc]}; W2p[s] = __builtin_bit_cast(unsigned, pr); }
        for (int s = F.tid; s < 1024; s += NTHR) { const int dir = s >> 9, c = s & 511; B2[s] = F.in[I_GLA_AB][dir * 512 + (c & ~127) + qk_src(c & 127)]; }
        __syncthreads();
#if GATE_CHECK
        { unsigned bad = 0;
          for (int s = F.tid; s < 32768; s += NTHR) { const int dir = s >> 14, k = (s >> 4) & 1023, j = s & 15; const float got = (float)W1p[((k >> 3) * 32 + dir * 16 + j) * 8 + (k & 7)]; bad += fabsf(got - w1[s]) > 1e-3f; }
          if (bad) atomicAdd((unsigned*)((char*)F.wt - WS_WT + WS_CTL + 32768) + 4, bad); }
        __syncthreads();
#endif
    }
    const float* gn = F.in[which == 0 ? I_N1G : I_N2G] + layer * D;
    const int gw = F.bid * NWAVES + F.wave, NGW = F.G * NWAVES;
    for (int row = gw; row < T; row += NGW) {
        const float* x = FROM_INPUT ? xinrow(F, row) : (const float*)xrow(F, row);
        const float* m = F.mod + ((size_t)layer * 3 + modrow(row)) * 6144;
        const float* sh = m + (which == 0 ? 0 : 3) * D; const float* sc = m + (which == 0 ? 1 : 4) * D;
        f32x4 v[4]; float ss = 0.f;
#pragma unroll
        for (int j = 0; j < 4; ++j) { v[j] = *(const f32x4*)(x + F.lane * 4 + 256 * j); ss += (v[j][0] * v[j][0] + v[j][1] * v[j][1]) + (v[j][2] * v[j][2] + v[j][3] * v[j][3]); }
        const float rs = rsqrtf(wave_sum(ss) * (1.0f / D) + EPS);
#pragma unroll
        for (int j = 0; j < 4; ++j) { const int n = F.lane * 4 + 256 * j; const f32x4 g4 = *(const f32x4*)(gn + n), s4 = *(const f32x4*)(sc + n), h4 = *(const f32x4*)(sh + n);
            v[j] = (v[j] * rs * g4) * (s4 + 1.0f) + h4;
            v2u w; w.x = pk2(v[j][0], v[j][1]); w.y = pk2(v[j][2], v[j][3]); *(v2u*)(F.H + (size_t)row * D + n) = w;
            if (GATE) { const h2 a = (h2){(_Float16)v[j][0], (_Float16)v[j][1]}, b = (h2){(_Float16)v[j][2], (_Float16)v[j][3]};
                v2u hw2; hw2.x = __builtin_bit_cast(unsigned, a); hw2.y = __builtin_bit_cast(unsigned, b); *(LAS v2u*)(hrow + n) = hw2; } }
        if (GATE) {
            LDS_WAIT(); asm volatile("" ::: "memory");
#if GATE_CHECK == 2
            { unsigned bad = 0; const int ol = (F.lane + 1) & 63;
              for (int j = 0; j < 4; ++j) for (int t = 0; t < 4; ++t) { const float want = __shfl(v[j][t], ol); const float got = (float)hrow[ol * 4 + 256 * j + t]; bad += fabsf(got - want) > 0.01f + 0.01f * fabsf(want); }
              if (bad) atomicAdd((unsigned*)((char*)F.wt - WS_WT + WS_CTL + 32768) + 4, bad); }
#endif
            const int mo = F.lane & 31, kh = F.lane >> 5;
            float a0 = 0.f, a1 = 0.f;
#pragma unroll 8
            for (int i = 0; i < 64; ++i) { const int k8 = kh * 64 + i;
                const v4u hv = *(const LAS v4u*)(hrow + k8 * 8); const v4u wv = *(const LAS v4u*)(W1p + (k8 * 32 + mo) * 8);
                a0 = DOT2(as_h2(hv.x), as_h2(wv.x), a0, false); a1 = DOT2(as_h2(hv.y), as_h2(wv.y), a1, false);
                a0 = DOT2(as_h2(hv.z), as_h2(wv.z), a0, false); a1 = DOT2(as_h2(hv.w), as_h2(wv.w), a1, false); }
            float hsum = a0 + a1; hsum += __shfl_xor(hsum, 32);
#if GATE_NAIVE
            { float mine = 0.f;
              for (int mm = 0; mm < 32; ++mm) { float p = 0.f; const float* wq = F.in[I_GLA_AW1] + (size_t)(mm >> 4) * D * 16 + (mm & 15);
                  for (int j = 0; j < 4; ++j) for (int t = 0; t < 4; ++t) p += v[j][t] * wq[(size_t)(F.lane * 4 + 256 * j + t) * 16];
                  p = wave_sum(p); if (mo == mm) mine = p; }
              hsum = mine; }
#endif
#if MK_HYBRID
            if (F.lane < 32) ((float*)F.BIG)[(size_t)row * 32 + F.lane] = hsum;
#endif
            unsigned hwp[16];
#pragma unroll
            for (int q = 0; q < 16; ++q) { const float e0 = __builtin_bit_cast(float, __builtin_amdgcn_readlane(__builtin_bit_cast(int, hsum), 2 * q)), e1 = __builtin_bit_cast(float, __builtin_amdgcn_readlane(__builtin_bit_cast(int, hsum), 2 * q + 1));
                hwp[q] = __builtin_bit_cast(unsigned, (h2){(_Float16)e0, (_Float16)e1}); }
#pragma unroll
            for (int grp = 0; grp < 4; ++grp) { const int dir = grp >> 1, c4 = F.lane * 4 + 256 * (grp & 1);
                f32x4 xg = *(const LAS f32x4*)(B2 + dir * 512 + c4);
#pragma unroll
                for (int jp = 0; jp < 8; ++jp) { const v4u wv = *(const LAS v4u*)(W2p + (dir * 8 + jp) * 512 + c4); const h2 hp = as_h2(hwp[dir * 8 + jp]);
                    xg[0] = DOT2(hp, as_h2(wv.x), xg[0], false); xg[1] = DOT2(hp, as_h2(wv.y), xg[1], false);
                    xg[2] = DOT2(hp, as_h2(wv.z), xg[2], false); xg[3] = DOT2(hp, as_h2(wv.w), xg[3], false); }
                _Float16 o[4];
#pragma unroll
                for (int t = 0; t < 4; ++t) { const float xv = xg[t]; const float tt = __builtin_amdgcn_exp2f(-fabsf(xv) * LOG2E);
                    o[t] = (_Float16)((fminf(xv, 0.f) * LOG2E - __builtin_amdgcn_logf(1.0f + tt)) * (1.0f / 16.0f)); }
                v2u w; w.x = (unsigned)__builtin_bit_cast(unsigned short, o[0]) | ((unsigned)__builtin_bit_cast(unsigned short, o[1]) << 16); w.y = (unsigned)__builtin_bit_cast(unsigned short, o[2]) | ((unsigned)__builtin_bit_cast(unsigned short, o[3]) << 16);
                *(v2u*)(F.Gt + ((size_t)dir * T + row) * 512 + c4) = w; }
            LDS_WAIT(); asm volatile("" ::: "memory");
        }
    }
}

__device__ __forceinline__ void gla_golden_phase(Frame& F) {
    if (F.bid >= 128) return;
    LAS float* red = (LAS float*)F.lds;
    const int tid = F.tid, e = tid & 15, dg = tid >> 4;
    const int sl = F.bid & 15, h = (F.bid >> 4) & 3, b = F.bid >> 6;
    const int vcol = h * 256 + sl * 16;
    const bf16* Q = F.BIG; const bf16* K = Q + (size_t)T * 512; const bf16* V = K + (size_t)T * 512;
    for (int dir = 0; dir < 2; ++dir) {
        float S[4] = {0.f, 0.f, 0.f, 0.f};
        int par = 0;
        for (int seg = 0; seg < 2; ++seg) {
            const int n = seg == 0 ? LCTX : NSEQ; const int base = b * TB + (seg == 0 ? 0 : LCTX);
            for (int s = 0; s < n; ++s) {
                const int row = base + (dir == 0 ? s : n - 1 - s);
#if GLA_NOSTATE
                if ((s & 63) == 0) { S[0] = 0.f; S[1] = 0.f; S[2] = 0.f; S[3] = 0.f; }
#endif
                const v2u qw = *(const v2u*)(Q + (size_t)row * 512 + h * 128 + dg * 4);
                const v2u kw = *(const v2u*)(K + (size_t)row * 512 + h * 128 + dg * 4);
                const v2u gw = *(const v2u*)(F.Gt + ((size_t)dir * T + row) * 512 + h * 128 + dg * 4);
                const float v = bf2f(V[(size_t)row * 1024 + vcol + e]);
                const unsigned qa[2] = {qw.x, qw.y}, ka[2] = {kw.x, kw.y}, ga[2] = {gw.x, gw.y};
                float part = 0.f;
#pragma unroll
                for (int i = 0; i < 4; ++i) {
                    const float q = bf2f((qa[i >> 1] >> ((i & 1) * 16)) & 0xffffu), k = bf2f((ka[i >> 1] >> ((i & 1) * 16)) & 0xffffu);
                    const float g = (float)__builtin_bit_cast(_Float16, (unsigned short)((ga[i >> 1] >> ((i & 1) * 16)) & 0xffffu));
                    S[i] = __builtin_amdgcn_exp2f(g) * S[i] + k * v; part += q * S[i];
                }
                red[(par * 32 + dg) * 17 + e] = part;
                __syncthreads();
                if (tid < 16) { float o = 0.f;
#pragma unroll
                    for (int g2 = 0; g2 < 32; ++g2) o += red[(par * 32 + g2) * 17 + tid];
                    float* dst = orow(F, row) + vcol + tid;
                    if (dir == 0) *dst = o; else *dst += o; }
                par ^= 1;
            }
        }
        __syncthreads();
    }
}
__device__ __forceinline__ void gla_post_phase(Frame& F) {
    const bf16* R = F.BIG + (size_t)T * 2048;
    const float* ng = F.in[I_GLA_NG];
    const int gw = F.bid * NWAVES + F.wave, NGW = F.G * NWAVES;
    for (int row = gw; row < T; row += NGW) {
        const float* o = orow(F, row);
#pragma unroll
        for (int j = 0; j < 4; ++j) { const f32x4 v = *(const f32x4*)(o + F.lane * 4 + 256 * j);
            const float rs = rsqrtf(wave_sum((v[0] * v[0] + v[1] * v[1]) + (v[2] * v[2] + v[3] * v[3])) * (1.0f / 256.0f) + EPS);
            const f32x4 g4 = *(const f32x4*)(ng + F.lane * 4); const v2u rw = *(const v2u*)(R + (size_t)row * 1024 + F.lane * 4 + 256 * j);
            const float r0 = bf2f(rw.x & 0xffffu), r1 = bf2f(rw.x >> 16), r2 = bf2f(rw.y & 0xffffu), r3 = bf2f(rw.y >> 16);
            v2u w; w.x = pk2(v[0] * rs * g4[0] * fast_silu(r0), v[1] * rs * g4[1] * fast_silu(r1)); w.y = pk2(v[2] * rs * g4[2] * fast_silu(r2), v[3] * rs * g4[3] * fast_silu(r3));
            *(v2u*)(F.H + (size_t)row * D + F.lane * 4 + 256 * j) = w; }
    }
}
__device__ __forceinline__ void na_golden_phase(Frame& F) {
    const int grp = F.tid >> 7, t = F.tid & 127;
    LAS float* q = (LAS float*)F.lds + grp * 1024;
    LAS float* pr = q + 64;
    LAS int* krow = (LAS int*)(q + 448);
    LAS float* red = q + 832;
    const bf16* NQ = F.BIG; const bf16* NK = NQ + (size_t)T * 1024; const bf16* NV = NK + (size_t)T * 1024;
    const float* rpb = F.in[I_NA_RPB];
    const int nitems = NB * NSEQ * 16, stride = F.G * 4;
    for (int it0 = F.bid * 4; it0 < nitems; it0 += stride) {
        const int item = it0 + grp; const bool act = item < nitems;
        const int h = item & 15, tok = act ? item >> 4 : 0;
        const int b = tok / NSEQ, pos = tok % NSEQ, r = pos / GW, c = pos % GW, row = b * TB + LCTX + pos;
        int rs = r - 4; rs = rs < 0 ? 0 : (rs > 120 ? 120 : rs);
        int cs = c - 8; cs = cs < 0 ? 0 : (cs > 48 ? 48 : cs);
        if (t < 64) q[t] = bf2f(NQ[(size_t)row * 1024 + h * 64 + t]);
        __syncthreads();
        float sc[3]; float mx = -3.0e38f;
        for (int m = 0; m < 3; ++m) {
            const int idx = t + 128 * m; int kr; float bias = 0.f;
            if (idx < 128) { const int i = idx >> 4, j = idx & 15; kr = b * TB + LCTX + (rs + i) * GW + (cs + j); bias = rpb[((size_t)h * 15 + (rs + i - r + 7)) * 31 + (cs + j - c + 15)]; }
            else kr = b * TB + (idx - 128);
            krow[idx] = kr;
            const bf16* kp = NK + (size_t)kr * 1024 + h * 64;
            float s = 0.f;
            for (int d8 = 0; d8 < 8; ++d8) { const v4u w = *(const v4u*)(kp + d8 * 8);
                s += q[d8 * 8 + 0] * bf2f(w.x & 0xffffu) + q[d8 * 8 + 1] * bf2f(w.x >> 16) + q[d8 * 8 + 2] * bf2f(w.y & 0xffffu) + q[d8 * 8 + 3] * bf2f(w.y >> 16)
                   + q[d8 * 8 + 4] * bf2f(w.z & 0xffffu) + q[d8 * 8 + 5] * bf2f(w.z >> 16) + q[d8 * 8 + 6] * bf2f(w.w & 0xffffu) + q[d8 * 8 + 7] * bf2f(w.w >> 16); }
            s += bias; sc[m] = s; mx = fmaxf(mx, s);
        }
        for (int o = 32; o > 0; o >>= 1) mx = fmaxf(mx, __shfl_xor(mx, o));
        if ((t & 63) == 0) red[t >> 6] = mx;
        __syncthreads();
        mx = fmaxf(red[0], red[1]);
        __syncthreads();
        float sum = 0.f;
        for (int m = 0; m < 3; ++m) { const float e = __builtin_amdgcn_exp2f((sc[m] - mx) * LOG2E); pr[t + 128 * m] = e; sum += e; }
        for (int o = 32; o > 0; o >>= 1) sum += __shfl_xor(sum, o);
        if ((t & 63) == 0) red[t >> 6] = sum;
        __syncthreads();
        const float inv = 1.0f / (red[0] + red[1]);
        if (t < 64 && act) { float o = 0.f;
            for (int idx = 0; idx < 384; ++idx) o += pr[idx] * bf2f(NV[(size_t)krow[idx] * 1024 + h * 64 + t]);
            F.H[(size_t)row * 1024 + h * 64 + t] = (bf16)f2bf(o * inv); }
        __syncthreads();
    }
}
__device__ __forceinline__ void final_phase(Frame& F) {
    const float* fg = F.in[I_FINAL_G];
    const int gw = F.bid * NWAVES + F.wave, NGW = F.G * NWAVES;
    for (int row = gw; row < NB * NSEQ; row += NGW) {
        float* x = F.xlat + (size_t)row * D;
        f32x4 v[4]; float ss = 0.f;
#pragma unroll
        for (int j = 0; j < 4; ++j) { v[j] = *(const f32x4*)(x + F.lane * 4 + 256 * j); ss += (v[j][0] * v[j][0] + v[j][1] * v[j][1]) + (v[j][2] * v[j][2] + v[j][3] * v[j][3]); }
        const float rs = rsqrtf(wave_sum(ss) * (1.0f / D) + EPS);
#pragma unroll
        for (int j = 0; j < 4; ++j) *(f32x4*)(x + F.lane * 4 + 256 * j) = v[j] * rs * *(const f32x4*)(fg + F.lane * 4 + 256 * j);
    }
}


namespace gla {
typedef short s16x4 __attribute__((ext_vector_type(4)));
typedef short s16x8 __attribute__((ext_vector_type(8)));
typedef _Float16 f16x8 __attribute__((ext_vector_type(8)));
constexpr int PQ = 272, PV = 528, PA = 144;
constexpr int L_Q = 0, L_K = 17408, L_G = 34816, L_V = 52224, L_A = 86016, L_D = 95232, L_R = 95744, L_M = 97792;
constexpr int NSC = 33;
constexpr size_t ST_SLOT = 32768;

__device__ __forceinline__ s16x4 trread(LAS unsigned char* p) { return __builtin_amdgcn_ds_read_tr16_b64_v4i16((LAS s16x4*)p); }
__device__ __forceinline__ s16x8 cat8(s16x4 a, s16x4 b) { return __builtin_shufflevector(a, b, 0, 1, 2, 3, 4, 5, 6, 7); }
__device__ __forceinline__ f32x4 mfma_bf16(s16x8 a, s16x8 b, f32x4 c) { return __builtin_amdgcn_mfma_f32_16x16x32_bf16(a, b, c, 0, 0, 0); }
__device__ __forceinline__ f32x4 mfma_f16(f16x8 a, f16x8 b, f32x4 c) { return __builtin_amdgcn_mfma_f32_16x16x32_f16(a, b, c, 0, 0, 0); }
__device__ __forceinline__ float ex2(float x) { return __builtin_amdgcn_exp2f(x); }
typedef float f32x2_t __attribute__((ext_vector_type(2)));
typedef __bf16 bf16x2_t __attribute__((ext_vector_type(2)));
__device__ __forceinline__ unsigned cvt2(float lo, float hi) { const f32x2_t v = {lo, hi}; const bf16x2_t b = __builtin_convertvector(v, bf16x2_t); return __builtin_bit_cast(unsigned, b); }
__device__ __forceinline__ v2u pack4(float a, float b, float c, float d) { v2u w; w.x = cvt2(a, b); w.y = cvt2(c, d); return w; }
#define GLA_BAR() do { asm volatile("s_waitcnt lgkmcnt(0)" ::: "memory"); __builtin_amdgcn_s_barrier(); asm volatile("" ::: "memory"); } while (0)

__device__ __forceinline__ void mask_fill(const Frame& F) {
    for (int idx = F.tid; idx < 4096; idx += NTHR) { const int ii = idx >> 6, jj = idx & 63;
        *(LAS _Float16*)(F.lds + L_M + ii * PA + jj * 2) = jj <= ii ? (_Float16)1.0f : (_Float16)0.0f;
        *(LAS _Float16*)(F.lds + L_M + 64 * PA + ii * PA + jj * 2) = jj >= ii ? (_Float16)1.0f : (_Float16)0.0f; }
    __syncthreads();
}
__device__ __forceinline__ int opq(int v) { asm volatile("" : "+v"(v)); return v; }
struct Raw { v4u q[2], k[2], g[2], v[4]; };
template <bool NEEDQ, int PART  >
__device__ __forceinline__ void raw_load(Raw& R, const Frame& F, const bf16* Q, const bf16* K, const bf16* V, int dir, int row0, int h) {
    const int tid = opq(F.tid);
#pragma unroll
    for (int x = 0; x < 2; ++x) { const int p = tid + 512 * x, r = p >> 4, c = p & 15; const size_t o = (size_t)(row0 + r) * 512 + h * 128 + c * 8;
        if (NEEDQ && PART != 0) R.q[x] = *(const v4u*)(Q + o);
        if (PART != 1) R.k[x] = *(const v4u*)(K + o);
        if (PART != 0) R.g[x] = *(const v4u*)(F.Gt + (size_t)dir * T * 512 + o); }
    if (PART != 0) {
#pragma unroll
        for (int x = 0; x < 4; ++x) { const int p = tid + 512 * x, r = p >> 5, c = p & 31; R.v[x] = *(const v4u*)(V + (size_t)(row0 + r) * 1024 + h * 256 + c * 8); } }
}
template <bool NEEDQ>
__device__ __forceinline__ void raw_store(const Raw& R, const Frame& F) {
    const int tid = opq(F.tid);
#pragma unroll
    for (int x = 0; x < 2; ++x) { const int p = tid + 512 * x, r = p >> 4, c = p & 15; const int o = r * PQ + c * 16;
        if (NEEDQ) *(LAS v4u*)(F.lds + L_Q + o) = R.q[x];
        *(LAS v4u*)(F.lds + L_K + o) = R.k[x];
        *(LAS v4u*)(F.lds + L_G + o) = R.g[x]; }
#pragma unroll
    for (int x = 0; x < 4; ++x) { const int p = tid + 512 * x, r = p >> 5, c = p & 31; *(LAS v4u*)(F.lds + L_V + r * PV + c * 16) = R.v[x]; }
}

template <bool NEEDQ>
__device__ __forceinline__ void decay_step(const Frame& F, bool fwd, f32x4& blsum) {
    const int ln = opq(F.lane); const int w = F.wave, i = ln & 15, q4 = ln >> 4;
    f32x4 bacc[4];
#pragma unroll
    for (int it = 0; it < 4; ++it) bacc[it] = (f32x4){0.f, 0.f, 0.f, 0.f};
    s16x8 ga[2];
#pragma unroll
    for (int kb = 0; kb < 2; ++kb) { LAS unsigned char* p = F.lds + L_G + (32 * kb + 8 * q4 + (i >> 2)) * PQ + (16 * w + 4 * (i & 3)) * 2;
        const s16x4 lo = trread(p), hi = trread(p + 4 * PQ); ga[kb] = cat8(lo, hi); }
#pragma unroll
    for (int it = 0; it < 4; ++it)
#pragma unroll
        for (int kb = 0; kb < 2; ++kb) {
            const bool skip = fwd ? (kb == 1 && it < 2) : (kb == 0 && it >= 2);
            if (!skip) { const f16x8 m = *(const LAS f16x8*)(F.lds + L_M + (fwd ? 0 : 64 * PA) + (16 * it + i) * PA + (32 * kb + 8 * q4) * 2);
                bacc[it] = mfma_f16(__builtin_bit_cast(f16x8, ga[kb]), m, bacc[it]); }
        }
    const int srcl = (ln & 48) | (fwd ? 15 : 0);
    f32x4 bl; { const f32x4 t3 = bacc[3], t0 = bacc[0];
#pragma unroll
        for (int r = 0; r < 4; ++r) bl[r] = __shfl(fwd ? t3[r] : t0[r], srcl); }
    if (!NEEDQ) blsum += bl;
    if (i == 0) { f32x4 d;
#pragma unroll
        for (int r = 0; r < 4; ++r) d[r] = ex2(bl[r]);
        *(LAS f32x4*)(F.lds + L_D + (16 * w + 4 * q4) * 4) = d; }
#pragma unroll
    for (int it = 0; it < 4; ++it) { const int o = (16 * it + i) * PQ + (16 * w + 4 * q4) * 2;
        const v2u kv = *(const LAS v2u*)(F.lds + L_K + o);
        const unsigned kx = kv.x, ky = kv.y;
        const float k0 = bf2f(kx & 0xffffu), k1 = bf2f(kx >> 16), k2 = bf2f(ky & 0xffffu), k3 = bf2f(ky >> 16);
        const f32x4 b = bacc[it];
        const float e20 = ex2(-b[0]), e21 = ex2(-b[1]), e22 = ex2(-b[2]), e23 = ex2(-b[3]);
        const float e30 = ex2(bl[0] - b[0]), e31 = ex2(bl[1] - b[1]), e32 = ex2(bl[2] - b[2]), e33 = ex2(bl[3] - b[3]);
        if (NEEDQ) { const v2u qv = *(const LAS v2u*)(F.lds + L_Q + o); const unsigned qx = qv.x, qy = qv.y;
            const float q0 = bf2f(qx & 0xffffu), q1 = bf2f(qx >> 16), q2 = bf2f(qy & 0xffffu), q3 = bf2f(qy >> 16);
            *(LAS v2u*)(F.lds + L_Q + o) = pack4(q0 * ex2(b[0]), q1 * ex2(b[1]), q2 * ex2(b[2]), q3 * ex2(b[3]));
            *(LAS v2u*)(F.lds + L_K + o) = pack4(k0 * e20, k1 * e21, k2 * e22, k3 * e23); }
        *(LAS v2u*)(F.lds + L_G + o) = pack4(k0 * e30, k1 * e31, k2 * e32, k3 * e33); }
}
__device__ __forceinline__ void load_vf(const Frame& F, s16x8 (&vf)[2][2]) {
    const int ln = opq(F.lane); const int w = F.wave, i = ln & 15, q4 = ln >> 4;
#pragma unroll
    for (int kb = 0; kb < 2; ++kb)
#pragma unroll
        for (int ee = 0; ee < 2; ++ee) { LAS unsigned char* p = F.lds + L_V + (32 * kb + 8 * q4 + (i >> 2)) * PV + (16 * (2 * w + ee) + 4 * (i & 3)) * 2;
            vf[kb][ee] = cat8(trread(p), trread(p + 4 * PV)); }
}
__device__ __forceinline__ void state_update(const Frame& F, f32x4 (&S)[8][2], const s16x8 (&vf)[2][2]) {
    const int ln = opq(F.lane); const int i = ln & 15, q4 = ln >> 4;
#pragma unroll
    for (int dt = 0; dt < 8; ++dt) { const f32x4 dl = *(const LAS f32x4*)(F.lds + L_D + (16 * dt + 4 * q4) * 4);
        S[dt][0] *= dl; S[dt][1] *= dl;
#pragma unroll
        for (int kb = 0; kb < 2; ++kb) { LAS unsigned char* p = F.lds + L_G + (32 * kb + 8 * q4 + (i >> 2)) * PQ + (16 * dt + 4 * (i & 3)) * 2;
            const s16x8 kd = cat8(trread(p), trread(p + 4 * PQ));
            S[dt][0] = mfma_bf16(kd, vf[kb][0], S[dt][0]); S[dt][1] = mfma_bf16(kd, vf[kb][1], S[dt][1]); }
        if (dt & 1) asm volatile("" ::: "memory"); }
}
__device__ __forceinline__ void state_store(const Frame& F, bf16* slot, const f32x4 (&S)[8][2]) {
#pragma unroll
    for (int dt = 0; dt < 8; ++dt)
#pragma unroll
        for (int ee = 0; ee < 2; ++ee) { const f32x4 s = S[dt][ee]; *(v2u*)(slot + ((size_t)(F.wave * 16 + dt * 2 + ee) * 64 + F.lane) * 4) = pack4(s[0], s[1], s[2], s[3]); }
}
__device__ __forceinline__ void state_load(const Frame& F, const bf16* slot, f32x4 (&S)[8][2]) {
#pragma unroll
    for (int dt = 0; dt < 8; ++dt)
#pragma unroll
        for (int ee = 0; ee < 2; ++ee) { const v2u s = *(const v2u*)(slot + ((size_t)(F.wave * 16 + dt * 2 + ee) * 64 + F.lane) * 4); const unsigned sx = s.x, sy = s.y;
            S[dt][ee] = (f32x4){bf2f(sx & 0xffffu), bf2f(sx >> 16), bf2f(sy & 0xffffu), bf2f(sy >> 16)}; }
}

__device__ __forceinline__ void s1_phase(Frame& F, bf16* ST, float* DT) {
    const bf16* Q = F.BIG; const bf16* K = Q + (size_t)T * 512; const bf16* V = K + (size_t)T * 512;
    const int nitems = 16 * NSC;
    mask_fill(F);
    for (int item = F.bid; item < nitems; item += F.G) {
        const int sc = item % NSC, bhd = item / NSC, dir = bhd & 1, h = (bhd >> 1) & 3, b = bhd >> 3;
        const bool fwd = dir == 0; const int row0 = b * TB + 256 * sc;
        f32x4 S[8][2];
#pragma unroll
        for (int dt = 0; dt < 8; ++dt) { S[dt][0] = (f32x4){0.f, 0.f, 0.f, 0.f}; S[dt][1] = (f32x4){0.f, 0.f, 0.f, 0.f}; }
        f32x4 blsum = (f32x4){0.f, 0.f, 0.f, 0.f};
        Raw R; raw_load<false, 2>(R, F, Q, K, V, dir, row0 + 64 * (fwd ? 0 : 3), h);
        for (int s = 0; s < 4; ++s) {
            GLA_BAR();
            raw_store<false>(R, F);
            if (s < 3) raw_load<false, 2>(R, F, Q, K, V, dir, row0 + 64 * (fwd ? s + 1 : 2 - s), h);
            GLA_BAR();
            decay_step<false>(F, fwd, blsum);
            GLA_BAR();
            s16x8 vf[2][2]; load_vf(F, vf);
            state_update(F, S, vf);
        }
        state_store(F, ST + ((size_t)bhd * NSC + sc) * ST_SLOT, S);
        if ((F.lane & 15) == 0) { f32x4 d;
#pragma unroll
            for (int r = 0; r < 4; ++r) d[r] = ex2(blsum[r]);
            *(f32x4*)(DT + ((size_t)bhd * NSC + sc) * 128 + 16 * F.wave + 4 * (F.lane >> 4)) = d; }
    }
}
__device__ __forceinline__ int sc_order(int dir, int n) { return n == 0 ? 0 : (dir == 0 ? n : NSC - n); }
__device__ __forceinline__ void s2_phase(Frame& F, bf16* ST, const float* DT) {
    const int total = 16 * 8 * 16 * 64;
    for (int g = F.bid * NTHR + F.tid; g < total; g += F.G * NTHR) {
        const int bhd = g >> 13, rem = g & 8191, tile = (rem >> 6) & 15, lane = rem & 63, dir = bhd & 1;
        const int d0 = 16 * (tile >> 1) + 4 * (lane >> 4);
        bf16* base = ST + (size_t)bhd * NSC * ST_SLOT + (size_t)rem * 4;
        const float* dtb = DT + (size_t)bhd * NSC * 128 + d0;
        f32x4 S = (f32x4){0.f, 0.f, 0.f, 0.f};
        v2u cur = *(const v2u*)(base + (size_t)sc_order(dir, 0) * ST_SLOT);
        f32x4 dcur = *(const f32x4*)(dtb + sc_order(dir, 0) * 128);
        for (int n = 0; n < NSC; ++n) {
            const int sc = sc_order(dir, n);
            v2u nxt = cur; f32x4 dn = dcur;
            if (n + 1 < NSC) { const int s2 = sc_order(dir, n + 1); nxt = *(const v2u*)(base + (size_t)s2 * ST_SLOT); dn = *(const f32x4*)(dtb + s2 * 128); }
            *(v2u*)(base + (size_t)sc * ST_SLOT) = pack4(S[0], S[1], S[2], S[3]);
            const unsigned cx = cur.x, cy = cur.y;
            S = dcur * S + (f32x4){bf2f(cx & 0xffffu), bf2f(cx >> 16), bf2f(cy & 0xffffu), bf2f(cy >> 16)};
            cur = nxt; dcur = dn;
        }
    }
}
__device__ __forceinline__ void c_phase(Frame& F, const bf16* ST) {
    const bf16* Q = F.BIG; const bf16* K = Q + (size_t)T * 512; const bf16* V = K + (size_t)T * 512; const bf16* Rg = V + (size_t)T * 1024;
    const float* ng = F.in[I_GLA_NG];
    const int w = F.wave;
    const int nitems = 8 * NSC;
    mask_fill(F);
    for (int item = F.bid; item < nitems; item += F.G) {
        const int sc = item % NSC, bh = item / NSC, h = bh & 3, b = bh >> 2;
        const int row0 = b * TB + 256 * sc;
        for (int dir = 0; dir < 2; ++dir) {
            const bool fwd = dir == 0; const int bhd = bh * 2 + dir;
            f32x4 S[8][2]; state_load(F, ST + ((size_t)bhd * NSC + sc) * ST_SLOT, S);
#if GLA_NOSTATE
#pragma unroll
            for (int dt = 0; dt < 8; ++dt) { S[dt][0] = (f32x4){0.f, 0.f, 0.f, 0.f}; S[dt][1] = (f32x4){0.f, 0.f, 0.f, 0.f}; }
#endif
            f32x4 blsum = (f32x4){0.f, 0.f, 0.f, 0.f};
            Raw R; raw_load<true, 2>(R, F, Q, K, V, dir, row0 + 64 * (fwd ? 0 : 3), h);
            for (int s = 0; s < 4; ++s) {
                const int c = fwd ? s : 3 - s, crow0 = row0 + 64 * c;
                GLA_BAR();
                raw_store<true>(R, F);
                if (s < 3) raw_load<true, 0>(R, F, Q, K, V, dir, row0 + 64 * (fwd ? s + 1 : 2 - s), h);
                GLA_BAR();
                decay_step<true>(F, fwd, blsum);
                GLA_BAR();
#if GLA_CHECK
                if (item == 0 && dir == GLA_CHECK_DIR && s == 0) {
                    unsigned bad = 0;
                    for (int idx = F.tid; idx < 64 * 128; idx += NTHR) { const int ii = idx >> 7, dd = idx & 127; float bsum = 0.f, btot = 0.f;
                        for (int jj = 0; jj < 64; ++jj) { const float gv = (float)F.Gt[((size_t)dir * T + crow0 + jj) * 512 + h * 128 + dd]; btot += gv; if (fwd ? (jj <= ii) : (jj >= ii)) bsum += gv; }
                        const float qv = bf2f(Q[(size_t)(crow0 + ii) * 512 + h * 128 + dd]), kv = bf2f(K[(size_t)(crow0 + ii) * 512 + h * 128 + dd]);
                        const float qs = bf2f(*(const LAS bf16*)(F.lds + L_Q + ii * PQ + dd * 2)), ks = bf2f(*(const LAS bf16*)(F.lds + L_K + ii * PQ + dd * 2)), kd = bf2f(*(const LAS bf16*)(F.lds + L_G + ii * PQ + dd * 2));
                        const float eq = qv * exp2f(bsum), ek = kv * exp2f(-bsum), ed = kv * exp2f(btot - bsum);
                        bad += fabsf(qs - eq) > 0.02f * fabsf(eq) + 1e-3f; bad += fabsf(ks - ek) > 0.02f * fabsf(ek) + 1e-3f; bad += fabsf(kd - ed) > 0.02f * fabsf(ed) + 1e-3f;
                        if (ii == 0) bad += fabsf(*(const LAS float*)(F.lds + L_D + dd * 4) - exp2f(btot)) > 0.01f; }
                    if (bad) atomicOr((unsigned*)((char*)F.mod - (WS_TAB + TAB_MOD) + WS_CTL + 32768 + 64), 1u);
                }
#endif
                { const int ln = opq(F.lane); const int i = ln & 15, q4 = ln >> 4; const int jt = w >> 1;
#pragma unroll
                  for (int t2 = 0; t2 < 2; ++t2) { const int it = 2 * (w & 1) + t2; f32x4 a = (f32x4){0.f, 0.f, 0.f, 0.f};
                      const bool dead = fwd ? (jt > it) : (jt < it);
                      if (!dead) {
#pragma unroll
                          for (int kb = 0; kb < 4; ++kb) { const s16x8 kf = *(const LAS s16x8*)(F.lds + L_K + (16 * jt + i) * PQ + (32 * kb + 8 * q4) * 2); const s16x8 qf = *(const LAS s16x8*)(F.lds + L_Q + (16 * it + i) * PQ + (32 * kb + 8 * q4) * 2);
                              a = mfma_bf16(kf, qf, a); }
                          if (jt == it) {
#pragma unroll
                              for (int r = 0; r < 4; ++r) { const int j = 4 * q4 + r; if (fwd ? (j > i) : (j < i)) a[r] = 0.f; } } }
                      *(LAS v2u*)(F.lds + L_A + (16 * it + i) * PA + (16 * jt + 4 * q4) * 2) = pack4(a[0], a[1], a[2], a[3]); } }
                GLA_BAR();
#if GLA_CHECK
                if (item == 0 && dir == GLA_CHECK_DIR && s == 0) {
                    unsigned bad = 0;
                    for (int idx = F.tid; idx < 64 * 64; idx += NTHR) { const int ii = idx >> 6, jj = idx & 63; float a = 0.f;
                        for (int dd = 0; dd < 128; ++dd) a += bf2f(*(const LAS bf16*)(F.lds + L_Q + ii * PQ + dd * 2)) * bf2f(*(const LAS bf16*)(F.lds + L_K + jj * PQ + dd * 2));
                        if (!(fwd ? (jj <= ii) : (jj >= ii))) a = 0.f;
                        const float got = bf2f(*(const LAS bf16*)(F.lds + L_A + ii * PA + jj * 2));
                        bad += fabsf(got - a) > 0.02f * fabsf(a) + 2e-2f; }
                    if (bad) atomicOr((unsigned*)((char*)F.mod - (WS_TAB + TAB_MOD) + WS_CTL + 32768 + 64), 2u);
                }
#endif
                s16x8 vf[2][2]; load_vf(F, vf);
#pragma unroll 1
                for (int hf = 0; hf < 4; ++hf) {
                    const int ln = opq(F.lane); const int i = ln & 15, q4 = ln >> 4;
                    f32x4 o[2][1];
#pragma unroll
                    for (int ee = 0; ee < 2; ++ee)
#pragma unroll
                        for (int t2 = 0; t2 < 1; ++t2) o[ee][t2] = (f32x4){0.f, 0.f, 0.f, 0.f};
#pragma unroll
                    for (int t2 = 0; t2 < 1; ++t2)
#pragma unroll
                        for (int kb = 0; kb < 2; ++kb) { const s16x8 af = *(const LAS s16x8*)(F.lds + L_A + (16 * (hf + t2) + i) * PA + (32 * kb + 8 * q4) * 2);
                            o[0][t2] = mfma_bf16(vf[kb][0], af, o[0][t2]); o[1][t2] = mfma_bf16(vf[kb][1], af, o[1][t2]); }
#if GLA_CHECK
                    if (item == 0 && dir == GLA_CHECK_DIR && s == 0) {
                        unsigned bad = 0;
                        for (int ee = 0; ee < 2; ++ee) for (int r = 0; r < 4; ++r) { const int tok = 16 * hf + i, e = 16 * (2 * w + ee) + 4 * q4 + r; float a = 0.f;
                            for (int jj = 0; jj < 64; ++jj) a += bf2f(*(const LAS bf16*)(F.lds + L_A + tok * PA + jj * 2)) * bf2f(*(const LAS bf16*)(F.lds + L_V + jj * PV + e * 2));
                            const f32x4 ov = o[ee][0]; bad += fabsf(ov[r] - a) > 0.02f * fabsf(a) + 2e-2f; }
                        if (bad) atomicOr((unsigned*)((char*)F.mod - (WS_TAB + TAB_MOD) + WS_CTL + 32768 + 64), 4u);
                    }
#endif
#pragma unroll
                    for (int kb = 0; kb < 4; ++kb) {
                        s16x8 sf[2];
#pragma unroll
                        for (int ee = 0; ee < 2; ++ee) { const f32x4 lo = S[2 * kb][ee], hi = S[2 * kb + 1][ee]; v4u t; t.x = cvt2(lo[0], lo[1]); t.y = cvt2(lo[2], lo[3]); t.z = cvt2(hi[0], hi[1]); t.w = cvt2(hi[2], hi[3]); sf[ee] = __builtin_bit_cast(s16x8, t); }
#pragma unroll
                        for (int t2 = 0; t2 < 1; ++t2) { LAS unsigned char* p = F.lds + L_Q + (16 * (hf + t2) + i) * PQ + (32 * kb + 4 * q4) * 2;
                            const s16x4 lo = *(const LAS s16x4*)p, hi = *(const LAS s16x4*)(p + 32); const s16x8 qf = cat8(lo, hi);
                            o[0][t2] = mfma_bf16(sf[0], qf, o[0][t2]); o[1][t2] = mfma_bf16(sf[1], qf, o[1][t2]); } }
                    if (dir == 0) {
#pragma unroll
                        for (int t2 = 0; t2 < 1; ++t2) { float* op = orow(F, crow0 + 16 * (hf + t2) + i) + h * 256 + 16 * (2 * w) + 4 * q4;
                            *(f32x4*)op = o[0][t2]; *(f32x4*)(op + 16) = o[1][t2]; }
                    } else {
                        float ssq[1];
#pragma unroll
                        for (int t2 = 0; t2 < 1; ++t2) { const float* op = orow(F, crow0 + 16 * (hf + t2) + i) + h * 256 + 16 * (2 * w) + 4 * q4;
                            o[0][t2] += *(const f32x4*)op; o[1][t2] += *(const f32x4*)(op + 16);
                            const f32x4 a = o[0][t2], c2 = o[1][t2];
                            float ss = (a[0] * a[0] + a[1] * a[1]) + (a[2] * a[2] + a[3] * a[3]) + (c2[0] * c2[0] + c2[1] * c2[1]) + (c2[2] * c2[2] + c2[3] * c2[3]);
                            ss += __shfl_xor(ss, 16); ss += __shfl_xor(ss, 32); ssq[t2] = ss; }
                        if (q4 == 0) {
#pragma unroll
                            for (int t2 = 0; t2 < 1; ++t2) *(LAS float*)(F.lds + L_R + (w * 64 + 16 * (hf + t2) + i) * 4) = ssq[t2]; }
                        GLA_BAR();
#pragma unroll
                        for (int t2 = 0; t2 < 1; ++t2) { float tot = 0.f;
#pragma unroll
                            for (int ww = 0; ww < 8; ++ww) tot += *(const LAS float*)(F.lds + L_R + (ww * 64 + 16 * (hf + t2) + i) * 4);
                            const float rs = rsqrtf(tot * (1.0f / 256.0f) + EPS);
                            const int row = crow0 + 16 * (hf + t2) + i;
#pragma unroll
                            for (int ee = 0; ee < 2; ++ee) { const int e = 16 * (2 * w + ee) + 4 * q4; const f32x4 g4 = *(const f32x4*)(ng + e);
                                const v2u rw = *(const v2u*)(Rg + (size_t)row * 1024 + h * 256 + e); const unsigned rx = rw.x, ry = rw.y;
                                const f32x4 ov = o[ee][t2];
                                *(v2u*)(F.H + (size_t)row * D + h * 256 + e) = pack4(ov[0] * rs * g4[0] * fast_silu(bf2f(rx & 0xffffu)), ov[1] * rs * g4[1] * fast_silu(bf2f(rx >> 16)),
                                                                                   ov[2] * rs * g4[2] * fast_silu(bf2f(ry & 0xffffu)), ov[3] * rs * g4[3] * fast_silu(bf2f(ry >> 16))); } }
                    }
                }
                if (s < 3) { raw_load<true, 1>(R, F, Q, K, V, dir, row0 + 64 * (fwd ? s + 1 : 2 - s), h);
#if !GLA_NOSTATE
                    state_update(F, S, vf);
#endif
                }
            }
            GLA_BAR();
        }
    }
}
}


namespace na {
typedef gla::s16x4 s16x4; typedef gla::s16x8 s16x8;
constexpr int PK = 144;
constexpr int KV = 64 * PK;
constexpr int L_BUF = 0, L_RPB = 4 * KV;
constexpr float NEG = -1.0e30f;

__device__ __forceinline__ void na_phase(Frame& F) {
    const bf16* NQ = F.BIG; const bf16* NK = NQ + (size_t)T * 1024; const bf16* NV = NK + (size_t)T * 1024; bf16* NO = F.H;
    const float* rpb = F.in[I_NA_RPB];
    const int w = F.wave, a = w & 3, rsel = w >> 2;
    const int vcu = (F.G % 8 == 0) ? (F.bid % 8) * (F.G / 8) + F.bid / 8 : F.bid;
    LAS float* rpl = (LAS float*)(F.lds + L_RPB);
    for (int item = vcu; item < NB * 16 * 64; item += F.G) {
        const int p = item & 63, bh = item >> 6, h = bh & 15, b = bh >> 4, r0 = 2 * p;
        const int rq = r0 + rsel;
        int rs_q = rq - 4; rs_q = rs_q < 0 ? 0 : (rs_q > 120 ? 120 : rs_q);
        int rs_lo = r0 - 4; rs_lo = rs_lo < 0 ? 0 : (rs_lo > 120 ? 120 : rs_lo);
        int rs_h1 = r0 - 3; rs_h1 = rs_h1 < 0 ? 0 : (rs_h1 > 120 ? 120 : rs_h1);
        const int nrows = rs_h1 + 8 - rs_lo, nblk = nrows + 4;
        const int ln = gla::opq(F.lane); const int i = ln & 15, q4 = ln >> 4;
        const int c = 16 * a + i; int cs = c - 8; cs = cs < 0 ? 0 : (cs > 48 ? 48 : cs);
        const size_t qrow = (size_t)b * TB + LCTX + rq * 64 + c;
        s16x8 qf[2];
#pragma unroll
        for (int ks = 0; ks < 2; ++ks) qf[ks] = *(const s16x8*)(NQ + qrow * 1024 + h * 64 + 32 * ks + 8 * q4);
        const int tkey = F.tid >> 3, tpart = F.tid & 7;
        v4u pk, pv;
        { const size_t row = (size_t)b * TB + LCTX + rs_lo * 64 + tkey; pk = *(const v4u*)(NK + row * 1024 + h * 64 + tpart * 8); pv = *(const v4u*)(NV + row * 1024 + h * 64 + tpart * 8); }
        GLA_BAR();
        for (int idx = F.tid; idx < 465; idx += NTHR) rpl[idx] = rpb[h * 465 + idx] * LOG2E;
        *(LAS v4u*)(F.lds + L_BUF + tkey * PK + tpart * 16) = pk; *(LAS v4u*)(F.lds + L_BUF + KV + tkey * PK + tpart * 16) = pv;
        f32x4 O[4];
#pragma unroll
        for (int dt = 0; dt < 4; ++dt) O[dt] = (f32x4){0.f, 0.f, 0.f, 0.f};
        float m = NEG, l = 0.f;
        for (int blk = 0; blk < nblk; ++blk) {
            GLA_BAR();
            if (blk + 1 < nblk) { const int nb = blk + 1; const size_t row = nb < nrows ? (size_t)b * TB + LCTX + (rs_lo + nb) * 64 + tkey : (size_t)b * TB + (nb - nrows) * 64 + tkey;
                pk = *(const v4u*)(NK + row * 1024 + h * 64 + tpart * 8); pv = *(const v4u*)(NV + row * 1024 + h * 64 + tpart * 8); }
            const bool isnb = blk < nrows; const int kr = rs_lo + blk;
            const bool act = isnb ? (kr >= rs_q && kr < rs_q + 8) : true;
            LAS unsigned char* Kb = F.lds + L_BUF + (blk & 1) * 2 * KV; LAS unsigned char* Vb = Kb + KV;
            if (act) {
                f32x4 s[4];
#pragma unroll
                for (int kt = 0; kt < 4; ++kt) { s[kt] = (f32x4){0.f, 0.f, 0.f, 0.f};
#pragma unroll
                    for (int ks = 0; ks < 2; ++ks) { const s16x8 kf = *(const LAS s16x8*)(Kb + (16 * kt + i) * PK + (32 * ks + 8 * q4) * 2); s[kt] = gla::mfma_bf16(kf, qf[ks], s[kt]); } }
                float bm = NEG;
#pragma unroll
                for (int kt = 0; kt < 4; ++kt)
#pragma unroll
                    for (int r = 0; r < 4; ++r) { float v = s[kt][r] * LOG2E;
                        if (isnb) { const int kc = 16 * kt + 4 * q4 + r; const bool ok = kc >= cs && kc < cs + 16; const int bi = (kr - rq + 7) * 31 + (kc - c + 15);
                            const float bias = rpl[ok ? bi : 0]; v = ok ? v + bias : NEG; }
                        s[kt][r] = v; bm = fmaxf(bm, v); }
                bm = fmaxf(bm, __shfl_xor(bm, 16)); bm = fmaxf(bm, __shfl_xor(bm, 32));
                const float mn = fmaxf(m, bm), alpha = gla::ex2(m - mn);
                float ls = 0.f;
#pragma unroll
                for (int kt = 0; kt < 4; ++kt)
#pragma unroll
                    for (int r = 0; r < 4; ++r) { const float pe = gla::ex2(s[kt][r] - mn); s[kt][r] = pe; ls += pe; }
                l = l * alpha + ls; m = mn;
#pragma unroll
                for (int dt = 0; dt < 4; ++dt) O[dt] *= alpha;
#pragma unroll
                for (int k2 = 0; k2 < 2; ++k2) { const f32x4 p0 = s[2 * k2], p1 = s[2 * k2 + 1];
                    v4u t; t.x = gla::cvt2(p0[0], p0[1]); t.y = gla::cvt2(p0[2], p0[3]); t.z = gla::cvt2(p1[0], p1[1]); t.w = gla::cvt2(p1[2], p1[3]);
                    const s16x8 pf = __builtin_bit_cast(s16x8, t);
#pragma unroll
                    for (int dt = 0; dt < 4; ++dt) { LAS unsigned char* vp = Vb + (32 * k2 + 4 * q4 + (i >> 2)) * PK + (16 * dt + 4 * (i & 3)) * 2;
                        const s16x8 vf = gla::cat8(gla::trread(vp), gla::trread(vp + 16 * PK));
                        O[dt] = gla::mfma_bf16(vf, pf, O[dt]); } }
            }
            if (blk + 1 < nblk) { LAS unsigned char* nbuf = F.lds + L_BUF + ((blk + 1) & 1) * 2 * KV; *(LAS v4u*)(nbuf + tkey * PK + tpart * 16) = pk; *(LAS v4u*)(nbuf + KV + tkey * PK + tpart * 16) = pv; }
        }
        l += __shfl_xor(l, 16); l += __shfl_xor(l, 32);
        const float inv = 1.0f / l;
#pragma unroll
        for (int dt = 0; dt < 4; ++dt) { const f32x4 o = O[dt] * inv; *(v2u*)(NO + qrow * 1024 + h * 64 + 16 * dt + 4 * q4) = gla::pack4(o[0], o[1], o[2], o[3]); }
    }
}
}

constexpr int NPHASE = 18;
enum { P_PRO = 0, P_MOD0, P_GIN, P_GLA_S1, P_GLA_S2, P_GLA_C, P_GOUT, P_MOD1, P_FIN0, P_FOUT0, P_MOD2, P_NQKV, P_NA, P_NOUT, P_MOD3, P_FIN1, P_FOUT1, P_FINAL, P_GOLD_GLA = 30, P_GOLD_POST = 31, P_GOLD_NA = 32 };
constexpr size_t WS_ST = WS_END;
constexpr size_t TAB_DT = 256 * 1024;
static_assert(WS_ST + (size_t)16 * 33 * 32768 * 2 <= 256 * MiB, "GLA states fit");
__global__ void __launch_bounds__(NTHR, 2) mega_fwd(Args args) {
    extern __shared__ __attribute__((aligned(16))) unsigned char lds[];
    Frame F;
    F.lds = (LAS unsigned char*)lds;
    F.tid = threadIdx.x; F.lane = F.tid & 63; F.wave = __builtin_amdgcn_readfirstlane(F.tid >> 6);
    F.G = gridDim.x; F.bid = blockIdx.x;
    F.in = args.in; F.xlat = args.out;
    unsigned char* ws = args.ws;
    F.xctx = (float*)(ws + WS_XCTX); F.octx = (float*)(ws + WS_OCTX);
    F.rcos = (float*)(ws + WS_TAB + TAB_COS); F.rsin = (float*)(ws + WS_TAB + TAB_SIN); F.mod = (float*)(ws + WS_TAB + TAB_MOD);
    F.wt = (bf16*)(ws + WS_WT); F.H = (bf16*)(ws + WS_H); F.Gt = (_Float16*)(ws + WS_G); F.BIG = (bf16*)(ws + WS_BIG);
    volatile LAS unsigned* MISC = (volatile LAS unsigned*)(F.lds + MISC_OFF);
    for (int u = F.tid; u < (LDS_BYTES - MISC_OFF) / 4; u += NTHR) ((LAS unsigned*)(F.lds + MISC_OFF))[u] = 0u;
    __syncthreads();
    const int lo = args.ph_lo, hi = args.ph_hi;
    const bool multi = (hi - lo) > 1;
    XcdBarrier bar; bar.bar = (unsigned*)(ws + WS_CTL) + CW_BAR; bar.x = 0; bar.st = nullptr;
    if (multi) bar = xcd_barrier_post((unsigned*)(ws + WS_CTL) + CW_BAR, MISC + 8);
#define IN(k) (phase_fence(F), (lo <= (k) && (k) < hi))
#define SEAM(k) do { if (IN(k) && IN((k) + 1)) xcd_barrier(bar); } while (0)
    bf16* Q = F.BIG; bf16* Kq = Q + (size_t)T * 512; bf16* V = Kq + (size_t)T * 512; bf16* R = V + (size_t)T * 1024;
    PG8_LAS unsigned char* ring = (PG8_LAS unsigned char*)F.lds;
    PG8_LAS float* edge = (PG8_LAS float*)(F.lds + EDGE_OFF);
    bf16* ST = (bf16*)(ws + WS_ST); float* DT = (float*)(ws + WS_TAB + TAB_DT);

    if (IN(P_PRO)) { p0_prologue(F); } SEAM(P_PRO);
    if (IN(P_MOD0)) { modulate_phase<true, true>(F, 0, 0); } SEAM(P_MOD0);
    if (IN(P_GIN)) { pg8::Gemm g{F.H, (const bf16*)((const char*)F.wt + WT_GLA_IN), T, 3072, D}; pg8::Sched S; S.init(pg8::RM_ALL66, 3072, F.G, F.bid);
        pg8::EpiGlaIn E{Q, Kq, V, R, F.rcos, F.rsin};
        pg8::gemm_phase<pg8::EpiGlaIn, pg8::Sched, PG8_ALIGN, PG8_SP2>(ring, g, S, E); } SEAM(P_GIN);
    if (IN(P_GLA_S1)) { gla::s1_phase(F, ST, DT); } SEAM(P_GLA_S1);
    if (IN(P_GLA_S2)) { gla::s2_phase(F, ST, DT); } SEAM(P_GLA_S2);
    if (IN(P_GLA_C)) { gla::c_phase(F, ST); } SEAM(P_GLA_C);
#if MK_HYBRID
    if (IN(P_GOLD_GLA)) { gla_golden_phase(F); }
    if (IN(P_GOLD_POST)) { gla_post_phase(F); }
#endif
    if (IN(P_GOUT)) { pg8::Gemm g{F.H, (const bf16*)((const char*)F.wt + WT_GLA_OUT), T, 1024, D}; pg8::Sched S; S.init(pg8::RM_ALL66, 1024, F.G, F.bid);
        pg8::EpiResid E{F.in[I_X], F.in[I_CTX], F.xlat, F.xctx, F.mod + 0 * 3 * 6144 + 2 * D};
        pg8::gemm_phase<pg8::EpiResid, pg8::Sched, PG8_ALIGN, PG8_SP2>(ring, g, S, E); } SEAM(P_GOUT);
    if (IN(P_MOD1)) { modulate_phase<false, false>(F, 0, 1); } SEAM(P_MOD1);
    if (IN(P_FIN0)) { pg8::Gemm g{F.H, (const bf16*)((const char*)F.wt + WT_FFN_IN0), T, 5632, D}; pg8::Sched S; S.init(pg8::RM_WIN68, 5632, F.G, F.bid);
        pg8::EpiFfnIn E{F.BIG, F.in[I_FFN_CW], F.in[I_FFN_CB], edge};
        pg8::gemm_phase<pg8::EpiFfnIn, pg8::Sched, true, PG8_SP2>(ring, g, S, E); } SEAM(P_FIN0);
    if (IN(P_FOUT0)) { pg8::Gemm g{F.BIG, (const bf16*)((const char*)F.wt + WT_FFN_OUT0), T, 1024, DFF}; pg8::Sched S; S.init(pg8::RM_ALL66, 1024, F.G, F.bid);
        pg8::EpiResid E{F.xlat, F.xctx, F.xlat, F.xctx, F.mod + 0 * 3 * 6144 + 5 * D};
        pg8::gemm_phase<pg8::EpiResid, pg8::Sched, PG8_ALIGN, PG8_SP2>(ring, g, S, E); } SEAM(P_FOUT0);
    if (IN(P_MOD2)) { modulate_phase<false, false>(F, 1, 0); } SEAM(P_MOD2);
    if (IN(P_NQKV)) { pg8::Gemm g{F.H, (const bf16*)((const char*)F.wt + WT_NA_QKV), T, 3072, D}; pg8::Sched S; S.init(pg8::RM_ALL66, 3072, F.G, F.bid);
        pg8::EpiNaQkv E{F.BIG};
        pg8::gemm_phase<pg8::EpiNaQkv, pg8::Sched, PG8_ALIGN, PG8_SP2>(ring, g, S, E); } SEAM(P_NQKV);
    if (IN(P_NA)) { na::na_phase(F); } SEAM(P_NA);
#if MK_HYBRID
    if (IN(P_GOLD_NA)) { na_golden_phase(F); }
#endif
    if (IN(P_NOUT)) { pg8::Gemm g{F.H, (const bf16*)((const char*)F.wt + WT_NA_OUT), T, 1024, D}; pg8::Sched S; S.init(pg8::RM_LAT64, 1024, F.G, F.bid);
        pg8::EpiResid E{F.xlat, F.xctx, F.xlat, F.xctx, F.mod + 1 * 3 * 6144 + 2 * D};
        pg8::gemm_phase<pg8::EpiResid, pg8::Sched, PG8_ALIGN, PG8_SP2>(ring, g, S, E); } SEAM(P_NOUT);
    if (IN(P_MOD3)) { modulate_phase<false, false>(F, 1, 1); } SEAM(P_MOD3);
    if (IN(P_FIN1)) { pg8::Gemm g{F.H, (const bf16*)((const char*)F.wt + WT_FFN_IN1), T, 5632, D}; pg8::Sched S; S.init(pg8::RM_WIN66, 5632, F.G, F.bid);
        pg8::EpiFfnIn E{F.BIG, F.in[I_FFN_CW] + 3 * DFF, F.in[I_FFN_CB] + DFF, edge};
        pg8::gemm_phase<pg8::EpiFfnIn, pg8::Sched, true, PG8_SP2>(ring, g, S, E); } SEAM(P_FIN1);
    if (IN(P_FOUT1)) { pg8::Gemm g{F.BIG, (const bf16*)((const char*)F.wt + WT_FFN_OUT1), T, 1024, DFF}; pg8::Sched S; S.init(pg8::RM_LAT64, 1024, F.G, F.bid);
        pg8::EpiResid E{F.xlat, F.xctx, F.xlat, F.xctx, F.mod + 1 * 3 * 6144 + 5 * D};
        pg8::gemm_phase<pg8::EpiResid, pg8::Sched, PG8_ALIGN, PG8_SP2>(ring, g, S, E); } SEAM(P_FOUT1);
    if (IN(P_FINAL)) { final_phase(F); }
#undef IN
#undef SEAM
}


#if MK_HYBRID
namespace gold {
__global__ void __launch_bounds__(256) k_ydiff(const bf16* a, const bf16* b, float* acc, int mode) {
    float mx = 0.f;
    for (size_t i = (size_t)blockIdx.x * 256 + threadIdx.x; i < (size_t)T * D; i += (size_t)gridDim.x * 256) {
        const int row = (int)(i >> 10), col = (int)(i & 1023); bool sel = true;
        if (mode == 10) sel = (row % TB) >= LCTX; if (mode == 2) sel = (row % TB) < LCTX; if (mode == 3) sel = (row % TB) >= LCTX && (row % TB) < LCTX + 256; if (mode == 4) sel = col < 256; if (mode == 5) sel = (row % TB) >= TB - 256;
        if (sel) mx = fmaxf(mx, fabsf(bf2f(a[i]) - bf2f(b[i])));
    }
    for (int o = 32; o > 0; o >>= 1) mx = fmaxf(mx, __shfl_xor(mx, o));
    if ((threadIdx.x & 63) == 0) atomicMax((unsigned*)acc, __float_as_uint(mx));
}
__global__ void k_apply(float* out, const float* acc, float scale) { out[0] = scale * acc[0]; }
__global__ void k_apply_flags(float* out, const unsigned* flags) { out[0] = 1000.0f * (float)flags[0]; }
}
#endif

extern "C" void kernel_launch(void* const* d_in, const int* in_sizes, int n_in, void* d_out, int out_size, void* d_ws, size_t ws_size, hipStream_t stream) {
    static int grid = 0;
    if (grid == 0) {
        if (n_in != 22 || out_size != NB * NSEQ * D || ws_size < WS_END) { fprintf(stderr, "kernel_launch: unexpected shapes (n_in %d out %d ws %zu)\n", n_in, out_size, ws_size); grid = -1; return; }
        int dev = 0, cus = 0, per_cu = 0;
        if (hipGetDevice(&dev) != hipSuccess || hipDeviceGetAttribute(&cus, hipDeviceAttributeMultiprocessorCount, dev) != hipSuccess) { grid = -1; return; }
        if (hipFuncSetAttribute((const void*)mega_fwd, hipFuncAttributeMaxDynamicSharedMemorySize, LDS_BYTES) != hipSuccess) { fprintf(stderr, "kernel_launch: hipFuncSetAttribute failed\n"); grid = -1; return; }
        if (hipOccupancyMaxActiveBlocksPerMultiprocessor(&per_cu, (const void*)mega_fwd, NTHR, LDS_BYTES) != hipSuccess || per_cu < 1) { fprintf(stderr, "kernel_launch: occupancy query says %d blocks per CU\n", per_cu); (void)hipGetLastError(); grid = -1; return; }
        grid = cus;
    }
    if (grid < 0) return;
    (void)hipMemsetAsync((char*)d_ws + WS_CTL, 0, CTL_ZERO_BYTES, stream);
    Args a{};
    for (int i = 0; i < 22; ++i) a.in[i] = (const float*)d_in[i];
    a.out = (float*)d_out; a.ws = (unsigned char*)d_ws;
#if MK_HYBRID
    auto run = [&](int p) { a.ph_lo = p; a.ph_hi = p + 1; hipLaunchKernelGGL(mega_fwd, dim3(grid), dim3(NTHR), LDS_BYTES, stream, a); };
#if GLA_TEST
    float* dacc = (float*)((char*)d_ws + WS_CTL + 32768);
    run(P_PRO); run(P_MOD0); run(P_GIN); run(P_GOLD_GLA); run(P_GOLD_POST);
    (void)hipMemcpyAsync((char*)d_ws + WS_WT, (char*)d_ws + WS_H, (size_t)T * D * 2, hipMemcpyDeviceToDevice, stream);
    run(P_GLA_S1); run(P_GLA_S2); run(P_GLA_C);
    gold::k_ydiff<<<1024, 256, 0, stream>>>((const bf16*)((char*)d_ws + WS_H), (const bf16*)((char*)d_ws + WS_WT), dacc, GLA_TEST);
    (void)hipMemsetAsync(d_out, 0, (size_t)NB * NSEQ * D * 4, stream);
#if GLA_CHECK
    gold::k_apply_flags<<<1, 1, 0, stream>>>((float*)d_out, (const unsigned*)((char*)d_ws + WS_CTL + 32768 + 64));
#else
    gold::k_apply<<<1, 1, 0, stream>>>((float*)d_out, dacc, 10000.0f);
#endif
#elif NA_TEST
    float* dacc = (float*)((char*)d_ws + WS_CTL + 32768);
    for (int p = 0; p <= P_NQKV; ++p) run(p);
    run(P_GOLD_NA);
    (void)hipMemcpyAsync((char*)d_ws + WS_WT, (char*)d_ws + WS_H, (size_t)T * D * 2, hipMemcpyDeviceToDevice, stream);
    run(P_NA);
    gold::k_ydiff<<<1024, 256, 0, stream>>>((const bf16*)((char*)d_ws + WS_H), (const bf16*)((char*)d_ws + WS_WT), dacc, NA_TEST);
    (void)hipMemsetAsync(d_out, 0, (size_t)NB * NSEQ * D * 4, stream);
    gold::k_apply<<<1, 1, 0, stream>>>((float*)d_out, dacc, 10000.0f);
#else
    for (int p = 0; p < NPHASE; ++p) run(p);
#endif
#else
    a.ph_lo = 0; a.ph_hi = NPHASE;
    void* kargs[] = {&a};
    hipError_t e = hipLaunchCooperativeKernel((const void*)mega_fwd, dim3(grid), dim3(NTHR), kargs, LDS_BYTES, stream);
    if (e != hipSuccess) fprintf(stderr, "kernel_launch: cooperative launch failed: %s (grid %d)\n", hipGetErrorString(e), grid);
#endif
}
```

```cpp
#include <hip/hip_runtime.h>
#include <hip/hip_fp16.h>
#include <cstdint>
#include <cstdio>
#ifndef MK_HYBRID
#define MK_HYBRID 0
#endif
#ifndef GOLD_FFN_IN
#define GOLD_FFN_IN 0
#endif
#ifndef GOLD_FFN_OUT
#define GOLD_FFN_OUT 0
#endif
#ifndef GOLD_WOUT
#define GOLD_WOUT 0
#endif
#ifndef GOLD_GATE
#define GOLD_GATE 0
#endif
#ifndef GATE_NAIVE
#define GATE_NAIVE 0
#endif
#ifndef GATE_CHECK
#define GATE_CHECK 0
#endif
#ifndef GLA_TEST
#define GLA_TEST 0
#endif
#ifndef GLA_NOSTATE
#define GLA_NOSTATE 0
#endif
#ifndef GLA_CHECK
#define GLA_CHECK 0
#endif
#ifndef GLA_CHECK_DIR
#define GLA_CHECK_DIR 0
#endif
#ifndef NA_TEST
#define NA_TEST 0
#endif
#ifndef PROBE_STAMP
#define PROBE_STAMP -1
#endif
#ifndef PROBE_SCALE
#define PROBE_SCALE 0.5f
#endif
namespace pg8 {
#define PG8_LAS __attribute__((address_space(3)))
typedef unsigned short bf16_t;
typedef short bf16x8 __attribute__((ext_vector_type(8)));
typedef float f32x4 __attribute__((ext_vector_type(4)));
typedef unsigned u32x4 __attribute__((ext_vector_type(4)));
constexpr int BM = 256, BK = 64, HALF = 128, HTB = HALF * BK * 2  , STAGE_BYTES = 8 * HTB, NXCD = 8, WGM = 8;

__host__ __device__ __forceinline__ int lds_byte(int r, int c) { const int st = (r >> 4) * 2 + (c >> 5), rr = r & 15, cc = c & 31, ob = rr * 64 + cc * 2; return st * 1024 + (ob ^ (((ob >> 9) & 1) << 5)); }
__host__ __device__ __forceinline__ void stage_rc(int b, int& R, int& C) { const int st = b / 1024, sb = b % 1024, swz = sb ^ (((sb >> 9) & 1) << 5); R = (st >> 1) * 16 + swz / 64; C = (st & 1) * 32 + (swz % 64) / 2; }
__host__ __device__ __forceinline__ int perm32(int rho) { const int n = rho >> 4, i = rho & 15; return 8 * (i >> 2) + 4 * n + (i & 3); }

struct Unit { int pm, pn, arow; };
struct Gemm { const bf16_t* A; const bf16_t* Bt; int M, N, K; };

__device__ __forceinline__ unsigned cvt_pk_bf16(float lo, float hi) { unsigned r; asm volatile("v_cvt_pk_bf16_f32 %0, %1, %2" : "=v"(r) : "v"(lo), "v"(hi)); return r; }

template <class Epi, class Sched, bool ALIGN_EPI = false, bool SP2 = false>
__device__ __forceinline__ void gemm_phase(PG8_LAS unsigned char* lds, const Gemm g, const Sched& S, const Epi& E) {
    const int tid = threadIdx.x, wid = __builtin_amdgcn_readfirstlane(tid >> 6), lane = tid & 63, wr = wid >> 2, wc = wid & 3, fr = lane & 15, fq = lane >> 4;
    const int K = g.K, nt = K / BK;
    unsigned voffA[2], voffB[2];
#pragma unroll
    for (int i = 0; i < 2; ++i) { int R, C; stage_rc(tid * 16 + i * 8192, R, C); const int Rb = Epi::PERM ? ((R & ~31) + perm32(R & 31)) : R;
        voffA[i] = (unsigned)(R * K + C) * 2u; voffB[i] = (unsigned)(Rb * K + C) * 2u; }
    const size_t kstep = (size_t)(BK * 2);
    const size_t hstep = (size_t)HALF * K * 2;
    const size_t tstep = 2 * hstep;
    const unsigned ldsw = (unsigned)wid * 1024u;
    const int aoff = lds_byte(wr * 64 + fr, fq * 8), boff = lds_byte(wc * 32 + fr, fq * 8);
#define PG8_SA(b, h) (((b) * 2 + (h)) * HTB)
#define PG8_SB(b, h) ((4 + (b) * 2 + (h)) * HTB)
#define PG8_STAGE(bufoff, gbase, voff) do { _Pragma("unroll") for (int _i = 0; _i < 2; ++_i) \
        __builtin_amdgcn_global_load_lds((const unsigned*)((const char*)(gbase) + (voff)[_i]), (PG8_LAS unsigned*)(lds + (bufoff) + ldsw + _i * 8192), 16, 0, 0); } while (0)
#define PG8_LDA(dst, b, h) do { _Pragma("unroll") for (int m = 0; m < 4; ++m) _Pragma("unroll") for (int k = 0; k < 2; ++k) dst[m][k] = *(const PG8_LAS bf16x8*)(lds + PG8_SA(b, h) + aoff + m * 2048 + k * 1024); } while (0)
#define PG8_LDB(dst, b, h) do { _Pragma("unroll") for (int n = 0; n < 2; ++n) _Pragma("unroll") for (int k = 0; k < 2; ++k) dst[n][k] = *(const PG8_LAS bf16x8*)(lds + PG8_SB(b, h) + boff + n * 2048 + k * 1024); } while (0)
#define PG8_MMA(ai, bj, At, Bt) do { __builtin_amdgcn_s_setprio(1); _Pragma("unroll") for (int m = 0; m < 4; ++m) _Pragma("unroll") for (int n = 0; n < 2; ++n) _Pragma("unroll") for (int k = 0; k < 2; ++k) \
        acc[ai][bj][m][n] = __builtin_amdgcn_mfma_f32_16x16x32_bf16(Bt[n][k], At[m][k], acc[ai][bj][m][n], 0, 0, 0); __builtin_amdgcn_s_setprio(0); } while (0)
#define PG8_WAIT_V(n) asm volatile("s_waitcnt vmcnt(" #n ")" ::: "memory")
#define PG8_WAIT_L(n) asm volatile("s_waitcnt lgkmcnt(" #n ")" ::: "memory")
#define PG8_BAR __builtin_amdgcn_s_barrier()
#define PG8_SCHED __builtin_amdgcn_sched_barrier(0)
    Unit cur, nxt; int ui = 0;
    if (!S.next(0, cur)) return;
    f32x4 acc[2][2][4][2];
#pragma unroll
    for (int a = 0; a < 2; ++a)
#pragma unroll
        for (int b = 0; b < 2; ++b)
#pragma unroll
            for (int m = 0; m < 4; ++m)
#pragma unroll
                for (int n = 0; n < 2; ++n) acc[a][b][m][n] = (f32x4){0.f, 0.f, 0.f, 0.f};
    bf16x8 At[4][2], B0[2][2], B1[2][2];
    const char* cA = (const char*)g.A + (size_t)cur.arow * (size_t)(K * 2); const char* cB = (const char*)g.Bt + (size_t)cur.pn * tstep;
    S.a_ready(cur);
    if constexpr (SP2) {
        PG8_STAGE(PG8_SB(0, 0), cB, voffB); PG8_STAGE(PG8_SB(0, 1), cB + hstep, voffB); PG8_STAGE(PG8_SA(0, 0), cA, voffA); PG8_STAGE(PG8_SA(0, 1), cA + hstep, voffA);
        if (wr == 1) PG8_BAR;
        PG8_WAIT_V(2); PG8_BAR;
        PG8_STAGE(PG8_SB(1, 0), cB + kstep, voffB); PG8_STAGE(PG8_SA(1, 0), cA + kstep, voffA); PG8_STAGE(PG8_SB(1, 1), cB + hstep + kstep, voffB);
        PG8_WAIT_V(6); PG8_BAR;
    } else {
        PG8_STAGE(PG8_SB(0, 0), cB, voffB); PG8_STAGE(PG8_SA(0, 0), cA, voffA); PG8_STAGE(PG8_SB(0, 1), cB + hstep, voffB); PG8_STAGE(PG8_SA(0, 1), cA + hstep, voffA);
        if (wr == 1) PG8_BAR;
        PG8_WAIT_V(4); PG8_BAR;
        PG8_STAGE(PG8_SB(1, 0), cB + kstep, voffB); PG8_STAGE(PG8_SA(1, 0), cA + kstep, voffA); PG8_STAGE(PG8_SB(1, 1), cB + hstep + kstep, voffB);
        PG8_WAIT_V(6); PG8_BAR;
    }
    for (;;) {
        const bool has_next = S.next(ui + 1, nxt);
        const char* nA = has_next ? (const char*)g.A + (size_t)nxt.arow * (size_t)(K * 2) : cA; const char* nB = has_next ? (const char*)g.Bt + (size_t)nxt.pn * tstep : cB;
        for (int t = 0; t < nt; t += 2) {
            const bool last = (t == nt - 2);
            const char* a1 = cA + (size_t)(t + 1) * kstep;
            const char* a2 = last ? nA : cA + (size_t)(t + 2) * kstep; const char* b2 = last ? nB : cB + (size_t)(t + 2) * kstep;
            const char* a3 = a2 + kstep; const char* b3 = b2 + kstep;
            if (last && has_next) S.a_ready(nxt);
            if constexpr (SP2) {
            PG8_LDB(B0, 0, 0); PG8_LDB(B1, 0, 1); PG8_SCHED; PG8_LDA(At, 0, 0); PG8_STAGE(PG8_SA(1, 1), a1 + hstep, voffA);
            PG8_WAIT_V(8); PG8_WAIT_L(0); PG8_BAR; PG8_MMA(0, 0, At, B0); PG8_MMA(0, 1, At, B1); PG8_BAR; PG8_SCHED;
            PG8_LDA(At, 0, 1); PG8_STAGE(PG8_SB(0, 0), b2, voffB); PG8_STAGE(PG8_SB(0, 1), b2 + hstep, voffB); PG8_STAGE(PG8_SA(0, 0), a2, voffA);
            PG8_WAIT_V(8); PG8_WAIT_L(0); PG8_BAR; PG8_MMA(1, 0, At, B0); PG8_MMA(1, 1, At, B1); PG8_BAR; PG8_SCHED;
            PG8_LDB(B0, 1, 0); PG8_LDB(B1, 1, 1); PG8_SCHED; PG8_LDA(At, 1, 0); PG8_STAGE(PG8_SA(0, 1), a2 + hstep, voffA);
            PG8_WAIT_V(8); PG8_WAIT_L(0); PG8_BAR; PG8_MMA(0, 0, At, B0); PG8_MMA(0, 1, At, B1); PG8_BAR; PG8_SCHED;
            PG8_LDA(At, 1, 1); PG8_STAGE(PG8_SB(1, 0), b3, voffB); PG8_STAGE(PG8_SB(1, 1), b3 + hstep, voffB); PG8_STAGE(PG8_SA(1, 0), a3, voffA);
            PG8_WAIT_V(8); PG8_WAIT_L(0); PG8_BAR; PG8_MMA(1, 0, At, B0); PG8_MMA(1, 1, At, B1); PG8_BAR; PG8_SCHED;
            } else {
            PG8_LDB(B0, 0, 0); PG8_SCHED; PG8_LDA(At, 0, 0); PG8_STAGE(PG8_SA(1, 1), a1 + hstep, voffA);
            PG8_WAIT_L(8); PG8_BAR; PG8_WAIT_L(0); PG8_MMA(0, 0, At, B0); PG8_BAR; PG8_SCHED;
            PG8_LDB(B1, 0, 1); PG8_STAGE(PG8_SB(0, 0), b2, voffB);
            PG8_BAR; PG8_WAIT_L(0); PG8_MMA(0, 1, At, B1); PG8_BAR;
            PG8_LDA(At, 0, 1); PG8_STAGE(PG8_SA(0, 0), a2, voffA);
            PG8_BAR; PG8_WAIT_L(0); PG8_MMA(1, 0, At, B0); PG8_BAR; PG8_SCHED;
            PG8_STAGE(PG8_SB(0, 1), b2 + hstep, voffB);
            PG8_WAIT_V(6); PG8_BAR; PG8_MMA(1, 1, At, B1); PG8_BAR;
            PG8_LDB(B0, 1, 0); PG8_SCHED; PG8_LDA(At, 1, 0); PG8_STAGE(PG8_SA(0, 1), a2 + hstep, voffA);
            PG8_WAIT_L(8); PG8_BAR; PG8_WAIT_L(0); PG8_MMA(0, 0, At, B0); PG8_BAR; PG8_SCHED;
            PG8_LDB(B1, 1, 1); PG8_STAGE(PG8_SB(1, 0), b3, voffB);
            PG8_BAR; PG8_WAIT_L(0); PG8_MMA(0, 1, At, B1); PG8_BAR;
            PG8_LDA(At, 1, 1); PG8_STAGE(PG8_SA(1, 0), a3, voffA);
            PG8_BAR; PG8_WAIT_L(0); PG8_MMA(1, 0, At, B0); PG8_BAR; PG8_SCHED;
            PG8_STAGE(PG8_SB(1, 1), b3 + hstep, voffB);
            PG8_WAIT_V(6); PG8_BAR; PG8_MMA(1, 1, At, B1); PG8_BAR;
            }
        }
        if constexpr (ALIGN_EPI) { if (wr == 0) PG8_BAR; }
        if constexpr (!Epi::AFTER_DRAIN) { E(acc, cur, wr, wc, fr, fq); S.done(cur); }
        if (!has_next) break;
#pragma unroll
        for (int a = 0; a < 2; ++a)
#pragma unroll
            for (int b = 0; b < 2; ++b)
#pragma unroll
                for (int m = 0; m < 4; ++m)
#pragma unroll
                    for (int n = 0; n < 2; ++n) acc[a][b][m][n] = (f32x4){0.f, 0.f, 0.f, 0.f};
        cur = nxt; cA = nA; cB = nB; ++ui;
        if constexpr (ALIGN_EPI) { if (wr == 1) PG8_BAR; }
    }
    PG8_WAIT_V(0);
    if constexpr (!ALIGN_EPI) { if (wr == 0) PG8_BAR; }
    PG8_BAR;
    if constexpr (Epi::AFTER_DRAIN) { E.fused(acc, cur, wr, wc, fr, fq, lds, wid, lane); S.done(cur); }
#undef PG8_SA
#undef PG8_SB
#undef PG8_STAGE
#undef PG8_LDA
#undef PG8_LDB
#undef PG8_MMA
#undef PG8_WAIT_V
#undef PG8_WAIT_L
#undef PG8_BAR
#undef PG8_SCHED
}
}

#ifndef PG8_SP2
#define PG8_SP2 true
#endif
#ifndef PG8_ALIGN
#define PG8_ALIGN true
#endif

constexpr int NWAVES = 8, NTHR = 512;
constexpr int D = 1024, NB = 2, NSEQ = 8192, LCTX = 256, TB = LCTX + NSEQ  , T = NB * TB  ;
constexpr int DFF = 2816, GW = 64;
constexpr float EPS = 1e-6f;
constexpr float LOG2E = 1.4426950408889634f;

#define LAS __attribute__((address_space(3)))
#define GAS __attribute__((address_space(1)))
typedef unsigned short bf16;
typedef unsigned v4u __attribute__((ext_vector_type(4)));
typedef unsigned v2u __attribute__((ext_vector_type(2)));
typedef float f32x4 __attribute__((ext_vector_type(4)));
typedef _Float16 h2 __attribute__((ext_vector_type(2)));
typedef GAS unsigned gu32;
#define RLX_AGENT __ATOMIC_RELAXED, __HIP_MEMORY_SCOPE_AGENT
#define LDS_WAIT() asm volatile("s_waitcnt lgkmcnt(0)" ::: "memory")
#define VM_WAIT() asm volatile("s_waitcnt vmcnt(0)" ::: "memory")

constexpr size_t MiB = 1u << 20;
constexpr size_t WS_CTL = 0, CTL_ZERO_BYTES = 64 * 1024;
constexpr size_t WS_TAB = 1 * MiB;
constexpr size_t TAB_COS = 0, TAB_SIN = 16384, TAB_MOD = 32768;
constexpr size_t WS_XCTX = 2 * MiB;
constexpr size_t WS_OCTX = 4 * MiB;
constexpr size_t WS_WT = 6 * MiB;
constexpr size_t WT_GLA_IN = 0, WT_GLA_OUT = 6 * MiB, WT_FFN_IN0 = 8 * MiB, WT_FFN_IN1 = 19 * MiB, WT_FFN_OUT0 = 30 * MiB, WT_FFN_OUT1 = 30 * MiB + 5632 * 1024, WT_NA_QKV = 41 * MiB, WT_NA_OUT = 47 * MiB;
constexpr size_t WS_H = 55 * MiB;
constexpr size_t WS_G = WS_H + 33 * MiB + MiB / 2;
constexpr size_t WS_BIG = WS_G + 33 * MiB;
constexpr size_t WS_END = WS_BIG + 99 * MiB;
static_assert(WS_END <= 256 * MiB, "ws map");
constexpr int CW_BAR = 1024;

constexpr int RING_BYTES = 131072;
constexpr int EDGE_OFF = RING_BYTES;
constexpr int MISC_OFF = RING_BYTES + 8192;
constexpr int LDS_BYTES = 147456;

__device__ __forceinline__ unsigned f2bf(float f) { unsigned u = __builtin_bit_cast(unsigned, f); return (u + 0x7fffu + ((u >> 16) & 1u)) >> 16; }
__device__ __forceinline__ unsigned pk2(float lo, float hi) { return f2bf(lo) | (f2bf(hi) << 16); }
__device__ __forceinline__ float bf2f(unsigned v) { return __builtin_bit_cast(float, v << 16); }
__device__ __forceinline__ float wave_sum(float v) {
#pragma unroll
    for (int o = 1; o < 64; o <<= 1) v += __shfl_xor(v, o);
    return v;
}
__device__ __forceinline__ float fast_silu(float x) { return x * __builtin_amdgcn_rcpf(1.0f + __builtin_amdgcn_exp2f(-x * LOG2E)); }


__device__ __forceinline__ h2 as_h2(unsigned u) { return __builtin_bit_cast(h2, u); }
#ifndef USE_FDOT2
#define USE_FDOT2 1
#endif
__device__ __forceinline__ float dot2_impl(h2 a, h2 b, float c) {
#if USE_FDOT2
    return __builtin_amdgcn_fdot2(a, b, c, false);
#else
    return c + (float)a[0] * (float)b[0] + (float)a[1] * (float)b[1];
#endif
}
#define DOT2(a, b, c, cl) dot2_impl((a), (b), (c))

#define XB_TMO      128
#define XB_XCNT(j)  (256  + 64 * (j))
#define XB_XSUB(j)  (1280 + 64 * (j))
#define XB_XGEN(j)  (2304 + 64 * (j))
#define XB_TOP      3328
#define XB_TOPGEN   3392
#define XCD_BAR_WORDS 3456
#define XB_SPIN_CAP (1u << 23)
__device__ __forceinline__ unsigned xb_ld(unsigned* p)              { return __hip_atomic_load(p, __ATOMIC_RELAXED, __HIP_MEMORY_SCOPE_AGENT); }
__device__ __forceinline__ unsigned xb_add(unsigned* p, unsigned v) { return __hip_atomic_fetch_add(p, v, __ATOMIC_RELAXED, __HIP_MEMORY_SCOPE_AGENT); }
__device__ __forceinline__ unsigned xb_xcc_id() { return (unsigned)__builtin_amdgcn_s_getreg((3 << 11) | 20) & 0xFu; }
#define XB_SPIN(cond, bar) do { unsigned _sp = 0; while (cond) { __builtin_amdgcn_s_sleep(1); \
    if ((++_sp & 255u) == 0u) { if (xb_ld(&(bar)[XB_TMO])) break; if (_sp > XB_SPIN_CAP) { atomicAdd(&(bar)[XB_TMO], 1u); break; } } } } while (0)
struct XcdBarrier { unsigned* bar; unsigned x; volatile LAS unsigned* st; };
__device__ __forceinline__ XcdBarrier xcd_barrier_post(unsigned* bar, volatile LAS unsigned* st) {
    XcdBarrier b; b.bar = bar; b.x = xb_xcc_id(); b.st = st;
    if (threadIdx.x == 0) (void)xb_add(&bar[XB_XCNT(b.x)], 1u);
    return b;
}
__device__ __forceinline__ void xcd_barrier_complete(unsigned* bar, unsigned x, unsigned& nloc, unsigned& nx) {
    const unsigned G = gridDim.x * gridDim.y * gridDim.z;
    unsigned sum, cnt, mine, sp = 0u;
    for (;;) {
        sum = 0u; cnt = 0u; mine = 0u;
#pragma unroll
        for (unsigned j = 0; j < 16; ++j) { const unsigned c = xb_ld(&bar[XB_XCNT(j)]); sum += c; cnt += (c > 0u) ? 1u : 0u; mine = (j == x) ? c : mine; }
        if (sum == G) break;
        __builtin_amdgcn_s_sleep(1);
        if ((++sp & 255u) == 0u) { if (xb_ld(&bar[XB_TMO])) break; if (sp > XB_SPIN_CAP) { atomicAdd(&bar[XB_TMO], 1u); break; } }
    }
    nloc = mine > 0u ? mine : 1u; nx = cnt > 0u ? cnt : 1u;
}
__device__ __forceinline__ void xcd_barrier(const XcdBarrier& b) {
    asm volatile("s_waitcnt vmcnt(0)" ::: "memory");
    __syncthreads();
    if (threadIdx.x == 0) {
        unsigned* bar = b.bar;
        __builtin_amdgcn_s_waitcnt(0);
        unsigned nloc = b.st[0], nx = b.st[1];
        if (nloc == 0u) { xcd_barrier_complete(bar, b.x, nloc, nx); b.st[0] = nloc; b.st[1] = nx; }
        const unsigned old = xb_add(&bar[XB_XSUB(b.x)], 1u);
        const unsigned gen = old / nloc;
        if (old + 1u == (gen + 1u) * nloc) {
            __builtin_amdgcn_fence(__ATOMIC_RELEASE, "agent");
            asm volatile("s_waitcnt vmcnt(0)" ::: "memory");
            const unsigned og = xb_add(&bar[XB_TOP], 1u);
            const unsigned tg = og / nx;
            if (og + 1u == (tg + 1u) * nx) xb_add(&bar[XB_TOPGEN], 1u);
            else XB_SPIN(xb_ld(&bar[XB_TOPGEN]) == tg, bar);
            __builtin_amdgcn_fence(__ATOMIC_ACQUIRE, "agent");
            xb_add(&bar[XB_XGEN(b.x)], 1u);
            asm volatile("s_waitcnt vmcnt(0)" ::: "memory");
        } else {
            XB_SPIN(xb_ld(&bar[XB_XGEN(b.x)]) == gen, bar);
            __builtin_amdgcn_fence(__ATOMIC_ACQUIRE, "agent");
            asm volatile("s_waitcnt vmcnt(0)" ::: "memory");
        }
    }
    __syncthreads();
}

struct Args { const float* in[22]; float* out; unsigned char* ws; int ph_lo, ph_hi; };
enum { I_X = 0, I_C, I_CTX, I_CCTX, I_ADA_W, I_ADA_B, I_N1G, I_N2G, I_FFN_WIN, I_FFN_CW, I_FFN_CB, I_FFN_WOUT, I_GLA_WIN, I_GLA_AW1, I_GLA_AW2, I_GLA_AB, I_GLA_NG, I_GLA_WOUT, I_NA_WQKV, I_NA_RPB, I_NA_WOUT, I_FINAL_G };

struct Frame {
    LAS unsigned char* lds;
    int tid, lane, wave, G, bid;
    const float* const* in;
    float* xlat; float* xctx; float* octx;
    float *rcos, *rsin, *mod;
    bf16 *wt; bf16 *H; _Float16* Gt; bf16* BIG;
};
__device__ __forceinline__ float* xrow(const Frame& F, int row) { const int b = row / TB, p = row % TB; return p < LCTX ? F.xctx + (size_t)(b * LCTX + p) * D : F.xlat + (size_t)(b * NSEQ + p - LCTX) * D; }
__device__ __forceinline__ float* orow(const Frame& F, int row) { const int b = row / TB, p = row % TB; return p < LCTX ? F.octx + (size_t)(b * LCTX + p) * D : F.xlat + (size_t)(b * NSEQ + p - LCTX) * D; }
__device__ __forceinline__ bf16* orow16(const Frame& F, int row) { const int b = row / TB, p = row % TB; return p < LCTX ? (bf16*)F.octx + (size_t)(b * LCTX + p) * D : (bf16*)F.xlat + (size_t)(b * NSEQ + p - LCTX) * D; }
__device__ __forceinline__ const float* xinrow(const Frame& F, int row) { const int b = row / TB, p = row % TB; return p < LCTX ? F.in[I_CTX] + (size_t)(b * LCTX + p) * D : F.in[I_X] + (size_t)(b * NSEQ + p - LCTX) * D; }
__device__ __forceinline__ int modrow(int row) { const int b = row / TB, p = row % TB; return p < LCTX ? 2 : b; }
__device__ __forceinline__ int qk_src(int cl) { const int grp = cl >> 3, within = cl & 7, pi = grp * 4 + (within & 3), x2 = within >> 2; return (pi >> 5) * 64 + x2 * 32 + (pi & 31); }

__device__ __forceinline__ void phase_fence(Frame& F) { asm volatile("" : "+v"(F.tid), "+v"(F.lane)); }
namespace pg8 {
enum RowMap { RM_ALL66 = 0, RM_LAT64 = 1, RM_WIN68 = 2, RM_WIN66 = 3 };
struct Sched {
    int nM, nN, nwg, G, c, rm;
    __device__ __forceinline__ void init(int rm_, int N, int G_, int c_) { rm = rm_; nM = rm_ == RM_ALL66 ? 66 : rm_ == RM_LAT64 ? 64 : rm_ == RM_WIN68 ? 68 : 66; nN = N / BM; nwg = nM * nN; G = G_; c = c_; }
    __device__ __forceinline__ int rowmap(int pm) const {
        if (rm == RM_ALL66) return pm * 256;
        if (rm == RM_LAT64) return (pm >> 5) * TB + LCTX + (pm & 31) * 256;
        if (rm == RM_WIN68) { const int b = pm / 34, j = pm % 34; return b * TB + (j == 0 ? 0 : LCTX + 254 * (j - 1)); }
        { const int b = pm / 33, j = pm % 33; return b * TB + LCTX + 254 * j; }
    }
    __device__ __forceinline__ bool next(int i, Unit& u) const {
        const long L = (long)i * G + c; if (L >= nwg) return false;
        int wgid = (int)L; { const int q = nwg / NXCD, r = nwg % NXCD, xcd = wgid % NXCD, off = wgid / NXCD; wgid = (xcd < r ? xcd * (q + 1) : r * (q + 1) + (xcd - r) * q) + off; }
        const int nig = WGM * nN, gid = wgid / nig, fm = gid * WGM, gsz = (nM - fm) < WGM ? (nM - fm) : WGM;
        u.pm = fm + ((wgid % nig) % gsz); u.pn = (wgid % nig) / gsz; u.arow = rowmap(u.pm); return true;
    }
    __device__ __forceinline__ void a_ready(const Unit&) const {}
    __device__ __forceinline__ void done(const Unit&) const {}
};

__device__ __forceinline__ u32x4 pack8(const f32x4& a, const f32x4& b) { u32x4 w; w.x = cvt_pk_bf16(a[0], a[1]); w.y = cvt_pk_bf16(a[2], a[3]); w.z = cvt_pk_bf16(b[0], b[1]); w.w = cvt_pk_bf16(b[2], b[3]); return w; }

struct EpiGlaIn {
    static constexpr bool PERM = true, AFTER_DRAIN = false;
    bf16_t *Q, *K, *V, *R; const float *rcos, *rsin;
    __device__ __forceinline__ void operator()(const f32x4 (&acc)[2][2][4][2], const Unit& u, int wr, int wc, int fr, int fq) const {
        const int row0 = u.arow + wr * 64 + fr;
        if (u.pn >= 4) {
            bf16_t* base = u.pn < 8 ? V : R; const int col0 = ((u.pn & 3) * 256) + wc * 32 + 8 * fq;
#pragma unroll
            for (int ai = 0; ai < 2; ++ai)
#pragma unroll
                for (int m = 0; m < 4; ++m) { bf16_t* rowp = base + (size_t)(row0 + ai * HALF + m * 16) * 1024 + col0;
#pragma unroll
                    for (int bj = 0; bj < 2; ++bj) *(u32x4*)(rowp + bj * HALF) = pack8(acc[ai][bj][m][0], acc[ai][bj][m][1]); }
        } else {
            const bool isq = u.pn < 2; bf16_t* base = isq ? Q : K; const int col0 = (u.pn & 1) * 256 + wc * 32 + 8 * fq;
            const float sc = isq ? 0.08838834764831845f : 1.0f;
            const bool lat = (u.arow % TB) >= LCTX;
            const int half = wc >> 1, i0 = 16 * (wc & 1) + 4 * fq;
#pragma unroll
            for (int ai = 0; ai < 2; ++ai)
#pragma unroll
                for (int m = 0; m < 4; ++m) { const int row = row0 + ai * HALF + m * 16; bf16_t* rowp = base + (size_t)row * 512 + col0;
                    f32x4 cs = (f32x4){1.f, 1.f, 1.f, 1.f}, sn = (f32x4){0.f, 0.f, 0.f, 0.f};
                    if (lat) { const int pos = (row % TB) - LCTX; const int pr = half == 0 ? (pos >> 6) : (pos & 63); cs = *(const f32x4*)(rcos + pr * 32 + i0); sn = *(const f32x4*)(rsin + pr * 32 + i0); }
#pragma unroll
                    for (int bj = 0; bj < 2; ++bj) { const f32x4 x1 = acc[ai][bj][m][0], x2 = acc[ai][bj][m][1];
                        const f32x4 y1 = (x1 * cs - x2 * sn) * sc, y2 = (x1 * sn + x2 * cs) * sc;
                        *(u32x4*)(rowp + bj * HALF) = pack8(y1, y2); } }
        }
    }
};
struct EpiResid {
    static constexpr bool PERM = false, AFTER_DRAIN = false;
    const float *src_lat, *src_ctx; float *dst_lat, *dst_ctx; const float* gate;
    __device__ __forceinline__ void operator()(const f32x4 (&acc)[2][2][4][2], const Unit& u, int wr, int wc, int fr, int fq) const {
        const int b = u.arow / TB, p0 = u.arow % TB; const bool ctx = p0 < LCTX;
        const size_t rbase = ctx ? (size_t)b * LCTX : (size_t)b * NSEQ + (p0 - LCTX);
        const float* s = (ctx ? src_ctx : src_lat) + rbase * D; float* d = (ctx ? dst_ctx : dst_lat) + rbase * D;
        const float* g = gate + (ctx ? 2 : b) * 6144;
        const int col0 = u.pn * BM + wc * 32 + 4 * fq;
        f32x4 gv[2][2];
#pragma unroll
        for (int bj = 0; bj < 2; ++bj)
#pragma unroll
            for (int n = 0; n < 2; ++n) gv[bj][n] = *(const f32x4*)(g + col0 + bj * HALF + n * 16);
#pragma unroll
        for (int ai = 0; ai < 2; ++ai)
#pragma unroll
            for (int m = 0; m < 4; ++m) { const size_t off = (size_t)(ai * HALF + wr * 64 + m * 16 + fr) * D + col0;
#pragma unroll
                for (int bj = 0; bj < 2; ++bj)
#pragma unroll
                    for (int n = 0; n < 2; ++n) *(f32x4*)(d + off + bj * HALF + n * 16) = *(const f32x4*)(s + off + bj * HALF + n * 16) + gv[bj][n] * acc[ai][bj][m][n]; }
    }
};
struct EpiNaQkv {
    static constexpr bool PERM = true, AFTER_DRAIN = false;
    bf16_t* base;
    __device__ __forceinline__ void operator()(const f32x4 (&acc)[2][2][4][2], const Unit& u, int wr, int wc, int fr, int fq) const {
        const int t = u.pn >> 2; bf16_t* o = base + (size_t)t * T * 1024; const float sc = t == 0 ? 0.125f * 1.4426950408889634f : 1.0f;
        const int row0 = u.arow + wr * 64 + fr, col0 = (u.pn & 3) * 256 + wc * 32 + 8 * fq;
#pragma unroll
        for (int ai = 0; ai < 2; ++ai)
#pragma unroll
            for (int m = 0; m < 4; ++m) { bf16_t* rowp = o + (size_t)(row0 + ai * HALF + m * 16) * 1024 + col0;
#pragma unroll
                for (int bj = 0; bj < 2; ++bj) *(u32x4*)(rowp + bj * HALF) = pack8(acc[ai][bj][m][0] * sc, acc[ai][bj][m][1] * sc); }
    }
};
__device__ __forceinline__ float dpp_ror1(float v) { return __builtin_bit_cast(float, __builtin_amdgcn_update_dpp(0, __builtin_bit_cast(int, v), 0x121, 0xf, 0xf, false)); }
__device__ __forceinline__ float dpp_rol1(float v) { return __builtin_bit_cast(float, __builtin_amdgcn_update_dpp(0, __builtin_bit_cast(int, v), 0x12F, 0xf, 0xf, false)); }
struct EpiFfnIn {
    static constexpr bool PERM = true, AFTER_DRAIN = false;
    bf16_t* U; const float *cw, *cb; PG8_LAS float* edge;
    __device__ __forceinline__ void operator()(f32x4 (&acc)[2][2][4][2], const Unit& u, int wr, int wc, int fr, int fq) const {
        const int b = u.arow / TB, p0 = u.arow % TB; const bool ctx = p0 < LCTX;
        const int seq_lo = b * TB + (ctx ? 0 : LCTX), seq_hi = b * TB + (ctx ? LCTX : TB);
        const int cl = wc * 32 + 8 * fq;
#pragma unroll
        for (int ai = 0; ai < 2; ++ai)
#pragma unroll
            for (int m = 0; m < 4; ++m) { const int row = u.arow + ai * HALF + wr * 64 + m * 16 + fr; const bool ok = row >= seq_lo && row < seq_hi;
                if (!ok) { acc[ai][0][m][0] = (f32x4){0.f, 0.f, 0.f, 0.f}; acc[ai][0][m][1] = (f32x4){0.f, 0.f, 0.f, 0.f}; } }
#pragma unroll
        for (int ai = 0; ai < 2; ++ai) { const int g = 2 * ai + wr;
            if (fr == 0) { *(PG8_LAS f32x4*)(edge + (2 * g) * 128 + cl) = acc[ai][0][0][0]; *(PG8_LAS f32x4*)(edge + (2 * g) * 128 + cl + 4) = acc[ai][0][0][1]; }
            if (fr == 15) { *(PG8_LAS f32x4*)(edge + (2 * g + 1) * 128 + cl) = acc[ai][0][3][0]; *(PG8_LAS f32x4*)(edge + (2 * g + 1) * 128 + cl + 4) = acc[ai][0][3][1]; } }
        asm volatile("s_waitcnt lgkmcnt(0)" ::: "memory"); __builtin_amdgcn_s_barrier(); asm volatile("" ::: "memory");
        const int f0 = u.pn * 128 + cl;
        f32x4 w0[2], w1[2], w2[2], bb[2];
#pragma unroll
        for (int n = 0; n < 2; ++n) { w0[n] = *(const f32x4*)(cw + f0 + 4 * n); w1[n] = *(const f32x4*)(cw + DFF + f0 + 4 * n); w2[n] = *(const f32x4*)(cw + 2 * DFF + f0 + 4 * n); bb[n] = *(const f32x4*)(cb + f0 + 4 * n); }
#pragma unroll
        for (int ai = 0; ai < 2; ++ai) { const int g = 2 * ai + wr;
            f32x4 ep[2], en[2];
#pragma unroll
            for (int n = 0; n < 2; ++n) { ep[n] = g > 0 ? *(const PG8_LAS f32x4*)(edge + (2 * (g - 1) + 1) * 128 + cl + 4 * n) : (f32x4){0.f, 0.f, 0.f, 0.f};
                                          en[n] = g < 3 ? *(const PG8_LAS f32x4*)(edge + (2 * (g + 1)) * 128 + cl + 4 * n) : (f32x4){0.f, 0.f, 0.f, 0.f}; }
#pragma unroll
            for (int m = 0; m < 4; ++m) { const int wrow = ai * HALF + wr * 64 + m * 16 + fr, row = u.arow + wrow;
                float o[8];
#pragma unroll
                for (int n = 0; n < 2; ++n)
#pragma unroll
                    for (int j = 0; j < 4; ++j) { const float cur = acc[ai][0][m][n][j];
                        const float sp = (m > 0 && fr == 15) ? acc[ai][0][m > 0 ? m - 1 : 0][n][j] : cur;
                        float pv = dpp_ror1(sp); if (m == 0) pv = fr == 0 ? ep[n][j] : pv;
                        const float sn = (m < 3 && fr == 0) ? acc[ai][0][m < 3 ? m + 1 : 3][n][j] : cur;
                        float nv = dpp_rol1(sn); if (m == 3) nv = fr == 15 ? en[n][j] : nv;
                        const float ac = pv * w0[n][j] + cur * w1[n][j] + nv * w2[n][j] + bb[n][j];
                        o[4 * n + j] = ac * __builtin_amdgcn_rcpf(1.0f + __builtin_amdgcn_exp2f(-ac * 1.4426950408889634f)) * acc[ai][1][m][n][j]; }
                const bool ok = row >= seq_lo && row < seq_hi && (wrow >= 1 || row == seq_lo) && (wrow <= 254 || row == seq_hi - 1);
                if (ok) { u32x4 w; w.x = cvt_pk_bf16(o[0], o[1]); w.y = cvt_pk_bf16(o[2], o[3]); w.z = cvt_pk_bf16(o[4], o[5]); w.w = cvt_pk_bf16(o[6], o[7]); *(u32x4*)(U + (size_t)row * DFF + f0) = w; } } }
    }
};
}

template <class CMap>
__device__ __forceinline__ void p0_transpose_item(const float* W, int K, int N, bf16* WT, LAS float* scr, int item, int lane, CMap cmap) {
    const int nblk = N / 32, kb = item / nblk, nb = item % nblk, k0 = 64 * kb, n0 = 32 * nb;
    const int srcc = cmap(n0 + (lane & 31));
#pragma unroll 8
    for (int i = 0; i < 32; ++i) { const int kk = 2 * i + (lane >> 5); scr[kk * 33 + (lane & 31)] = W[(size_t)(k0 + kk) * N + srcc]; }
    LDS_WAIT(); asm volatile("" ::: "memory");
    const int c = lane & 7;
#pragma unroll
    for (int j = 0; j < 4; ++j) { const int n = (lane >> 3) + 8 * j; const LAS float* s = scr + (8 * c) * 33 + n;
        v4u o; o.x = pk2(s[0 * 33], s[1 * 33]); o.y = pk2(s[2 * 33], s[3 * 33]); o.z = pk2(s[4 * 33], s[5 * 33]); o.w = pk2(s[6 * 33], s[7 * 33]);
        *(GAS v4u*)(WT + (size_t)(n0 + n) * K + k0 + 8 * c) = o; }
    LDS_WAIT(); asm volatile("" ::: "memory");
}
struct CmId { __device__ __forceinline__ int operator()(int c) const { return c; } };
struct CmGlaIn { __device__ __forceinline__ int operator()(int c) const { return c < 1024 ? (c & ~127) + qk_src(c & 127) : c; } };
struct CmFfnIn { __device__ __forceinline__ int operator()(int c) const { const int t = c >> 8, cl = c & 255; return cl < 128 ? 128 * t + cl : DFF + 128 * t + (cl - 128); } };

__device__ __forceinline__ void p0_prologue(Frame& F) {
    if (F.bid < 192) {
        LAS float* s = (LAS float*)F.lds;
        LAS float* part = (LAS float*)(F.lds + 12288);
        for (int e = F.tid; e < 3 * D; e += NTHR) { const int r = e / D, k = e % D; const float v = r < 2 ? F.in[I_C][r * D + k] : F.in[I_CCTX][k]; s[e] = v / (1.0f + expf(-v)); }
        __syncthreads();
        const int layer = F.bid / 96, n = (F.bid % 96) * 64 + (F.tid & 63), ks = F.tid >> 6;
        const float* w = F.in[I_ADA_W] + (size_t)layer * D * 6144 + n;
        float a0 = 0.f, a1 = 0.f, a2 = 0.f;
#pragma unroll 8
        for (int k = ks * 128; k < ks * 128 + 128; ++k) { const float wv = w[(size_t)k * 6144]; a0 += s[k] * wv; a1 += s[D + k] * wv; a2 += s[2 * D + k] * wv; }
        part[(ks * 3 + 0) * 64 + (F.tid & 63)] = a0; part[(ks * 3 + 1) * 64 + (F.tid & 63)] = a1; part[(ks * 3 + 2) * 64 + (F.tid & 63)] = a2;
        __syncthreads();
        if (F.tid < 192) { const int r = F.tid >> 6, cc = F.tid & 63; float t = 0.f;
#pragma unroll
            for (int q = 0; q < 8; ++q) t += part[(q * 3 + r) * 64 + cc];
            const int nn = (F.bid % 96) * 64 + cc;
            F.mod[((size_t)layer * 3 + r) * 6144 + nn] = t + F.in[I_ADA_B][layer * 6144 + nn]; }
        __syncthreads();
    } else if (F.bid < 200) {
        const int e = (F.bid - 192) * NTHR + F.tid; const int pos = e >> 5, i = e & 31;
        const float inv = 1.0f / powf(10000.0f, (float)(2 * i) / 64.0f); const float ang = (float)pos * inv;
        F.rcos[e] = cosf(ang); F.rsin[e] = sinf(ang);
    }
    LAS float* scr = (LAS float*)(F.lds + F.wave * 16384);
    const int gw = F.bid * NWAVES + F.wave, NGW = F.G * NWAVES;
    constexpr int I_GI = 16 * 96, I_GO = 16 * 32, I_FI = 16 * 176, I_FO = 44 * 32, I_NQ = 16 * 96, I_NO = 16 * 32;
    constexpr int NITEMS = I_GI + I_GO + 2 * I_FI + 2 * I_FO + I_NQ + I_NO;
    for (int it = gw; it < NITEMS; it += NGW) {
        int r = it;
        if (r < I_GI) { p0_transpose_item(F.in[I_GLA_WIN], D, 3072, (bf16*)((char*)F.wt + WT_GLA_IN), scr, r, F.lane, CmGlaIn{}); continue; } r -= I_GI;
        if (r < I_GO) { p0_transpose_item(F.in[I_GLA_WOUT], D, 1024, (bf16*)((char*)F.wt + WT_GLA_OUT), scr, r, F.lane, CmId{}); continue; } r -= I_GO;
        if (r < I_FI) { p0_transpose_item(F.in[I_FFN_WIN], D, 5632, (bf16*)((char*)F.wt + WT_FFN_IN0), scr, r, F.lane, CmFfnIn{}); continue; } r -= I_FI;
        if (r < I_FI) { p0_transpose_item(F.in[I_FFN_WIN] + (size_t)D * 5632, D, 5632, (bf16*)((char*)F.wt + WT_FFN_IN1), scr, r, F.lane, CmFfnIn{}); continue; } r -= I_FI;
        if (r < I_FO) { p0_transpose_item(F.in[I_FFN_WOUT], DFF, 1024, (bf16*)((char*)F.wt + WT_FFN_OUT0), scr, r, F.lane, CmId{}); continue; } r -= I_FO;
        if (r < I_FO) { p0_transpose_item(F.in[I_FFN_WOUT] + (size_t)DFF * 1024, DFF, 1024, (bf16*)((char*)F.wt + WT_FFN_OUT1), scr, r, F.lane, CmId{}); continue; } r -= I_FO;
        if (r < I_NQ) { p0_transpose_item(F.in[I_NA_WQKV], D, 3072, (bf16*)((char*)F.wt + WT_NA_QKV), scr, r, F.lane, CmId{}); continue; } r -= I_NQ;
        p0_transpose_item(F.in[I_NA_WOUT], D, 1024, (bf16*)((char*)F.wt + WT_NA_OUT), scr, r, F.lane, CmId{});
    }
}

template <bool GATE, bool FROM_INPUT>
__device__ __forceinline__ void modulate_phase(Frame& F, int layer, int which) {
    LAS _Float16* W1p = (LAS _Float16*)F.lds;
    LAS unsigned* W2p = (LAS unsigned*)(F.lds + 65536);
    LAS float* B2 = (LAS float*)(F.lds + 65536 + 32768);
    LAS _Float16* hrow = (LAS _Float16*)(F.lds + 65536 + 32768 + 4096) + F.wave * 1024;
    if (GATE) {
        const float* w1 = F.in[I_GLA_AW1];
        for (int s = F.tid; s < 32768; s += NTHR) { const int dir = s >> 14, k = (s >> 4) & 1023, j = s & 15; W1p[((k >> 3) * 32 + dir * 16 + j) * 8 + (k & 7)] = (_Float16)w1[s]; }
        const float* w2 = F.in[I_GLA_AW2];
        for (int s = F.tid; s < 8192; s += NTHR) { const int djp = s >> 9, c = s & 511, dir = djp >> 3, jp = djp & 7; const int oc = (c & ~127) + qk_src(c & 127);
            const h2 pr = (h2){(_Float16)w2[(dir * 16 + 2 * jp) * 512 + oc], (_Float16)w2[(dir * 16 + 2 * jp + 1) * 512 + oc]}; W2p[s] = __builtin_bit_cast(unsigned, pr); }
        for (int s = F.tid; s < 1024; s += NTHR) { const int dir = s >> 9, c = s & 511; B2[s] = F.in[I_GLA_AB][dir * 512 + (c & ~127) + qk_src(c & 127)]; }
        __syncthreads();
#if GATE_CHECK
        { unsigned bad = 0;
          for (int s = F.tid; s < 32768; s += NTHR) { const int dir = s >> 14, k = (s >> 4) & 1023, j = s & 15; const float got = (float)W1p[((k >> 3) * 32 + dir * 16 + j) * 8 + (k & 7)]; bad += fabsf(got - w1[s]) > 1e-3f; }
          if (bad) atomicAdd((unsigned*)((char*)F.wt - WS_WT + WS_CTL + 32768) + 4, bad); }
        __syncthreads();
#endif
    }
    const float* gn = F.in[which == 0 ? I_N1G : I_N2G] + layer * D;
    const int gw = F.bid * NWAVES + F.wave, NGW = F.G * NWAVES;
    for (int row = gw; row < T; row += NGW) {
        const float* x = FROM_INPUT ? xinrow(F, row) : (const float*)xrow(F, row);
        const float* m = F.mod + ((size_t)layer * 3 + modrow(row)) * 6144;
        const float* sh = m + (which == 0 ? 0 : 3) * D; const float* sc = m + (which == 0 ? 1 : 4) * D;
        f32x4 v[4]; float ss = 0.f;
#pragma unroll
        for (int j = 0; j < 4; ++j) { v[j] = *(const f32x4*)(x + F.lane * 4 + 256 * j); ss += (v[j][0] * v[j][0] + v[j][1] * v[j][1]) + (v[j][2] * v[j][2] + v[j][3] * v[j][3]); }
        const float rs = rsqrtf(wave_sum(ss) * (1.0f / D) + EPS);
#pragma unroll
        for (int j = 0; j < 4; ++j) { const int n = F.lane * 4 + 256 * j; const f32x4 g4 = *(const f32x4*)(gn + n), s4 = *(const f32x4*)(sc + n), h4 = *(const f32x4*)(sh + n);
            v[j] = (v[j] * rs * g4) * (s4 + 1.0f) + h4;
            v2u w; w.x = pk2(v[j][0], v[j][1]); w.y = pk2(v[j][2], v[j][3]); *(v2u*)(F.H + (size_t)row * D + n) = w;
            if (GATE) { const h2 a = (h2){(_Float16)v[j][0], (_Float16)v[j][1]}, b = (h2){(_Float16)v[j][2], (_Float16)v[j][3]};
                v2u hw2; hw2.x = __builtin_bit_cast(unsigned, a); hw2.y = __builtin_bit_cast(unsigned, b); *(LAS v2u*)(hrow + n) = hw2; } }
        if (GATE) {
            LDS_WAIT(); asm volatile("" ::: "memory");
#if GATE_CHECK == 2
            { unsigned bad = 0; const int ol = (F.lane + 1) & 63;
              for (int j = 0; j < 4; ++j) for (int t = 0; t < 4; ++t) { const float want = __shfl(v[j][t], ol); const float got = (float)hrow[ol * 4 + 256 * j + t]; bad += fabsf(got - want) > 0.01f + 0.01f * fabsf(want); }
              if (bad) atomicAdd((unsigned*)((char*)F.wt - WS_WT + WS_CTL + 32768) + 4, bad); }
#endif
            const int mo = F.lane & 31, kh = F.lane >> 5;
            float a0 = 0.f, a1 = 0.f;
#pragma unroll 8
            for (int i = 0; i < 64; ++i) { const int k8 = kh * 64 + i;
                const v4u hv = *(const LAS v4u*)(hrow + k8 * 8); const v4u wv = *(const LAS v4u*)(W1p + (k8 * 32 + mo) * 8);
                a0 = DOT2(as_h2(hv.x), as_h2(wv.x), a0, false); a1 = DOT2(as_h2(hv.y), as_h2(wv.y), a1, false);
                a0 = DOT2(as_h2(hv.z), as_h2(wv.z), a0, false); a1 = DOT2(as_h2(hv.w), as_h2(wv.w), a1, false); }
            float hsum = a0 + a1; hsum += __shfl_xor(hsum, 32);
#if GATE_NAIVE
            { float mine = 0.f;
              for (int mm = 0; mm < 32; ++mm) { float p = 0.f; const float* wq = F.in[I_GLA_AW1] + (size_t)(mm >> 4) * D * 16 + (mm & 15);
                  for (int j = 0; j < 4; ++j) for (int t = 0; t < 4; ++t) p += v[j][t] * wq[(size_t)(F.lane * 4 + 256 * j + t) * 16];
                  p = wave_sum(p); if (mo == mm) mine = p; }
              hsum = mine; }
#endif
#if MK_HYBRID
            if (F.lane < 32) ((float*)F.BIG)[(size_t)row * 32 + F.lane] = hsum;
#endif
            unsigned hwp[16];
#pragma unroll
            for (int q = 0; q < 16; ++q) { const float e0 = __builtin_bit_cast(float, __builtin_amdgcn_readlane(__builtin_bit_cast(int, hsum), 2 * q)), e1 = __builtin_bit_cast(float, __builtin_amdgcn_readlane(__builtin_bit_cast(int, hsum), 2 * q + 1));
                hwp[q] = __builtin_bit_cast(unsigned, (h2){(_Float16)e0, (_Float16)e1}); }
#pragma unroll
            for (int grp = 0; grp < 4; ++grp) { const int dir = grp >> 1, c4 = F.lane * 4 + 256 * (grp & 1);
                f32x4 xg = *(const LAS f32x4*)(B2 + dir * 512 + c4);
#pragma unroll
                for (int jp = 0; jp < 8; ++jp) { const v4u wv = *(const LAS v4u*)(W2p + (dir * 8 + jp) * 512 + c4); const h2 hp = as_h2(hwp[dir * 8 + jp]);
                    xg[0] = DOT2(hp, as_h2(wv.x), xg[0], false); xg[1] = DOT2(hp, as_h2(wv.y), xg[1], false);
                    xg[2] = DOT2(hp, as_h2(wv.z), xg[2], false); xg[3] = DOT2(hp, as_h2(wv.w), xg[3], false); }
                _Float16 o[4];
#pragma unroll
                for (int t = 0; t < 4; ++t) { const float xv = xg[t]; const float tt = __builtin_amdgcn_exp2f(-fabsf(xv) * LOG2E);
                    o[t] = (_Float16)((fminf(xv, 0.f) * LOG2E - __builtin_amdgcn_logf(1.0f + tt)) * (1.0f / 16.0f)); }
                v2u w; w.x = (unsigned)__builtin_bit_cast(unsigned short, o[0]) | ((unsigned)__builtin_bit_cast(unsigned short, o[1]) << 16); w.y = (unsigned)__builtin_bit_cast(unsigned short, o[2]) | ((unsigned)__builtin_bit_cast(unsigned short, o[3]) << 16);
                *(v2u*)(F.Gt + ((size_t)dir * T + row) * 512 + c4) = w; }
            LDS_WAIT(); asm volatile("" ::: "memory");
        }
    }
}

__device__ __forceinline__ void gla_golden_phase(Frame& F) {
    if (F.bid >= 128) return;
    LAS float* red = (LAS float*)F.lds;
    const int tid = F.tid, e = tid & 15, dg = tid >> 4;
    const int sl = F.bid & 15, h = (F.bid >> 4) & 3, b = F.bid >> 6;
    const int vcol = h * 256 + sl * 16;
    const bf16* Q = F.BIG; const bf16* K = Q + (size_t)T * 512; const bf16* V = K + (size_t)T * 512;
    for (int dir = 0; dir < 2; ++dir) {
        float S[4] = {0.f, 0.f, 0.f, 0.f};
        int par = 0;
        for (int seg = 0; seg < 2; ++seg) {
            const int n = seg == 0 ? LCTX : NSEQ; const int base = b * TB + (seg == 0 ? 0 : LCTX);
            for (int s = 0; s < n; ++s) {
                const int row = base + (dir == 0 ? s : n - 1 - s);
#if GLA_NOSTATE
                if ((s & 63) == 0) { S[0] = 0.f; S[1] = 0.f; S[2] = 0.f; S[3] = 0.f; }
#endif
                const v2u qw = *(const v2u*)(Q + (size_t)row * 512 + h * 128 + dg * 4);
                const v2u kw = *(const v2u*)(K + (size_t)row * 512 + h * 128 + dg * 4);
                const v2u gw = *(const v2u*)(F.Gt + ((size_t)dir * T + row) * 512 + h * 128 + dg * 4);
                const float v = bf2f(V[(size_t)row * 1024 + vcol + e]);
                const unsigned qa[2] = {qw.x, qw.y}, ka[2] = {kw.x, kw.y}, ga[2] = {gw.x, gw.y};
                float part = 0.f;
#pragma unroll
                for (int i = 0; i < 4; ++i) {
                    const float q = bf2f((qa[i >> 1] >> ((i & 1) * 16)) & 0xffffu), k = bf2f((ka[i >> 1] >> ((i & 1) * 16)) & 0xffffu);
                    const float g = (float)__builtin_bit_cast(_Float16, (unsigned short)((ga[i >> 1] >> ((i & 1) * 16)) & 0xffffu));
                    S[i] = __builtin_amdgcn_exp2f(g) * S[i] + k * v; part += q * S[i];
                }
                red[(par * 32 + dg) * 17 + e] = part;
                __syncthreads();
                if (tid < 16) { float o = 0.f;
#pragma unroll
                    for (int g2 = 0; g2 < 32; ++g2) o += red[(par * 32 + g2) * 17 + tid];
                    float* dst = orow(F, row) + vcol + tid;
                    if (dir == 0) *dst = o; else *dst += o; }
                par ^= 1;
            }
        }
        __syncthreads();
    }
}
__device__ __forceinline__ void gla_post_phase(Frame& F) {
    const bf16* R = F.BIG + (size_t)T * 2048;
    const float* ng = F.in[I_GLA_NG];
    const int gw = F.bid * NWAVES + F.wave, NGW = F.G * NWAVES;
    for (int row = gw; row < T; row += NGW) {
        const float* o = orow(F, row);
#pragma unroll
        for (int j = 0; j < 4; ++j) { const f32x4 v = *(const f32x4*)(o + F.lane * 4 + 256 * j);
            const float rs = rsqrtf(wave_sum((v[0] * v[0] + v[1] * v[1]) + (v[2] * v[2] + v[3] * v[3])) * (1.0f / 256.0f) + EPS);
            const f32x4 g4 = *(const f32x4*)(ng + F.lane * 4); const v2u rw = *(const v2u*)(R + (size_t)row * 1024 + F.lane * 4 + 256 * j);
            const float r0 = bf2f(rw.x & 0xffffu), r1 = bf2f(rw.x >> 16), r2 = bf2f(rw.y & 0xffffu), r3 = bf2f(rw.y >> 16);
            v2u w; w.x = pk2(v[0] * rs * g4[0] * fast_silu(r0), v[1] * rs * g4[1] * fast_silu(r1)); w.y = pk2(v[2] * rs * g4[2] * fast_silu(r2), v[3] * rs * g4[3] * fast_silu(r3));
            *(v2u*)(F.H + (size_t)row * D + F.lane * 4 + 256 * j) = w; }
    }
}
__device__ __forceinline__ void na_golden_phase(Frame& F) {
    const int grp = F.tid >> 7, t = F.tid & 127;
    LAS float* q = (LAS float*)F.lds + grp * 1024;
    LAS float* pr = q + 64;
    LAS int* krow = (LAS int*)(q + 448);
    LAS float* red = q + 832;
    const bf16* NQ = F.BIG; const bf16* NK = NQ + (size_t)T * 1024; const bf16* NV = NK + (size_t)T * 1024;
    const float* rpb = F.in[I_NA_RPB];
    const int nitems = NB * NSEQ * 16, stride = F.G * 4;
    for (int it0 = F.bid * 4; it0 < nitems; it0 += stride) {
        const int item = it0 + grp; const bool act = item < nitems;
        const int h = item & 15, tok = act ? item >> 4 : 0;
        const int b = tok / NSEQ, pos = tok % NSEQ, r = pos / GW, c = pos % GW, row = b * TB + LCTX + pos;
        int rs = r - 4; rs = rs < 0 ? 0 : (rs > 120 ? 120 : rs);
        int cs = c - 8; cs = cs < 0 ? 0 : (cs > 48 ? 48 : cs);
        if (t < 64) q[t] = bf2f(NQ[(size_t)row * 1024 + h * 64 + t]);
        __syncthreads();
        float sc[3]; float mx = -3.0e38f;
        for (int m = 0; m < 3; ++m) {
            const int idx = t + 128 * m; int kr; float bias = 0.f;
            if (idx < 128) { const int i = idx >> 4, j = idx & 15; kr = b * TB + LCTX + (rs + i) * GW + (cs + j); bias = rpb[((size_t)h * 15 + (rs + i - r + 7)) * 31 + (cs + j - c + 15)]; }
            else kr = b * TB + (idx - 128);
            krow[idx] = kr;
            const bf16* kp = NK + (size_t)kr * 1024 + h * 64;
            float s = 0.f;
            for (int d8 = 0; d8 < 8; ++d8) { const v4u w = *(const v4u*)(kp + d8 * 8);
                s += q[d8 * 8 + 0] * bf2f(w.x & 0xffffu) + q[d8 * 8 + 1] * bf2f(w.x >> 16) + q[d8 * 8 + 2] * bf2f(w.y & 0xffffu) + q[d8 * 8 + 3] * bf2f(w.y >> 16)
                   + q[d8 * 8 + 4] * bf2f(w.z & 0xffffu) + q[d8 * 8 + 5] * bf2f(w.z >> 16) + q[d8 * 8 + 6] * bf2f(w.w & 0xffffu) + q[d8 * 8 + 7] * bf2f(w.w >> 16); }
            s += bias * LOG2E; sc[m] = s; mx = fmaxf(mx, s);
        }
        for (int o = 32; o > 0; o >>= 1) mx = fmaxf(mx, __shfl_xor(mx, o));
        if ((t & 63) == 0) red[t >> 6] = mx;
        __syncthreads();
        mx = fmaxf(red[0], red[1]);
        __syncthreads();
        float sum = 0.f;
        for (int m = 0; m < 3; ++m) { const float e = __builtin_amdgcn_exp2f(sc[m] - mx); pr[t + 128 * m] = e; sum += e; }
        for (int o = 32; o > 0; o >>= 1) sum += __shfl_xor(sum, o);
        if ((t & 63) == 0) red[t >> 6] = sum;
        __syncthreads();
        const float inv = 1.0f / (red[0] + red[1]);
        if (t < 64 && act) { float o = 0.f;
            for (int idx = 0; idx < 384; ++idx) o += pr[idx] * bf2f(NV[(size_t)krow[idx] * 1024 + h * 64 + t]);
            F.H[(size_t)row * 1024 + h * 64 + t] = (bf16)f2bf(o * inv); }
        __syncthreads();
    }
}
__device__ __forceinline__ void final_phase(Frame& F) {
    const float* fg = F.in[I_FINAL_G];
    const int gw = F.bid * NWAVES + F.wave, NGW = F.G * NWAVES;
    for (int row = gw; row < NB * NSEQ; row += NGW) {
        float* x = F.xlat + (size_t)row * D;
        f32x4 v[4]; float ss = 0.f;
#pragma unroll
        for (int j = 0; j < 4; ++j) { v[j] = *(const f32x4*)(x + F.lane * 4 + 256 * j); ss += (v[j][0] * v[j][0] + v[j][1] * v[j][1]) + (v[j][2] * v[j][2] + v[j][3] * v[j][3]); }
        const float rs = rsqrtf(wave_sum(ss) * (1.0f / D) + EPS);
#pragma unroll
        for (int j = 0; j < 4; ++j) *(f32x4*)(x + F.lane * 4 + 256 * j) = v[j] * rs * *(const f32x4*)(fg + F.lane * 4 + 256 * j);
    }
}


#if PROBE_STAMP >= 200
#define PROF(k) do { if (F.bid == 0 && F.tid == 0) { unsigned long long* pa = (unsigned long long*)((char*)F.mod - (WS_TAB + TAB_MOD) + WS_CTL + 49152); const unsigned long long nw = __builtin_amdgcn_s_memrealtime(); pa[(k) + 1] += nw - pa[0]; pa[0] = nw; } } while (0)
#define PROF_START() do { if (F.bid == 0 && F.tid == 0) { unsigned long long* pa = (unsigned long long*)((char*)F.mod - (WS_TAB + TAB_MOD) + WS_CTL + 49152); pa[0] = __builtin_amdgcn_s_memrealtime(); } } while (0)
#else
#define PROF(k) do { } while (0)
#define PROF_START() do { } while (0)
#endif
namespace gla {
typedef short s16x4 __attribute__((ext_vector_type(4)));
typedef short s16x8 __attribute__((ext_vector_type(8)));
typedef _Float16 f16x8 __attribute__((ext_vector_type(8)));
constexpr int PQ = 272, PV = 528, PA = 144;
constexpr int L_Q = 0, L_K = 17408, L_G = 34816, L_V = 52224, L_A = 86016, L_D = 95232, L_R = 95744, L_M = 97792;
constexpr int NSC = 33;
constexpr size_t ST_SLOT = 32768;

__device__ __forceinline__ s16x4 trread(LAS unsigned char* p) { return __builtin_amdgcn_ds_read_tr16_b64_v4i16((LAS s16x4*)p); }
__device__ __forceinline__ s16x8 cat8(s16x4 a, s16x4 b) { return __builtin_shufflevector(a, b, 0, 1, 2, 3, 4, 5, 6, 7); }
__device__ __forceinline__ f32x4 mfma_bf16(s16x8 a, s16x8 b, f32x4 c) { return __builtin_amdgcn_mfma_f32_16x16x32_bf16(a, b, c, 0, 0, 0); }
__device__ __forceinline__ f32x4 mfma_f16(f16x8 a, f16x8 b, f32x4 c) { return __builtin_amdgcn_mfma_f32_16x16x32_f16(a, b, c, 0, 0, 0); }
__device__ __forceinline__ float ex2(float x) { return __builtin_amdgcn_exp2f(x); }
typedef float f32x2_t __attribute__((ext_vector_type(2)));
typedef __bf16 bf16x2_t __attribute__((ext_vector_type(2)));
__device__ __forceinline__ unsigned cvt2(float lo, float hi) { const f32x2_t v = {lo, hi}; const bf16x2_t b = __builtin_convertvector(v, bf16x2_t); return __builtin_bit_cast(unsigned, b); }
__device__ __forceinline__ v2u pack4(float a, float b, float c, float d) { v2u w; w.x = cvt2(a, b); w.y = cvt2(c, d); return w; }
#define GLA_BAR() do { asm volatile("s_waitcnt lgkmcnt(0)" ::: "memory"); __builtin_amdgcn_s_barrier(); asm volatile("" ::: "memory"); } while (0)

__device__ __forceinline__ void mask_fill(const Frame& F) {
    for (int idx = F.tid; idx < 4096; idx += NTHR) { const int ii = idx >> 6, jj = idx & 63;
        *(LAS _Float16*)(F.lds + L_M + ii * PA + jj * 2) = jj <= ii ? (_Float16)1.0f : (_Float16)0.0f;
        *(LAS _Float16*)(F.lds + L_M + 64 * PA + ii * PA + jj * 2) = jj >= ii ? (_Float16)1.0f : (_Float16)0.0f; }
    __syncthreads();
}
__device__ __forceinline__ int opq(int v) { asm volatile("" : "+v"(v)); return v; }
struct Raw { v4u q[2], k[2], g[2], v[4]; };
template <bool NEEDQ, int PART  >
__device__ __forceinline__ void raw_load(Raw& R, const Frame& F, const bf16* Q, const bf16* K, const bf16* V, int dir, int row0, int h) {
    const int tid = opq(F.tid);
#pragma unroll
    for (int x = 0; x < 2; ++x) { const int p = tid + 512 * x, r = p >> 4, c = p & 15; const size_t o = (size_t)(row0 + r) * 512 + h * 128 + c * 8;
        if (NEEDQ && PART != 0) R.q[x] = *(const v4u*)(Q + o);
        if (PART != 1) R.k[x] = *(const v4u*)(K + o);
        if (PART != 0) R.g[x] = *(const v4u*)(F.Gt + (size_t)dir * T * 512 + o); }
    if (PART != 0) {
#pragma unroll
        for (int x = 0; x < 4; ++x) { const int p = tid + 512 * x, r = p >> 5, c = p & 31; R.v[x] = *(const v4u*)(V + (size_t)(row0 + r) * 1024 + h * 256 + c * 8); } }
}
template <bool NEEDQ>
__device__ __forceinline__ void raw_store(const Raw& R, const Frame& F) {
    const int tid = opq(F.tid);
#pragma unroll
    for (int x = 0; x < 2; ++x) { const int p = tid + 512 * x, r = p >> 4, c = p & 15; const int o = r * PQ + c * 16;
        if (NEEDQ) *(LAS v4u*)(F.lds + L_Q + o) = R.q[x];
        *(LAS v4u*)(F.lds + L_K + o) = R.k[x];
        *(LAS v4u*)(F.lds + L_G + o) = R.g[x]; }
#pragma unroll
    for (int x = 0; x < 4; ++x) { const int p = tid + 512 * x, r = p >> 5, c = p & 31; *(LAS v4u*)(F.lds + L_V + r * PV + c * 16) = R.v[x]; }
}

template <bool NEEDQ>
__device__ __forceinline__ void decay_step(const Frame& F, bool fwd, f32x4& blsum) {
    const int ln = opq(F.lane); const int w = F.wave, i = ln & 15, q4 = ln >> 4;
    f32x4 bacc[4];
#pragma unroll
    for (int it = 0; it < 4; ++it) bacc[it] = (f32x4){0.f, 0.f, 0.f, 0.f};
    s16x8 ga[2];
#pragma unroll
    for (int kb = 0; kb < 2; ++kb) { LAS unsigned char* p = F.lds + L_G + (32 * kb + 8 * q4 + (i >> 2)) * PQ + (16 * w + 4 * (i & 3)) * 2;
        const s16x4 lo = trread(p), hi = trread(p + 4 * PQ); ga[kb] = cat8(lo, hi); }
#pragma unroll
    for (int it = 0; it < 4; ++it)
#pragma unroll
        for (int kb = 0; kb < 2; ++kb) {
            const bool skip = fwd ? (kb == 1 && it < 2) : (kb == 0 && it >= 2);
            if (!skip) { const f16x8 m = *(const LAS f16x8*)(F.lds + L_M + (fwd ? 0 : 64 * PA) + (16 * it + i) * PA + (32 * kb + 8 * q4) * 2);
                bacc[it] = mfma_f16(__builtin_bit_cast(f16x8, ga[kb]), m, bacc[it]); }
        }
    const int srcl = (ln & 48) | (fwd ? 15 : 0);
    f32x4 bl; { const f32x4 t3 = bacc[3], t0 = bacc[0];
#pragma unroll
        for (int r = 0; r < 4; ++r) bl[r] = __shfl(fwd ? t3[r] : t0[r], srcl); }
    if (!NEEDQ) blsum += bl;
    if (i == 0) { f32x4 d;
#pragma unroll
        for (int r = 0; r < 4; ++r) d[r] = ex2(bl[r]);
        *(LAS f32x4*)(F.lds + L_D + (16 * w + 4 * q4) * 4) = d; }
#pragma unroll
    for (int it = 0; it < 4; ++it) { const int o = (16 * it + i) * PQ + (16 * w + 4 * q4) * 2;
        const v2u kv = *(const LAS v2u*)(F.lds + L_K + o);
        const unsigned kx = kv.x, ky = kv.y;
        const float k0 = bf2f(kx & 0xffffu), k1 = bf2f(kx >> 16), k2 = bf2f(ky & 0xffffu), k3 = bf2f(ky >> 16);
        const f32x4 b = bacc[it];
        const float e20 = ex2(-b[0]), e21 = ex2(-b[1]), e22 = ex2(-b[2]), e23 = ex2(-b[3]);
        const float e30 = ex2(bl[0] - b[0]), e31 = ex2(bl[1] - b[1]), e32 = ex2(bl[2] - b[2]), e33 = ex2(bl[3] - b[3]);
        if (NEEDQ) { const v2u qv = *(const LAS v2u*)(F.lds + L_Q + o); const unsigned qx = qv.x, qy = qv.y;
            const float q0 = bf2f(qx & 0xffffu), q1 = bf2f(qx >> 16), q2 = bf2f(qy & 0xffffu), q3 = bf2f(qy >> 16);
            *(LAS v2u*)(F.lds + L_Q + o) = pack4(q0 * ex2(b[0]), q1 * ex2(b[1]), q2 * ex2(b[2]), q3 * ex2(b[3]));
            *(LAS v2u*)(F.lds + L_K + o) = pack4(k0 * e20, k1 * e21, k2 * e22, k3 * e23); }
        *(LAS v2u*)(F.lds + L_G + o) = pack4(k0 * e30, k1 * e31, k2 * e32, k3 * e33); }
}
__device__ __forceinline__ void load_vf(const Frame& F, s16x8 (&vf)[2][2]) {
    const int ln = opq(F.lane); const int w = F.wave, i = ln & 15, q4 = ln >> 4;
#pragma unroll
    for (int kb = 0; kb < 2; ++kb)
#pragma unroll
        for (int ee = 0; ee < 2; ++ee) { LAS unsigned char* p = F.lds + L_V + (32 * kb + 8 * q4 + (i >> 2)) * PV + (16 * (2 * w + ee) + 4 * (i & 3)) * 2;
            vf[kb][ee] = cat8(trread(p), trread(p + 4 * PV)); }
}
__device__ __forceinline__ void state_update(const Frame& F, f32x4 (&S)[8][2], const s16x8 (&vf)[2][2]) {
    const int ln = opq(F.lane); const int i = ln & 15, q4 = ln >> 4;
#pragma unroll
    for (int dt = 0; dt < 8; ++dt) { const f32x4 dl = *(const LAS f32x4*)(F.lds + L_D + (16 * dt + 4 * q4) * 4);
        S[dt][0] *= dl; S[dt][1] *= dl;
#pragma unroll
        for (int kb = 0; kb < 2; ++kb) { LAS unsigned char* p = F.lds + L_G + (32 * kb + 8 * q4 + (i >> 2)) * PQ + (16 * dt + 4 * (i & 3)) * 2;
            const s16x8 kd = cat8(trread(p), trread(p + 4 * PQ));
            S[dt][0] = mfma_bf16(kd, vf[kb][0], S[dt][0]); S[dt][1] = mfma_bf16(kd, vf[kb][1], S[dt][1]); }
        if (dt & 1) asm volatile("" ::: "memory"); }
}
__device__ __forceinline__ void state_store(const Frame& F, bf16* slot, const f32x4 (&S)[8][2]) {
#pragma unroll
    for (int dt = 0; dt < 8; ++dt)
#pragma unroll
        for (int ee = 0; ee < 2; ++ee) { const f32x4 s = S[dt][ee]; *(v2u*)(slot + ((size_t)(F.wave * 16 + dt * 2 + ee) * 64 + F.lane) * 4) = pack4(s[0], s[1], s[2], s[3]); }
}
__device__ __forceinline__ void state_load(const Frame& F, const bf16* slot, f32x4 (&S)[8][2]) {
#pragma unroll
    for (int dt = 0; dt < 8; ++dt)
#pragma unroll
        for (int ee = 0; ee < 2; ++ee) { const v2u s = *(const v2u*)(slot + ((size_t)(F.wave * 16 + dt * 2 + ee) * 64 + F.lane) * 4); const unsigned sx = s.x, sy = s.y;
            S[dt][ee] = (f32x4){bf2f(sx & 0xffffu), bf2f(sx >> 16), bf2f(sy & 0xffffu), bf2f(sy >> 16)}; }
}

__device__ __forceinline__ void s1_phase(Frame& F, bf16* ST, float* DT) {
    const bf16* Q = F.BIG; const bf16* K = Q + (size_t)T * 512; const bf16* V = K + (size_t)T * 512;
    const int nitems = 16 * NSC;
    if (F.bid >= F.G - 8) return;
    mask_fill(F);
    for (int item = F.bid; item < nitems; item += F.G - 8) {
        const int sc = item % NSC, bhd = item / NSC, dir = bhd & 1, h = (bhd >> 1) & 3, b = bhd >> 3;
        const bool fwd = dir == 0; const int row0 = b * TB + 256 * sc;
        f32x4 S[8][2];
#pragma unroll
        for (int dt = 0; dt < 8; ++dt) { S[dt][0] = (f32x4){0.f, 0.f, 0.f, 0.f}; S[dt][1] = (f32x4){0.f, 0.f, 0.f, 0.f}; }
        f32x4 blsum = (f32x4){0.f, 0.f, 0.f, 0.f};
        Raw R; raw_load<false, 2>(R, F, Q, K, V, dir, row0 + 64 * (fwd ? 0 : 3), h);
        for (int s = 0; s < 4; ++s) {
            GLA_BAR();
            raw_store<false>(R, F);
            if (s < 3) raw_load<false, 2>(R, F, Q, K, V, dir, row0 + 64 * (fwd ? s + 1 : 2 - s), h);
            GLA_BAR();
            decay_step<false>(F, fwd, blsum);
            GLA_BAR();
            s16x8 vf[2][2]; load_vf(F, vf);
            state_update(F, S, vf);
        }
        state_store(F, ST + ((size_t)bhd * NSC + sc) * ST_SLOT, S);
        if ((F.lane & 15) == 0) { f32x4 d;
#pragma unroll
            for (int r = 0; r < 4; ++r) d[r] = ex2(blsum[r]);
            *(f32x4*)(DT + ((size_t)bhd * NSC + sc) * 128 + 16 * F.wave + 4 * (F.lane >> 4)) = d; }
    }
}
__device__ __forceinline__ int sc_order(int dir, int n) { return n == 0 ? 0 : (dir == 0 ? n : NSC - n); }
__device__ __forceinline__ void s2_phase(Frame& F, bf16* ST, const float* DT) {
    const int total = 16 * 8 * 16 * 64;
    for (int g = F.bid * NTHR + F.tid; g < total; g += F.G * NTHR) {
        const int bhd = g >> 13, rem = g & 8191, tile = (rem >> 6) & 15, lane = rem & 63, dir = bhd & 1;
        const int d0 = 16 * (tile >> 1) + 4 * (lane >> 4);
        bf16* base = ST + (size_t)bhd * NSC * ST_SLOT + (size_t)rem * 4;
        const float* dtb = DT + (size_t)bhd * NSC * 128 + d0;
        f32x4 S = (f32x4){0.f, 0.f, 0.f, 0.f};
        v2u cur = *(const v2u*)(base + (size_t)sc_order(dir, 0) * ST_SLOT);
        f32x4 dcur = *(const f32x4*)(dtb + sc_order(dir, 0) * 128);
        for (int n = 0; n < NSC; ++n) {
            const int sc = sc_order(dir, n);
            v2u nxt = cur; f32x4 dn = dcur;
            if (n + 1 < NSC) { const int s2 = sc_order(dir, n + 1); nxt = *(const v2u*)(base + (size_t)s2 * ST_SLOT); dn = *(const f32x4*)(dtb + s2 * 128); }
            *(v2u*)(base + (size_t)sc * ST_SLOT) = pack4(S[0], S[1], S[2], S[3]);
            const unsigned cx = cur.x, cy = cur.y;
            S = dcur * S + (f32x4){bf2f(cx & 0xffffu), bf2f(cx >> 16), bf2f(cy & 0xffffu), bf2f(cy >> 16)};
            cur = nxt; dcur = dn;
        }
    }
}
template <bool CTX_ONLY>
__device__ __forceinline__ void c_phase(Frame& F, const bf16* ST) {
    const bf16* Q = F.BIG; const bf16* K = Q + (size_t)T * 512; const bf16* V = K + (size_t)T * 512; const bf16* Rg = V + (size_t)T * 1024;
    const float* ng = F.in[I_GLA_NG];
    const int w = F.wave;
    mask_fill(F);
    PROF_START();
    const int nitems = CTX_ONLY ? 8 : 8 * (NSC - 1);
    for (int item = CTX_ONLY ? F.bid - (F.G - 8) : F.bid; item >= 0 && item < nitems; item += CTX_ONLY ? nitems : F.G) {
        const int sc = CTX_ONLY ? 0 : 1 + item % (NSC - 1), bh = CTX_ONLY ? item : item / (NSC - 1), h = bh & 3, b = bh >> 2;
        const int row0 = b * TB + 256 * sc;
        for (int dir = 0; dir < 2; ++dir) {
            const bool fwd = dir == 0; const int bhd = bh * 2 + dir;
            f32x4 S[8][2];
            if (CTX_ONLY) {
#pragma unroll
                for (int dt = 0; dt < 8; ++dt) { S[dt][0] = (f32x4){0.f, 0.f, 0.f, 0.f}; S[dt][1] = (f32x4){0.f, 0.f, 0.f, 0.f}; }
            } else state_load(F, ST + ((size_t)bhd * NSC + sc) * ST_SLOT, S);
#if GLA_NOSTATE
#pragma unroll
            for (int dt = 0; dt < 8; ++dt) { S[dt][0] = (f32x4){0.f, 0.f, 0.f, 0.f}; S[dt][1] = (f32x4){0.f, 0.f, 0.f, 0.f}; }
#endif
            f32x4 blsum = (f32x4){0.f, 0.f, 0.f, 0.f};
            Raw R; raw_load<true, 2>(R, F, Q, K, V, dir, row0 + 64 * (fwd ? 0 : 3), h);
            PROF(0);
            for (int s = 0; s < 4; ++s) {
                const int c = fwd ? s : 3 - s, crow0 = row0 + 64 * c;
                GLA_BAR();
                PROF(1);
                raw_store<true>(R, F);
                if (s < 3) raw_load<true, 2>(R, F, Q, K, V, dir, row0 + 64 * (fwd ? s + 1 : 2 - s), h);
                GLA_BAR();
                PROF(2);
                decay_step<true>(F, fwd, blsum);
                GLA_BAR();
                PROF(3);
#if GLA_CHECK
                if (item == 0 && dir == GLA_CHECK_DIR && s == 0) {
                    unsigned bad = 0;
                    for (int idx = F.tid; idx < 64 * 128; idx += NTHR) { const int ii = idx >> 7, dd = idx & 127; float bsum = 0.f, btot = 0.f;
                        for (int jj = 0; jj < 64; ++jj) { const float gv = (float)F.Gt[((size_t)dir * T + crow0 + jj) * 512 + h * 128 + dd]; btot += gv; if (fwd ? (jj <= ii) : (jj >= ii)) bsum += gv; }
                        const float qv = bf2f(Q[(size_t)(crow0 + ii) * 512 + h * 128 + dd]), kv = bf2f(K[(size_t)(crow0 + ii) * 512 + h * 128 + dd]);
                        const float qs = bf2f(*(const LAS bf16*)(F.lds + L_Q + ii * PQ + dd * 2)), ks = bf2f(*(const LAS bf16*)(F.lds + L_K + ii * PQ + dd * 2)), kd = bf2f(*(const LAS bf16*)(F.lds + L_G + ii * PQ + dd * 2));
                        const float eq = qv * exp2f(bsum), ek = kv * exp2f(-bsum), ed = kv * exp2f(btot - bsum);
                        bad += fabsf(qs - eq) > 0.02f * fabsf(eq) + 1e-3f; bad += fabsf(ks - ek) > 0.02f * fabsf(ek) + 1e-3f; bad += fabsf(kd - ed) > 0.02f * fabsf(ed) + 1e-3f;
                        if (ii == 0) bad += fabsf(*(const LAS float*)(F.lds + L_D + dd * 4) - exp2f(btot)) > 0.01f; }
                    if (bad) atomicOr((unsigned*)((char*)F.mod - (WS_TAB + TAB_MOD) + WS_CTL + 32768 + 64), 1u);
                }
#endif
                { const int ln = opq(F.lane); const int i = ln & 15, q4 = ln >> 4; const int jt = w >> 1;
#pragma unroll
                  for (int t2 = 0; t2 < 2; ++t2) { const int it = 2 * (w & 1) + t2; f32x4 a = (f32x4){0.f, 0.f, 0.f, 0.f};
                      const bool dead = fwd ? (jt > it) : (jt < it);
                      if (!dead) {
#pragma unroll
                          for (int kb = 0; kb < 4; ++kb) { const s16x8 kf = *(const LAS s16x8*)(F.lds + L_K + (16 * jt + i) * PQ + (32 * kb + 8 * q4) * 2); const s16x8 qf = *(const LAS s16x8*)(F.lds + L_Q + (16 * it + i) * PQ + (32 * kb + 8 * q4) * 2);
                              a = mfma_bf16(kf, qf, a); }
                          if (jt == it) {
#pragma unroll
                              for (int r = 0; r < 4; ++r) { const int j = 4 * q4 + r; if (fwd ? (j > i) : (j < i)) a[r] = 0.f; } } }
                      *(LAS v2u*)(F.lds + L_A + (16 * it + i) * PA + (16 * jt + 4 * q4) * 2) = pack4(a[0], a[1], a[2], a[3]); } }
                GLA_BAR();
#if GLA_CHECK
                if (item == 0 && dir == GLA_CHECK_DIR && s == 0) {
                    unsigned bad = 0;
                    for (int idx = F.tid; idx < 64 * 64; idx += NTHR) { const int ii = idx >> 6, jj = idx & 63; float a = 0.f;
                        for (int dd = 0; dd < 128; ++dd) a += bf2f(*(const LAS bf16*)(F.lds + L_Q + ii * PQ + dd * 2)) * bf2f(*(const LAS bf16*)(F.lds + L_K + jj * PQ + dd * 2));
                        if (!(fwd ? (jj <= ii) : (jj >= ii))) a = 0.f;
                        const float got = bf2f(*(const LAS bf16*)(F.lds + L_A + ii * PA + jj * 2));
                        bad += fabsf(got - a) > 0.02f * fabsf(a) + 2e-2f; }
                    if (bad) atomicOr((unsigned*)((char*)F.mod - (WS_TAB + TAB_MOD) + WS_CTL + 32768 + 64), 2u);
                }
#endif
                PROF(4);
                s16x8 vf[2][2]; load_vf(F, vf);
#pragma unroll 1
                for (int hf = 0; hf < 4; ++hf) {
                    const int ln = opq(F.lane); const int i = ln & 15, q4 = ln >> 4;
                    f32x4 o[2][1];
#pragma unroll
                    for (int ee = 0; ee < 2; ++ee)
#pragma unroll
                        for (int t2 = 0; t2 < 1; ++t2) o[ee][t2] = (f32x4){0.f, 0.f, 0.f, 0.f};
#pragma unroll
                    for (int t2 = 0; t2 < 1; ++t2)
#pragma unroll
                        for (int kb = 0; kb < 2; ++kb) { const s16x8 af = *(const LAS s16x8*)(F.lds + L_A + (16 * (hf + t2) + i) * PA + (32 * kb + 8 * q4) * 2);
                            o[0][t2] = mfma_bf16(vf[kb][0], af, o[0][t2]); o[1][t2] = mfma_bf16(vf[kb][1], af, o[1][t2]); }
#if GLA_CHECK
                    if (item == 0 && dir == GLA_CHECK_DIR && s == 0) {
                        unsigned bad = 0;
                        for (int ee = 0; ee < 2; ++ee) for (int r = 0; r < 4; ++r) { const int tok = 16 * hf + i, e = 16 * (2 * w + ee) + 4 * q4 + r; float a = 0.f;
                            for (int jj = 0; jj < 64; ++jj) a += bf2f(*(const LAS bf16*)(F.lds + L_A + tok * PA + jj * 2)) * bf2f(*(const LAS bf16*)(F.lds + L_V + jj * PV + e * 2));
                            const f32x4 ov = o[ee][0]; bad += fabsf(ov[r] - a) > 0.02f * fabsf(a) + 2e-2f; }
                        if (bad) atomicOr((unsigned*)((char*)F.mod - (WS_TAB + TAB_MOD) + WS_CTL + 32768 + 64), 4u);
                    }
#endif
#pragma unroll
                    for (int kb = 0; kb < 4; ++kb) {
                        s16x8 sf[2];
#pragma unroll
                        for (int ee = 0; ee < 2; ++ee) { const f32x4 lo = S[2 * kb][ee], hi = S[2 * kb + 1][ee]; v4u t; t.x = cvt2(lo[0], lo[1]); t.y = cvt2(lo[2], lo[3]); t.z = cvt2(hi[0], hi[1]); t.w = cvt2(hi[2], hi[3]); sf[ee] = __builtin_bit_cast(s16x8, t); }
#pragma unroll
                        for (int t2 = 0; t2 < 1; ++t2) { LAS unsigned char* p = F.lds + L_Q + (16 * (hf + t2) + i) * PQ + (32 * kb + 4 * q4) * 2;
                            const s16x4 lo = *(const LAS s16x4*)p, hi = *(const LAS s16x4*)(p + 32); const s16x8 qf = cat8(lo, hi);
                            o[0][t2] = mfma_bf16(sf[0], qf, o[0][t2]); o[1][t2] = mfma_bf16(sf[1], qf, o[1][t2]); } }
                    { const int row = crow0 + 16 * hf + i;
                      bf16* yp = (dir == 0 ? orow16(F, row) : F.H + (size_t)row * D) + h * 256 + 16 * (2 * w) + 4 * q4; const f32x4 a0 = o[0][0], a1 = o[1][0];
                      *(v2u*)yp = pack4(a0[0], a0[1], a0[2], a0[3]); *(v2u*)(yp + 16) = pack4(a1[0], a1[1], a1[2], a1[3]); }
                }
                PROF(5);
                if (s < 3) {
#if !GLA_NOSTATE
                    state_update(F, S, vf);
#endif
                }
            }
            GLA_BAR();
        }
        PROF(6);
        asm volatile("s_waitcnt vmcnt(0)" ::: "memory"); __syncthreads();
        { const int ln = opq(F.lane); const f32x4 g4 = *(const f32x4*)(ng + 4 * ln);
#pragma unroll 1
          for (int rr = 0; rr < 32; rr += 8) {
              v2u of[8], ob[8], rg[8];
#pragma unroll
              for (int u = 0; u < 8; ++u) { const int row = row0 + w * 32 + rr + u;
                  of[u] = *(const v2u*)(orow16(F, row) + h * 256 + 4 * ln); ob[u] = *(const v2u*)(F.H + (size_t)row * D + h * 256 + 4 * ln); rg[u] = *(const v2u*)(Rg + (size_t)row * 1024 + h * 256 + 4 * ln); }
#pragma unroll
              for (int u = 0; u < 8; ++u) { const int row = row0 + w * 32 + rr + u; const unsigned bx = ob[u].x, by = ob[u].y, rx = rg[u].x, ry = rg[u].y, fx = of[u].x, fy = of[u].y;
                  const f32x4 o = (f32x4){bf2f(fx & 0xffffu), bf2f(fx >> 16), bf2f(fy & 0xffffu), bf2f(fy >> 16)} + (f32x4){bf2f(bx & 0xffffu), bf2f(bx >> 16), bf2f(by & 0xffffu), bf2f(by >> 16)};
                  const float rs = rsqrtf(wave_sum((o[0] * o[0] + o[1] * o[1]) + (o[2] * o[2] + o[3] * o[3])) * (1.0f / 256.0f) + EPS);
                  *(v2u*)(F.H + (size_t)row * D + h * 256 + 4 * ln) = pack4(o[0] * rs * g4[0] * fast_silu(bf2f(rx & 0xffffu)), o[1] * rs * g4[1] * fast_silu(bf2f(rx >> 16)),
                                                                           o[2] * rs * g4[2] * fast_silu(bf2f(ry & 0xffffu)), o[3] * rs * g4[3] * fast_silu(bf2f(ry >> 16))); } } }
        PROF(7);
    }
}
}


namespace na {
typedef gla::s16x4 s16x4; typedef gla::s16x8 s16x8;
constexpr int PK = 144;
constexpr int KV = 128 * PK;
constexpr int L_BUF = 0, L_RPB = 4 * KV;
constexpr float NEG = -1.0e30f;

template <int A, bool NB>
__device__ __forceinline__ void na_block128(LAS unsigned char* Kb, LAS unsigned char* Vb, const s16x8 (&qf)[2], f32x4 (&O)[4], float& m, float& l,
                                            bool act0, bool act1, int kr0, int rq, int c, int cs, int i, int q4, const LAS float* rpl) {
    constexpr int KLO = NB ? (A > 0 ? A - 1 : 0) : 0, KHI = NB ? (A < 3 ? A + 1 : 3) : 3, NT = KHI - KLO + 1;
    f32x4 s[2][NT];
#pragma unroll
    for (int hh = 0; hh < 2; ++hh)
#pragma unroll
        for (int tt = 0; tt < NT; ++tt) { f32x4 acc = (f32x4){0.f, 0.f, 0.f, 0.f};
#pragma unroll
            for (int ks = 0; ks < 2; ++ks) { const s16x8 kf = *(const LAS s16x8*)(Kb + (64 * hh + 16 * (KLO + tt) + i) * PK + (32 * ks + 8 * q4) * 2); acc = gla::mfma_bf16(kf, qf[ks], acc); }
            s[hh][tt] = acc; }
    float bm = NEG;
#pragma unroll
    for (int hh = 0; hh < 2; ++hh) { const bool acth = hh == 0 ? act0 : act1; const int brow = (kr0 + hh - rq + 7) * 31 - c + 15;
#pragma unroll
        for (int tt = 0; tt < NT; ++tt)
#pragma unroll
            for (int r = 0; r < 4; ++r) { float v = s[hh][tt][r];
                if (NB) { const int kc = 16 * (KLO + tt) + 4 * q4 + r; const bool ok = acth && kc >= cs && kc < cs + 16; const float bias = rpl[ok ? brow + kc : 0]; v = ok ? v + bias : NEG; }
                s[hh][tt][r] = v; bm = fmaxf(bm, v); } }
    if (__builtin_amdgcn_ballot_w64(bm > m + 8.0f) != 0ull) {
        bm = fmaxf(bm, __shfl_xor(bm, 16)); bm = fmaxf(bm, __shfl_xor(bm, 32));
        const float mn = fmaxf(m, bm), alpha = gla::ex2(m - mn);
        l *= alpha; m = mn;
#pragma unroll
        for (int dt = 0; dt < 4; ++dt) O[dt] *= alpha;
    }
    float ls = 0.f;
#pragma unroll
    for (int hh = 0; hh < 2; ++hh)
#pragma unroll
        for (int tt = 0; tt < NT; ++tt)
#pragma unroll
            for (int r = 0; r < 4; ++r) { const float pe = gla::ex2(s[hh][tt][r] - m); s[hh][tt][r] = pe; ls += pe; }
    l += ls;
#pragma unroll
    for (int hh = 0; hh < 2; ++hh)
#pragma unroll
        for (int k2 = 0; k2 < 2; ++k2) {
            if (2 * k2 + 1 >= KLO && 2 * k2 <= KHI) {
                const int t0 = 2 * k2 - KLO, t1 = 2 * k2 + 1 - KLO;
                f32x4 p0 = (f32x4){0.f, 0.f, 0.f, 0.f}, p1 = (f32x4){0.f, 0.f, 0.f, 0.f};
                if (t0 >= 0 && t0 < NT) p0 = s[hh][t0 >= 0 && t0 < NT ? t0 : 0];
                if (t1 >= 0 && t1 < NT) p1 = s[hh][t1 >= 0 && t1 < NT ? t1 : 0];
                v4u tq; tq.x = gla::cvt2(p0[0], p0[1]); tq.y = gla::cvt2(p0[2], p0[3]); tq.z = gla::cvt2(p1[0], p1[1]); tq.w = gla::cvt2(p1[2], p1[3]);
                const s16x8 pf = __builtin_bit_cast(s16x8, tq);
#pragma unroll
                for (int dt = 0; dt < 4; ++dt) { LAS unsigned char* vp = Vb + (64 * hh + 32 * k2 + 4 * q4 + (i >> 2)) * PK + (16 * dt + 4 * (i & 3)) * 2;
                    const s16x8 vf = gla::cat8(gla::trread(vp), gla::trread(vp + 16 * PK));
                    O[dt] = gla::mfma_bf16(vf, pf, O[dt]); } } }
}
template <int A>
__device__ __forceinline__ void na_item_blocks(Frame& F, const bf16* NK, const bf16* NV, const s16x8 (&qf)[2], f32x4 (&O)[4], float& m, float& l,
                                               int b, int h, int rs_lo, int rs_q, int rq, int nbn, int nblk, int c, int cs, int i, int q4, const LAS float* rpl) {
    const int tid = gla::opq(F.tid);
    v4u pk[3][2], pv[3][2];
#define NA_LOAD(set, nb) do { const int nb_ = (nb); if (nb_ < nblk) { _Pragma("unroll") for (int x_ = 0; x_ < 2; ++x_) { const int pc_ = tid + 512 * x_, key_ = pc_ >> 3, part_ = pc_ & 7; \
            int gr_ = rs_lo + 2 * nb_ + (key_ >> 6); gr_ = gr_ > 127 ? 127 : gr_; \
            const size_t row_ = nb_ < nbn ? (size_t)b * TB + LCTX + gr_ * 64 + (key_ & 63) : (size_t)b * TB + (nb_ - nbn) * 128 + key_; \
            pk[set][x_] = *(const v4u*)(NK + row_ * 1024 + h * 64 + part_ * 8); pv[set][x_] = *(const v4u*)(NV + row_ * 1024 + h * 64 + part_ * 8); } } } while (0)
#define NA_WRITE(set, nb) do { const int nb_ = (nb); if (nb_ < nblk) { LAS unsigned char* nbuf_ = F.lds + L_BUF + (nb_ & 1) * 2 * KV; _Pragma("unroll") for (int x_ = 0; x_ < 2; ++x_) { const int pc_ = tid + 512 * x_, key_ = pc_ >> 3, part_ = pc_ & 7; \
            *(LAS v4u*)(nbuf_ + key_ * PK + part_ * 16) = pk[set][x_]; *(LAS v4u*)(nbuf_ + KV + key_ * PK + part_ * 16) = pv[set][x_]; } } } while (0)
    NA_LOAD(0, 0); NA_LOAD(1, 1); NA_LOAD(2, 2);
    GLA_BAR();
    for (int idx = F.tid; idx < 465; idx += NTHR) ((LAS float*)rpl)[idx] = F.in[I_NA_RPB][h * 465 + idx] * LOG2E;
    NA_WRITE(0, 0);
#define NA_STEP(blk_, setcur) do { const int blk = (blk_); \
        GLA_BAR(); \
        NA_LOAD(setcur, blk + 3); \
        const bool isnb = blk < nbn; const int kr0 = rs_lo + 2 * blk; \
        const bool act0 = isnb ? (kr0 >= rs_q && kr0 < rs_q + 8) : true, act1 = isnb ? (kr0 + 1 >= rs_q && kr0 + 1 < rs_q + 8) : true; \
        LAS unsigned char* Kb = F.lds + L_BUF + (blk & 1) * 2 * KV; LAS unsigned char* Vb = Kb + KV; \
        if (isnb) { if (act0 || act1) na_block128<A, true>(Kb, Vb, qf, O, m, l, act0, act1, kr0, rq, c, cs, i, q4, rpl); } \
        else na_block128<A, false>(Kb, Vb, qf, O, m, l, true, true, kr0, rq, c, cs, i, q4, rpl); \
        NA_WRITE((setcur + 1) % 3, blk + 1); } while (0)
    for (int blk0 = 0; blk0 < nblk; blk0 += 3) {
        NA_STEP(blk0, 0);
        if (blk0 + 1 < nblk) NA_STEP(blk0 + 1, 1);
        if (blk0 + 2 < nblk) NA_STEP(blk0 + 2, 2);
    }
#undef NA_STEP
#undef NA_LOAD
#undef NA_WRITE
}

__device__ __forceinline__ void na_phase(Frame& F) {
    const bf16* NQ = F.BIG; const bf16* NK = NQ + (size_t)T * 1024; const bf16* NV = NK + (size_t)T * 1024; bf16* NO = F.H;
    const int w = F.wave, a = w & 3, rsel = w >> 2;
    const int vcu = (F.G % 8 == 0) ? (F.bid % 8) * (F.G / 8) + F.bid / 8 : F.bid;
    LAS float* rpl = (LAS float*)(F.lds + L_RPB);
    for (int item = vcu; item < NB * 16 * 64; item += F.G) {
        const int p = item & 63, bh = item >> 6, h = bh & 15, b = bh >> 4, r0 = 2 * p;
        const int rq = r0 + rsel;
        int rs_q = rq - 4; rs_q = rs_q < 0 ? 0 : (rs_q > 120 ? 120 : rs_q);
        int rs_lo = r0 - 4; rs_lo = rs_lo < 0 ? 0 : (rs_lo > 120 ? 120 : rs_lo);
        int rs_h1 = r0 - 3; rs_h1 = rs_h1 < 0 ? 0 : (rs_h1 > 120 ? 120 : rs_h1);
        const int nrows = rs_h1 + 8 - rs_lo, nbn = (nrows + 1) >> 1, nblk = nbn + 2;
        const int ln = gla::opq(F.lane); const int i = ln & 15, q4 = ln >> 4;
        const int c = 16 * a + i; int cs = c - 8; cs = cs < 0 ? 0 : (cs > 48 ? 48 : cs);
        const size_t qrow = (size_t)b * TB + LCTX + rq * 64 + c;
        s16x8 qf[2];
#pragma unroll
        for (int ks = 0; ks < 2; ++ks) qf[ks] = *(const s16x8*)(NQ + qrow * 1024 + h * 64 + 32 * ks + 8 * q4);
        f32x4 O[4];
#pragma unroll
        for (int dt = 0; dt < 4; ++dt) O[dt] = (f32x4){0.f, 0.f, 0.f, 0.f};
        float m = NEG, l = 0.f;
        if (a == 0) na_item_blocks<0>(F, NK, NV, qf, O, m, l, b, h, rs_lo, rs_q, rq, nbn, nblk, c, cs, i, q4, rpl);
        else if (a == 1) na_item_blocks<1>(F, NK, NV, qf, O, m, l, b, h, rs_lo, rs_q, rq, nbn, nblk, c, cs, i, q4, rpl);
        else if (a == 2) na_item_blocks<2>(F, NK, NV, qf, O, m, l, b, h, rs_lo, rs_q, rq, nbn, nblk, c, cs, i, q4, rpl);
        else na_item_blocks<3>(F, NK, NV, qf, O, m, l, b, h, rs_lo, rs_q, rq, nbn, nblk, c, cs, i, q4, rpl);
        l += __shfl_xor(l, 16); l += __shfl_xor(l, 32);
        const float inv = 1.0f / l;
#pragma unroll
        for (int dt = 0; dt < 4; ++dt) { const f32x4 o = O[dt] * inv; *(v2u*)(NO + qrow * 1024 + h * 64 + 16 * dt + 4 * q4) = gla::pack4(o[0], o[1], o[2], o[3]); }
    }
}
}

constexpr int NPHASE = 18;
enum { P_PRO = 0, P_MOD0, P_GIN, P_GLA_S1, P_GLA_S2, P_GLA_C, P_GOUT, P_MOD1, P_FIN0, P_FOUT0, P_MOD2, P_NQKV, P_NA, P_NOUT, P_MOD3, P_FIN1, P_FOUT1, P_FINAL, P_GOLD_GLA = 30, P_GOLD_POST = 31, P_GOLD_NA = 32 };
constexpr size_t WS_ST = WS_END;
constexpr size_t TAB_DT = 256 * 1024;
static_assert(WS_ST + (size_t)16 * 33 * 32768 * 2 <= 256 * MiB, "GLA states fit");
__global__ void __launch_bounds__(NTHR, 2) mega_fwd(Args args) {
    extern __shared__ __attribute__((aligned(16))) unsigned char lds[];
    Frame F;
    F.lds = (LAS unsigned char*)lds;
    F.tid = threadIdx.x; F.lane = F.tid & 63; F.wave = __builtin_amdgcn_readfirstlane(F.tid >> 6);
    F.G = gridDim.x; F.bid = blockIdx.x;
    F.in = args.in; F.xlat = args.out;
    unsigned char* ws = args.ws;
    F.xctx = (float*)(ws + WS_XCTX); F.octx = (float*)(ws + WS_OCTX);
    F.rcos = (float*)(ws + WS_TAB + TAB_COS); F.rsin = (float*)(ws + WS_TAB + TAB_SIN); F.mod = (float*)(ws + WS_TAB + TAB_MOD);
    F.wt = (bf16*)(ws + WS_WT); F.H = (bf16*)(ws + WS_H); F.Gt = (_Float16*)(ws + WS_G); F.BIG = (bf16*)(ws + WS_BIG);
    volatile LAS unsigned* MISC = (volatile LAS unsigned*)(F.lds + MISC_OFF);
    for (int u = F.tid; u < (LDS_BYTES - MISC_OFF) / 4; u += NTHR) ((LAS unsigned*)(F.lds + MISC_OFF))[u] = 0u;
    __syncthreads();
    const int lo = args.ph_lo, hi = args.ph_hi;
    const bool multi = (hi - lo) > 1;
    XcdBarrier bar; bar.bar = (unsigned*)(ws + WS_CTL) + CW_BAR; bar.x = 0; bar.st = nullptr;
    if (multi) bar = xcd_barrier_post((unsigned*)(ws + WS_CTL) + CW_BAR, MISC + 8);
#define IN(k) (phase_fence(F), (lo <= (k) && (k) < hi))
#if PROBE_STAMP >= 0
#define STAMP(k) do { if (F.bid == 0 && F.tid == 0) ((unsigned long long*)(ws + WS_CTL + 40960))[(k) + 1] = __builtin_amdgcn_s_memrealtime(); } while (0)
#else
#define STAMP(k) do { } while (0)
#endif
#define SEAM(k) do { if (IN(k) && IN((k) + 1)) xcd_barrier(bar); STAMP(k); } while (0)
    bf16* Q = F.BIG; bf16* Kq = Q + (size_t)T * 512; bf16* V = Kq + (size_t)T * 512; bf16* R = V + (size_t)T * 1024;
    PG8_LAS unsigned char* ring = (PG8_LAS unsigned char*)F.lds;
    PG8_LAS float* edge = (PG8_LAS float*)(F.lds + EDGE_OFF);
    bf16* ST = (bf16*)(ws + WS_ST); float* DT = (float*)(ws + WS_TAB + TAB_DT);

#if PROBE_STAMP >= 0
    if (F.bid == 0 && F.tid == 0) ((unsigned long long*)(ws + WS_CTL + 40960))[0] = __builtin_amdgcn_s_memrealtime();
#endif
    if (IN(P_PRO)) { p0_prologue(F); } SEAM(P_PRO);
    if (IN(P_MOD0)) { modulate_phase<true, true>(F, 0, 0); } SEAM(P_MOD0);
    if (IN(P_GIN)) { pg8::Gemm g{F.H, (const bf16*)((const char*)F.wt + WT_GLA_IN), T, 3072, D}; pg8::Sched S; S.init(pg8::RM_ALL66, 3072, F.G, F.bid);
        pg8::EpiGlaIn E{Q, Kq, V, R, F.rcos, F.rsin};
        pg8::gemm_phase<pg8::EpiGlaIn, pg8::Sched, PG8_ALIGN, PG8_SP2>(ring, g, S, E); } SEAM(P_GIN);
    if (IN(P_GLA_S1)) { gla::s1_phase(F, ST, DT); if (F.bid >= F.G - 8) gla::c_phase<true>(F, ST); } SEAM(P_GLA_S1);
    if (IN(P_GLA_S2)) { gla::s2_phase(F, ST, DT); } SEAM(P_GLA_S2);
    if (IN(P_GLA_C)) { gla::c_phase<false>(F, ST); } SEAM(P_GLA_C);
#if MK_HYBRID
    if (IN(P_GOLD_GLA)) { gla_golden_phase(F); }
    if (IN(P_GOLD_POST)) { gla_post_phase(F); }
#endif
    if (IN(P_GOUT)) { pg8::Gemm g{F.H, (const bf16*)((const char*)F.wt + WT_GLA_OUT), T, 1024, D}; pg8::Sched S; S.init(pg8::RM_ALL66, 1024, F.G, F.bid);
        pg8::EpiResid E{F.in[I_X], F.in[I_CTX], F.xlat, F.xctx, F.mod + 0 * 3 * 6144 + 2 * D};
        pg8::gemm_phase<pg8::EpiResid, pg8::Sched, PG8_ALIGN, PG8_SP2>(ring, g, S, E); } SEAM(P_GOUT);
    if (IN(P_MOD1)) { modulate_phase<false, false>(F, 0, 1); } SEAM(P_MOD1);
    if (IN(P_FIN0)) { pg8::Gemm g{F.H, (const bf16*)((const char*)F.wt + WT_FFN_IN0), T, 5632, D}; pg8::Sched S; S.init(pg8::RM_WIN68, 5632, F.G, F.bid);
        pg8::EpiFfnIn E{F.BIG, F.in[I_FFN_CW], F.in[I_FFN_CB], edge};
        pg8::gemm_phase<pg8::EpiFfnIn, pg8::Sched, true, PG8_SP2>(ring, g, S, E); } SEAM(P_FIN0);
    if (IN(P_FOUT0)) { pg8::Gemm g{F.BIG, (const bf16*)((const char*)F.wt + WT_FFN_OUT0), T, 1024, DFF}; pg8::Sched S; S.init(pg8::RM_ALL66, 1024, F.G, F.bid);
        pg8::EpiResid E{F.xlat, F.xctx, F.xlat, F.xctx, F.mod + 0 * 3 * 6144 + 5 * D};
        pg8::gemm_phase<pg8::EpiResid, pg8::Sched, PG8_ALIGN, PG8_SP2>(ring, g, S, E); } SEAM(P_FOUT0);
    if (IN(P_MOD2)) { modulate_phase<false, false>(F, 1, 0); } SEAM(P_MOD2);
    if (IN(P_NQKV)) { pg8::Gemm g{F.H, (const bf16*)((const char*)F.wt + WT_NA_QKV), T, 3072, D}; pg8::Sched S; S.init(pg8::RM_ALL66, 3072, F.G, F.bid);
        pg8::EpiNaQkv E{F.BIG};
        pg8::gemm_phase<pg8::EpiNaQkv, pg8::Sched, PG8_ALIGN, PG8_SP2>(ring, g, S, E); } SEAM(P_NQKV);
    if (IN(P_NA)) { na::na_phase(F); } SEAM(P_NA);
#if MK_HYBRID
    if (IN(P_GOLD_NA)) { na_golden_phase(F); }
#endif
    if (IN(P_NOUT)) { pg8::Gemm g{F.H, (const bf16*)((const char*)F.wt + WT_NA_OUT), T, 1024, D}; pg8::Sched S; S.init(pg8::RM_LAT64, 1024, F.G, F.bid);
        pg8::EpiResid E{F.xlat, F.xctx, F.xlat, F.xctx, F.mod + 1 * 3 * 6144 + 2 * D};
        pg8::gemm_phase<pg8::EpiResid, pg8::Sched, PG8_ALIGN, PG8_SP2>(ring, g, S, E); } SEAM(P_NOUT);
    if (IN(P_MOD3)) { modulate_phase<false, false>(F, 1, 1); } SEAM(P_MOD3);
    if (IN(P_FIN1)) { pg8::Gemm g{F.H, (const bf16*)((const char*)F.wt + WT_FFN_IN1), T, 5632, D}; pg8::Sched S; S.init(pg8::RM_WIN66, 5632, F.G, F.bid);
        pg8::EpiFfnIn E{F.BIG, F.in[I_FFN_CW] + 3 * DFF, F.in[I_FFN_CB] + DFF, edge};
        pg8::gemm_phase<pg8::EpiFfnIn, pg8::Sched, true, PG8_SP2>(ring, g, S, E); } SEAM(P_FIN1);
    if (IN(P_FOUT1)) { pg8::Gemm g{F.BIG, (const bf16*)((const char*)F.wt + WT_FFN_OUT1), T, 1024, DFF}; pg8::Sched S; S.init(pg8::RM_LAT64, 1024, F.G, F.bid);
        pg8::EpiResid E{F.xlat, F.xctx, F.xlat, F.xctx, F.mod + 1 * 3 * 6144 + 5 * D};
        pg8::gemm_phase<pg8::EpiResid, pg8::Sched, PG8_ALIGN, PG8_SP2>(ring, g, S, E); } SEAM(P_FOUT1);
    if (IN(P_FINAL)) { final_phase(F); }
#if PROBE_STAMP >= 0
    if (IN(P_FINAL)) { __syncthreads(); if (F.bid == 0 && F.tid == 0) { const unsigned long long* st = (const unsigned long long*)(ws + WS_CTL + 40960); const unsigned long long* pa = (const unsigned long long*)(ws + WS_CTL + 49152); const unsigned long long t1 = PROBE_STAMP >= 300 ? pa[PROBE_STAMP - 300 + 1] : PROBE_STAMP >= 200 ? pa[PROBE_STAMP - 200 + 1] : PROBE_STAMP == 99 ? __builtin_amdgcn_s_memrealtime() : st[PROBE_STAMP + 1], t0 = PROBE_STAMP >= 200 ? 0ull : PROBE_STAMP == 99 ? st[0] : st[PROBE_STAMP]; asm volatile("s_waitcnt vmcnt(0)" ::: "memory"); F.xlat[0] = (float)(t1 - t0) * 0.01f * PROBE_SCALE; } }
#endif
#undef IN
#undef SEAM
}


#if MK_HYBRID
namespace gold {
__global__ void __launch_bounds__(256) k_ydiff(const bf16* a, const bf16* b, float* acc, int mode) {
    float mx = 0.f;
    for (size_t i = (size_t)blockIdx.x * 256 + threadIdx.x; i < (size_t)T * D; i += (size_t)gridDim.x * 256) {
        const int row = (int)(i >> 10), col = (int)(i & 1023); bool sel = true;
        if (mode == 10) sel = (row % TB) >= LCTX; if (mode == 2) sel = (row % TB) < LCTX; if (mode == 3) sel = (row % TB) >= LCTX && (row % TB) < LCTX + 256; if (mode == 4) sel = col < 256; if (mode == 5) sel = (row % TB) >= TB - 256;
        if (sel) mx = fmaxf(mx, fabsf(bf2f(a[i]) - bf2f(b[i])));
    }
    for (int o = 32; o > 0; o >>= 1) mx = fmaxf(mx, __shfl_xor(mx, o));
    if ((threadIdx.x & 63) == 0) atomicMax((unsigned*)acc, __float_as_uint(mx));
}
__global__ void k_apply(float* out, const float* acc, float scale) { out[0] = scale * acc[0]; }
__global__ void k_apply_flags(float* out, const unsigned* flags) { out[0] = 1000.0f * (float)flags[0]; }
}
#endif

extern "C" void kernel_launch(void* const* d_in, const int* in_sizes, int n_in, void* d_out, int out_size, void* d_ws, size_t ws_size, hipStream_t stream) {
    static int grid = 0;
    if (grid == 0) {
        if (n_in != 22 || out_size != NB * NSEQ * D || ws_size < WS_END) { fprintf(stderr, "kernel_launch: unexpected shapes (n_in %d out %d ws %zu)\n", n_in, out_size, ws_size); grid = -1; return; }
        int dev = 0, cus = 0, per_cu = 0;
        if (hipGetDevice(&dev) != hipSuccess || hipDeviceGetAttribute(&cus, hipDeviceAttributeMultiprocessorCount, dev) != hipSuccess) { grid = -1; return; }
        if (hipFuncSetAttribute((const void*)mega_fwd, hipFuncAttributeMaxDynamicSharedMemorySize, LDS_BYTES) != hipSuccess) { fprintf(stderr, "kernel_launch: hipFuncSetAttribute failed\n"); grid = -1; return; }
        if (hipOccupancyMaxActiveBlocksPerMultiprocessor(&per_cu, (const void*)mega_fwd, NTHR, LDS_BYTES) != hipSuccess || per_cu < 1) { fprintf(stderr, "kernel_launch: occupancy query says %d blocks per CU\n", per_cu); (void)hipGetLastError(); grid = -1; return; }
        grid = cus;
    }
    if (grid < 0) return;
    (void)hipMemsetAsync((char*)d_ws + WS_CTL, 0, CTL_ZERO_BYTES, stream);
    Args a{};
    for (int i = 0; i < 22; ++i) a.in[i] = (const float*)d_in[i];
    a.out = (float*)d_out; a.ws = (unsigned char*)d_ws;
#if MK_HYBRID
    auto run = [&](int p) { a.ph_lo = p; a.ph_hi = p + 1; hipLaunchKernelGGL(mega_fwd, dim3(grid), dim3(NTHR), LDS_BYTES, stream, a); };
#if GLA_TEST
    float* dacc = (float*)((char*)d_ws + WS_CTL + 32768);
    run(P_PRO); run(P_MOD0); run(P_GIN); run(P_GOLD_GLA); run(P_GOLD_POST);
    (void)hipMemcpyAsync((char*)d_ws + WS_WT, (char*)d_ws + WS_H, (size_t)T * D * 2, hipMemcpyDeviceToDevice, stream);
    run(P_GLA_S1); run(P_GLA_S2); run(P_GLA_C);
    gold::k_ydiff<<<1024, 256, 0, stream>>>((const bf16*)((char*)d_ws + WS_H), (const bf16*)((char*)d_ws + WS_WT), dacc, GLA_TEST);
    (void)hipMemsetAsync(d_out, 0, (size_t)NB * NSEQ * D * 4, stream);
#if GLA_CHECK
    gold::k_apply_flags<<<1, 1, 0, stream>>>((float*)d_out, (const unsigned*)((char*)d_ws + WS_CTL + 32768 + 64));
#else
    gold::k_apply<<<1, 1, 0, stream>>>((float*)d_out, dacc, 10000.0f);
#endif
#elif NA_TEST
    float* dacc = (float*)((char*)d_ws + WS_CTL + 32768);
    for (int p = 0; p <= P_NQKV; ++p) run(p);
    run(P_GOLD_NA);
    (void)hipMemcpyAsync((char*)d_ws + WS_WT, (char*)d_ws + WS_H, (size_t)T * D * 2, hipMemcpyDeviceToDevice, stream);
    run(P_NA);
    gold::k_ydiff<<<1024, 256, 0, stream>>>((const bf16*)((char*)d_ws + WS_H), (const bf16*)((char*)d_ws + WS_WT), dacc, NA_TEST);
    (void)hipMemsetAsync(d_out, 0, (size_t)NB * NSEQ * D * 4, stream);
    gold::k_apply<<<1, 1, 0, stream>>>((float*)d_out, dacc, 10000.0f);
#else
    for (int p = 0; p < NPHASE; ++p) run(p);
#endif
#else
    a.ph_lo = 0; a.ph_hi = NPHASE;
    void* kargs[] = {&a};
    hipError_t e = hipLaunchCooperativeKernel((const void*)mega_fwd, dim3(grid), dim3(NTHR), kargs, LDS_BYTES, stream);
    if (e != hipSuccess) fprintf(stderr, "kernel_launch: cooperative launch failed: %s (grid %d)\n", hipGetErrorString(e), grid);
#endif
}
```
